# Optimizing an MI355X kernel written in HIP

```python
import math
import jax
import jax.numpy as jnp
from jax import lax
import numpy as np

D_MODEL = 1024
BATCH = 8
SEQ = 4096
DEPTH = 2

GRID_W = 64
CTX_LEN = 256
N_MOD = 6
EPS = 1e-6

N_BRANCH = 4
BRANCH_W = D_MODEL // N_BRANCH
FN_GROUPS = 4
FN_GW = BRANCH_W // FN_GROUPS
RW_HD = 64
RW_HEADS = BRANCH_W // RW_HD
RW_DECAY_RANK = 32
RW_ICL_RANK = 32
RW_GATE_RANK = 64
RW_COLS = 3 * BRANCH_W + RW_DECAY_RANK + RW_ICL_RANK + RW_GATE_RANK
RW_DECAY_SCALE = math.exp(-0.5)
RW_GN_EPS = 64e-5
DN_HD = 64
DN_HEADS = BRANCH_W // DN_HD
DN_CONV = 5
DN_CHUNK = 64
S5_GW = 16
S5_GROUPS = BRANCH_W // S5_GW
S5_STATE = 64
N_EXPERTS = 16
N_EXPERT_GROUPS = 4
EXPERTS_PER_GROUP = N_EXPERTS // N_EXPERT_GROUPS
TOP_K = 2
D_EXPERT = 256

IN_SIZES = (BRANCH_W, RW_COLS, 3 * BRANCH_W, BRANCH_W, 2 * DN_HEADS, 2 * DN_HEADS, BRANCH_W, N_BRANCH * D_MODEL)
N_IN = sum(IN_SIZES)
RW_SIZES = (BRANCH_W, BRANCH_W, BRANCH_W, RW_DECAY_RANK, RW_ICL_RANK, RW_GATE_RANK)

kernel_name = "hybrid_parallel_mixer_moe_trunk"


def _split_points(sizes):
    return [int(v) for v in np.cumsum(sizes)[:-1]]


def _oriented(t, d):
    return jnp.flip(t, axis=1) if d == 1 else t


def rms_norm(x, g):
    xf = x.astype(jnp.float32)
    y = xf * lax.rsqrt(jnp.mean(xf * xf, axis=-1, keepdims=True) + EPS)
    return (y * g.astype(jnp.float32)).astype(x.dtype)


def l2_normalize(t):
    return t * lax.rsqrt(jnp.sum(t * t, axis=-1, keepdims=True) + EPS)


def adaln(cond, w_mod, b_mod):
    m = jax.nn.silu(cond) @ w_mod + b_mod
    return jnp.split(m[..., None, :], N_MOD, axis=-1)


def raster_to_columns(t, rows):
    b, l, ch = t.shape
    return t.reshape(b, rows, GRID_W, ch).swapaxes(1, 2).reshape(b, l, ch)


def columns_to_raster(t, rows):
    b, l, ch = t.shape
    return t.reshape(b, GRID_W, rows, ch).swapaxes(1, 2).reshape(b, l, ch)


def centred_token_shift(p, mu_prev, mu_next):
    prev = jnp.pad(p, ((0, 0), (1, 0), (0, 0)))[:, :-1]
    nxt = jnp.pad(p, ((0, 0), (0, 1), (0, 0)))[:, 1:]
    return p + mu_prev * (prev - p) + mu_next * (nxt - p)


def centred_depthwise_conv(u, w):
    pad = w.shape[0] // 2
    return lax.conv_general_dilated(u, w[:, None, :].astype(u.dtype), (1,), [(pad, pad)],
                                    dimension_numbers=("NWC", "WIO", "NWC"),
                                    feature_group_count=u.shape[-1])


def fourier_mix(u):
    b, l, _ = u.shape
    ug = u.astype(jnp.float32).reshape(b, l, FN_GROUPS, FN_GW)
    f = jnp.fft.fftn(ug, axes=(1, 3), norm="ortho")
    return jnp.real(f).reshape(b, l, BRANCH_W).astype(u.dtype)


def rwkv_scan(r, w, k, v, kk, a, s0):
    def step(s, inp):
        r_t, w_t, k_t, v_t, kk_t, a_t = inp
        s_kk = jnp.einsum("bhvk,bhk->bhv", s, -kk_t)
        s = (s * w_t[:, :, None, :]
             + jnp.einsum("bhv,bhk->bhvk", s_kk, kk_t * a_t)
             + jnp.einsum("bhv,bhk->bhvk", v_t, k_t))
        return s, jnp.einsum("bhvk,bhk->bhv", s, r_t)
    xs = tuple(jnp.moveaxis(t, 1, 0) for t in (r, w, k, v, kk, a))
    s_fin, ys = lax.scan(step, s0, xs)
    return jnp.moveaxis(ys, 0, 1), s_fin


def rwkv_mixer(p_c, p_l, mu, w0, w_up, a0, a_up, k_k, k_a, r_k, g_up, ln_g, ln_b, want_ctx):
    f32 = jnp.float32

    def heads(t):
        return t.reshape(t.shape[0], t.shape[1], RW_HEADS, RW_HD)

    def streams(p):
        p = centred_token_shift(p, mu[0], mu[1]).astype(f32)
        return jnp.split(p, _split_points(RW_SIZES), axis=-1)

    def scan_inputs(s, d):
        r, k, v, wl, al, _ = s
        w = jnp.exp(-RW_DECAY_SCALE * jax.nn.sigmoid(w0[d] + jnp.tanh(wl) @ w_up[d]))
        a = jax.nn.sigmoid(a0[d] + al @ a_up[d])
        kk = l2_normalize(heads(k * k_k))
        k_mod = k * (1.0 + (a - 1.0) * k_a)
        out = (heads(r), heads(w), heads(k_mod), heads(v), kk, heads(a))
        return tuple(_oriented(t, d) for t in out)

    s_c, s_l = streams(p_c), streams(p_l)
    b = p_l.shape[0]
    y_c, y_l = 0.0, 0.0
    for d in range(2):
        s0 = jnp.zeros((b, RW_HEADS, RW_HD, RW_HD), f32)
        yc_d, s_ctx = rwkv_scan(*scan_inputs(s_c, d), s0)
        yl_d, _ = rwkv_scan(*scan_inputs(s_l, d), s_ctx)
        y_c = y_c + _oriented(yc_d, d)
        y_l = y_l + _oriented(yl_d, d)

    def post(y, s, dtype):
        r, k, v, _, _, gl = s
        mean = jnp.mean(y, axis=-1, keepdims=True)
        var = jnp.mean(jnp.square(y - mean), axis=-1, keepdims=True)
        yn = ((y - mean) * lax.rsqrt(var + RW_GN_EPS)).reshape(r.shape) * ln_g + ln_b
        bonus = (jnp.sum(heads(r) * heads(k) * r_k, axis=-1, keepdims=True) * heads(v)).reshape(r.shape)
        g = jax.nn.sigmoid(gl) @ g_up
        return ((yn + bonus) * g).astype(dtype)

    out_l = post(y_l, s_l, p_l.dtype)
    out_c = post(y_c, s_c, p_c.dtype) if want_ctx else None
    return out_c, out_l


def gated_delta_chunked(q, k, v, log_a, beta, s0):
    b, l, h, n = q.shape
    nc, cs = l // DN_CHUNK, DN_CHUNK

    def chunk(t):
        return jnp.moveaxis(t.reshape((b, nc, cs) + t.shape[2:]), 2, 3)

    q = chunk(q) * (n ** -0.5)
    k = chunk(k)
    v = chunk(v)
    g = jnp.cumsum(chunk(log_a), axis=-1)
    bt = chunk(beta)
    pos = jnp.arange(cs)
    incl = pos[:, None] >= pos[None, :]
    strict = pos[:, None] > pos[None, :]
    decay = jnp.exp(jnp.where(incl, g[..., :, None] - g[..., None, :], -jnp.inf))
    kb = k * bt[..., None]
    a_low = jnp.where(strict, jnp.einsum("bnhik,bnhjk->bnhij", kb, k) * decay, 0.0)
    m = a_low + jnp.eye(cs, dtype=q.dtype)
    rhs = jnp.concatenate([v * bt[..., None], kb * jnp.exp(g)[..., None]], axis=-1)
    sol = lax.linalg.triangular_solve(m, rhs, left_side=True, lower=True, unit_diagonal=True)
    u_val, w_dec = sol[..., :n], sol[..., n:]
    attn = jnp.einsum("bnhik,bnhjk->bnhij", q, k) * decay
    q_dec = q * jnp.exp(g)[..., None]
    k_tail = k * jnp.exp(g[..., -1:] - g)[..., None]
    g_tot = jnp.exp(g[..., -1])

    def step(s, inp):
        u_c, w_c, attn_c, qd_c, kt_c, gt_c = inp
        v_new = u_c - jnp.einsum("bhck,bhkv->bhcv", w_c, s)
        o = jnp.einsum("bhck,bhkv->bhcv", qd_c, s) + jnp.einsum("bhij,bhjv->bhiv", attn_c, v_new)
        s = s * gt_c[..., None, None] + jnp.einsum("bhck,bhcv->bhkv", kt_c, v_new)
        return s, o

    xs = tuple(jnp.moveaxis(t, 1, 0) for t in (u_val, w_dec, attn, q_dec, k_tail, g_tot))
    s_fin, o = lax.scan(step, s0, xs)
    o = jnp.moveaxis(jnp.moveaxis(o, 0, 1), 3, 2).reshape(b, l, h, n)
    return o, s_fin


def deltanet_mixer(qkv_c, qkv_l, gate_c, gate_l, al_c, al_l, be_c, be_l, conv_w, a_log, dt_bias, norm_g, want_ctx):
    f32 = jnp.float32

    def prep(qkv, al, be):
        b, l, _ = qkv.shape
        u = jax.nn.silu(centred_depthwise_conv(qkv, conv_w)).astype(f32).reshape(b, l, 3, DN_HEADS, DN_HD)
        q, k, v = l2_normalize(u[:, :, 0]), l2_normalize(u[:, :, 1]), u[:, :, 2]
        al = al.astype(f32).reshape(b, l, 2, DN_HEADS)
        be = be.astype(f32).reshape(b, l, 2, DN_HEADS)
        log_a = -jnp.exp(a_log) * jax.nn.softplus(al + dt_bias)
        return q, k, v, log_a, jax.nn.sigmoid(be)

    def dir_inputs(p, d):
        q, k, v, la, bt = p
        return tuple(_oriented(t, d) for t in (q, k, v, la[:, :, d], bt[:, :, d]))

    p_c, p_l = prep(qkv_c, al_c, be_c), prep(qkv_l, al_l, be_l)
    b = qkv_l.shape[0]
    o_c, o_l = 0.0, 0.0
    for d in range(2):
        s0 = jnp.zeros((b, DN_HEADS, DN_HD, DN_HD), f32)
        oc_d, s_ctx = gated_delta_chunked(*dir_inputs(p_c, d), s0)
        ol_d, _ = gated_delta_chunked(*dir_inputs(p_l, d), s_ctx)
        o_c = o_c + _oriented(oc_d, d)
        o_l = o_l + _oriented(ol_d, d)

    def post(o, gate):
        b_, l_ = o.shape[:2]
        on = o * lax.rsqrt(jnp.mean(o * o, axis=-1, keepdims=True) + EPS) * norm_g
        return (on.reshape(b_, l_, BRANCH_W) * jax.nn.silu(gate.astype(f32))).astype(gate.dtype)

    out_l = post(o_l, gate_l)
    out_c = post(o_c, gate_c) if want_ctx else None
    return out_c, out_l


def s5_scan(u, lam_bar, b_bar, c_mat, s0):
    bu = jnp.einsum("gph,blgh->blgp", b_bar, u.astype(jnp.complex64))
    bu = bu.at[:, 0].add(lam_bar * s0)
    a = jnp.broadcast_to(lam_bar, bu.shape)

    def combine(e1, e2):
        a1, b1 = e1
        a2, b2 = e2
        return a1 * a2, a2 * b1 + b2

    _, states = lax.associative_scan(combine, (a, bu), axis=1)
    y = jnp.real(jnp.einsum("ghp,blgp->blgh", c_mat, states))
    return y, states[:, -1]


def s5_mixer(u_c, u_l, rows, lam_re, lam_im, log_step, b_re, b_im, c_re, c_im, d_skip, w_glu, b_glu, want_ctx):
    f32 = jnp.float32

    def groups(u):
        return u.astype(f32).reshape(u.shape[0], u.shape[1], S5_GROUPS, S5_GW)

    uc = groups(u_c)
    ul = groups(raster_to_columns(u_l, rows))
    dg = d_skip.astype(f32).reshape(S5_GROUPS, S5_GW)
    y_c, y_l = uc * dg, ul * dg
    b = u_l.shape[0]
    for d in range(2):
        lam = lax.complex(lam_re[d].astype(f32), lam_im[d].astype(f32))
        lam_bar = jnp.exp(lam * jnp.exp(log_step[d].astype(f32))[:, None])
        b_bar = ((lam_bar - 1.0) / lam)[..., None] * lax.complex(b_re[d].astype(f32), b_im[d].astype(f32))
        c_mat = lax.complex(c_re[d].astype(f32), c_im[d].astype(f32))
        s0 = jnp.zeros((b, S5_GROUPS, S5_STATE), jnp.complex64)
        yc_d, s_ctx = s5_scan(_oriented(uc, d), lam_bar, b_bar, c_mat, s0)
        yl_d, _ = s5_scan(_oriented(ul, d), lam_bar, b_bar, c_mat, s_ctx)
        y_c = y_c + _oriented(yc_d, d)
        y_l = y_l + _oriented(yl_d, d)

    def glu(y):
        z = jax.nn.gelu(y.reshape(y.shape[0], y.shape[1], BRANCH_W))
        return z * jax.nn.sigmoid(z @ w_glu.astype(f32) + b_glu.astype(f32))

    out_l = columns_to_raster(glu(y_l), rows).astype(u_l.dtype)
    out_c = glu(y_c).astype(u_c.dtype) if want_ctx else None
    return out_c, out_l


def merge_branches(ys, gates, w_branch, w_out):
    g = gates.reshape(gates.shape[:-1] + (N_BRANCH, D_MODEL))
    m = 0.0
    for i, y in enumerate(ys):
        m = m + jax.nn.sigmoid(g[..., i, :]) * (y @ w_branch[i])
    return m @ w_out


def moe_ffn(h, router_w, router_b, w1, w3, w2):
    f32 = jnp.float32
    scores = jax.nn.sigmoid(h.astype(f32) @ router_w.astype(f32))
    sel = (scores + router_b.astype(f32)).reshape(scores.shape[:-1] + (N_EXPERT_GROUPS, EXPERTS_PER_GROUP))
    group_score = jnp.sum(lax.top_k(sel, TOP_K)[0], axis=-1)
    best = jnp.argmax(group_score, axis=-1)
    in_group = (best[..., None] == jnp.arange(N_EXPERT_GROUPS))[..., None]
    masked = jnp.where(in_group, sel, -jnp.inf).reshape(scores.shape)
    _, idx = lax.top_k(masked, TOP_K)
    w_sel = jnp.take_along_axis(scores, idx, axis=-1)
    w_sel = w_sel / jnp.sum(w_sel, axis=-1, keepdims=True)
    combine = jnp.sum(jax.nn.one_hot(idx, N_EXPERTS, dtype=f32) * w_sel[..., None], axis=-2)
    y = jnp.zeros(h.shape, f32)
    for e in range(N_EXPERTS):
        act = jax.nn.silu(h @ w1[e]) * (h @ w3[e])
        y = y + combine[..., e:e + 1] * (act @ w2[e])
    return y.astype(h.dtype)


def trunk_layer(x, xc, c, c_ctx, rows, want_ctx, router_w, router_b, lp):
    mod = adaln(c, lp["w_mod"], lp["b_mod"])
    mod_c = adaln(c_ctx, lp["w_mod"], lp["b_mod"])
    splits = _split_points(IN_SIZES)
    h = rms_norm(x, lp["norm1_g"]) * (1.0 + mod[1]) + mod[0]
    hc = rms_norm(xc, lp["norm1_g"]) * (1.0 + mod_c[1]) + mod_c[0]
    fn_l, rw_l, dqkv_l, dg_l, dal_l, dbe_l, s5_l, gate_l = jnp.split(h @ lp["w_in"], splits, axis=-1)
    fn_c, rw_c, dqkv_c, dg_c, dal_c, dbe_c, s5_c, gate_c = jnp.split(hc @ lp["w_in"], splits, axis=-1)

    ya_l = fourier_mix(fn_l)
    ya_c = fourier_mix(fn_c) if want_ctx else None
    yb_c, yb_l = rwkv_mixer(rw_c, rw_l, lp["rw_mu"], lp["rw_w0"], lp["rw_w_up"], lp["rw_a0"], lp["rw_a_up"],
                            lp["rw_k_k"], lp["rw_k_a"], lp["rw_r_k"], lp["rw_g_up"], lp["rw_ln_g"], lp["rw_ln_b"],
                            want_ctx)
    yc_c, yc_l = deltanet_mixer(dqkv_c, dqkv_l, dg_c, dg_l, dal_c, dal_l, dbe_c, dbe_l, lp["dn_conv"],
                                lp["dn_a_log"], lp["dn_dt_bias"], lp["dn_norm_g"], want_ctx)
    yd_c, yd_l = s5_mixer(s5_c, s5_l, rows, lp["s5_lam_re"], lp["s5_lam_im"], lp["s5_log_step"],
                          lp["s5_b_re"], lp["s5_b_im"], lp["s5_c_re"], lp["s5_c_im"], lp["s5_d"],
                          lp["s5_w_glu"], lp["s5_b_glu"], want_ctx)

    x = x + mod[2] * merge_branches((ya_l, yb_l, yc_l, yd_l), gate_l, lp["w_branch"], lp["w_out"])
    h2 = rms_norm(x, lp["norm2_g"]) * (1.0 + mod[4]) + mod[3]
    x = x + mod[5] * moe_ffn(h2, router_w, router_b, lp["moe_w1"], lp["moe_w3"], lp["moe_w2"])
    if want_ctx:
        xc = xc + mod_c[2] * merge_branches((ya_c, yb_c, yc_c, yd_c), gate_c, lp["w_branch"], lp["w_out"])
        h2c = rms_norm(xc, lp["norm2_g"]) * (1.0 + mod_c[4]) + mod_c[3]
        xc = xc + mod_c[5] * moe_ffn(h2c, router_w, router_b, lp["moe_w1"], lp["moe_w3"], lp["moe_w2"])
    return x, xc


def setup_inputs(seed: int = 0) -> dict:
    key = jax.random.key(seed)
    keys = iter(jax.random.split(key, 64))
    f32 = jnp.float32

    def nrm(shape, scale):
        return jax.random.normal(next(keys), shape, f32) * scale

    def uni(shape, lo, hi):
        return jax.random.uniform(next(keys), shape, f32, lo, hi)

    nl, d = DEPTH, D_MODEL
    dt = jnp.exp(uni((nl, 2, DN_HEADS), math.log(1e-3), math.log(1e-1)))
    n_idx = jnp.arange(S5_STATE, dtype=f32)
    return {
        "x": nrm((BATCH, SEQ, d), 1.0),
        "c": nrm((BATCH, d), 1.0),
        "ctx": nrm((BATCH, CTX_LEN, d), 1.0),
        "c_ctx": nrm((d,), 1.0),
        "w_mod": nrm((nl, d, N_MOD * d), 0.5 * d ** -0.5),
        "b_mod": nrm((nl, N_MOD * d), 0.02),
        "norm1_g": 1.0 + nrm((nl, d), 0.02),
        "norm2_g": 1.0 + nrm((nl, d), 0.02),
        "w_in": nrm((nl, d, N_IN), d ** -0.5),
        "rw_mu": uni((nl, 2, RW_COLS), 0.0, 0.5),
        "rw_w0": uni((nl, 2, BRANCH_W), -5.0, -0.5),
        "rw_w_up": nrm((nl, 2, RW_DECAY_RANK, BRANCH_W), 0.1),
        "rw_a0": nrm((nl, 2, BRANCH_W), 0.1),
        "rw_a_up": nrm((nl, 2, RW_ICL_RANK, BRANCH_W), 0.1),
        "rw_k_k": 0.85 + nrm((nl, BRANCH_W), 0.02),
        "rw_k_a": 1.0 + nrm((nl, BRANCH_W), 0.02),
        "rw_r_k": nrm((nl, RW_HEADS, RW_HD), 0.1),
        "rw_g_up": nrm((nl, RW_GATE_RANK, BRANCH_W), RW_GATE_RANK ** -0.5),
        "rw_ln_g": 1.0 + nrm((nl, BRANCH_W), 0.02),
        "rw_ln_b": nrm((nl, BRANCH_W), 0.02),
        "dn_conv": nrm((nl, DN_CONV, 3 * BRANCH_W), DN_CONV ** -0.5),
        "dn_a_log": jnp.log(uni((nl, 2, DN_HEADS), 1.0, 16.0)),
        "dn_dt_bias": dt + jnp.log(-jnp.expm1(-dt)),
        "dn_norm_g": 1.0 + nrm((nl, DN_HD), 0.02),
        "s5_lam_re": -0.5 + nrm((nl, 2, S5_GROUPS, S5_STATE), 0.01),
        "s5_lam_im": math.pi * n_idx + nrm((nl, 2, S5_GROUPS, S5_STATE), 0.01),
        "s5_log_step": uni((nl, 2, S5_GROUPS), math.log(1e-3), math.log(1e-1)),
        "s5_b_re": nrm((nl, 2, S5_GROUPS, S5_STATE, S5_GW), (2 * S5_GW) ** -0.5),
        "s5_b_im": nrm((nl, 2, S5_GROUPS, S5_STATE, S5_GW), (2 * S5_GW) ** -0.5),
        "s5_c_re": nrm((nl, 2, S5_GROUPS, S5_GW, S5_STATE), (2 * S5_STATE) ** -0.5),
        "s5_c_im": nrm((nl, 2, S5_GROUPS, S5_GW, S5_STATE), (2 * S5_STATE) ** -0.5),
        "s5_d": nrm((nl, BRANCH_W), 1.0),
        "s5_w_glu": nrm((nl, BRANCH_W, BRANCH_W), BRANCH_W ** -0.5),
        "s5_b_glu": nrm((nl, BRANCH_W), 0.02),
        "w_branch": nrm((nl, N_BRANCH, BRANCH_W, d), BRANCH_W ** -0.5),
        "w_out": nrm((nl, d, d), d ** -0.5),
        "router_w": nrm((d, N_EXPERTS), d ** -0.5),
        "router_b": nrm((N_EXPERTS,), 0.01),
        "moe_w1": nrm((nl, N_EXPERTS, d, D_EXPERT), d ** -0.5),
        "moe_w3": nrm((nl, N_EXPERTS, d, D_EXPERT), d ** -0.5),
        "moe_w2": nrm((nl, N_EXPERTS, D_EXPERT, d), D_EXPERT ** -0.5),
        "final_g": 1.0 + nrm((d,), 0.02),
    }


def reference(x, c, ctx, c_ctx, w_mod, b_mod, norm1_g, norm2_g, w_in, rw_mu, rw_w0, rw_w_up, rw_a0, rw_a_up,
              rw_k_k, rw_k_a, rw_r_k, rw_g_up, rw_ln_g, rw_ln_b, dn_conv, dn_a_log, dn_dt_bias, dn_norm_g,
              s5_lam_re, s5_lam_im, s5_log_step, s5_b_re, s5_b_im, s5_c_re, s5_c_im, s5_d, s5_w_glu, s5_b_glu,
              w_branch, w_out, router_w, router_b, moe_w1, moe_w3, moe_w2, final_g):
    rows = x.shape[1] // GRID_W
    xc = ctx
    for i in range(DEPTH):
        lp = {
            "w_mod": w_mod[i], "b_mod": b_mod[i], "norm1_g": norm1_g[i], "norm2_g": norm2_g[i],
            "w_in": w_in[i], "rw_mu": rw_mu[i], "rw_w0": rw_w0[i], "rw_w_up": rw_w_up[i],
            "rw_a0": rw_a0[i], "rw_a_up": rw_a_up[i], "rw_k_k": rw_k_k[i], "rw_k_a": rw_k_a[i],
            "rw_r_k": rw_r_k[i], "rw_g_up": rw_g_up[i], "rw_ln_g": rw_ln_g[i], "rw_ln_b": rw_ln_b[i],
            "dn_conv": dn_conv[i], "dn_a_log": dn_a_log[i], "dn_dt_bias": dn_dt_bias[i],
            "dn_norm_g": dn_norm_g[i], "s5_lam_re": s5_lam_re[i], "s5_lam_im": s5_lam_im[i],
            "s5_log_step": s5_log_step[i], "s5_b_re": s5_b_re[i], "s5_b_im": s5_b_im[i],
            "s5_c_re": s5_c_re[i], "s5_c_im": s5_c_im[i], "s5_d": s5_d[i], "s5_w_glu": s5_w_glu[i],
            "s5_b_glu": s5_b_glu[i], "w_branch": w_branch[i], "w_out": w_out[i],
            "moe_w1": moe_w1[i], "moe_w3": moe_w3[i], "moe_w2": moe_w2[i],
        }
        x, xc = trunk_layer(x, xc, c, c_ctx, rows, i < DEPTH - 1, router_w, router_b, lp)
    return rms_norm(x, final_g)
```

```cpp
#include <hip/hip_runtime.h>
#include <stdio.h>
#include <stdint.h>

#ifndef MK_SINGLE
#define MK_SINGLE 0
#endif

namespace {

typedef unsigned short bf16_t;
typedef short bf16x8 __attribute__((ext_vector_type(8)));
typedef float f32x4 __attribute__((ext_vector_type(4)));

constexpr int D = 1024, NB = 8, L = 4096, LC = 256;
constexpr int RL = NB * L, RC = NB * LC, RT = RL + RC;
constexpr int NP = 2816;
constexpr int NIN = 6544;
constexpr int NTHR = 512;
constexpr int NSLOT = 71680;
constexpr int LDS_BYTES = 131072;
constexpr int PC_FC = 0, PC_FS = 256, PC_RW = 512, PC_DQKV = 1408, PC_DG = 2176, PC_DAL = 2432, PC_DBE = 2440, PC_S5 = 2448;

constexpr size_t al256(size_t x) { return (x + 255) & ~(size_t)255; }
constexpr size_t WS_CTL = 0;
constexpr size_t CTL_BYTES = 65536;
constexpr size_t WS_MOD = WS_CTL + CTL_BYTES;
constexpr size_t WS_LAMB = al256(WS_MOD + 2 * 9 * 6144 * 4);
constexpr size_t WS_BBAR = al256(WS_LAMB + 2 * 2 * 16 * 64 * 8);
constexpr size_t WS_TOK = al256(WS_BBAR + 2 * 2 * 16 * 64 * 16 * 8);
constexpr size_t WS_SLOT = al256(WS_TOK + (size_t)RT * 16);
constexpr size_t WS_XC = al256(WS_SLOT + (size_t)RT * 8);
constexpr size_t WS_WINT = al256(WS_XC + (size_t)RC * D * 4);
constexpr size_t WS_WGT = al256(WS_WINT + (size_t)NP * 1024 * 2);
constexpr size_t WS_WBT = al256(WS_WGT + (size_t)4096 * 1024 * 2);
constexpr size_t WS_WOT = al256(WS_WBT + (size_t)4 * 1024 * 256 * 2);
constexpr size_t WS_W13T = al256(WS_WOT + (size_t)1024 * 1024 * 2);
constexpr size_t WS_W2T = al256(WS_W13T + (size_t)16 * 512 * 1024 * 2);
constexpr size_t WS_WGLUT = al256(WS_W2T + (size_t)16 * 1024 * 256 * 2);
constexpr size_t WS_H = al256(WS_WGLUT + (size_t)256 * 256 * 2);
constexpr size_t WS_PM = al256(WS_H + (size_t)RT * D * 2);
constexpr size_t WS_Y = al256(WS_PM + (size_t)RT * NP * 2);
constexpr size_t WS_YS = al256(WS_Y + (size_t)RT * D * 2);
constexpr size_t WS_END = al256(WS_YS + (size_t)6 * RT * 256 * 2);
constexpr size_t WS_MM = WS_PM;
constexpr size_t WS_XS = WS_PM;
constexpr size_t WS_ACT = WS_PM + (size_t)NSLOT * D * 2;
constexpr size_t WS_YE = WS_Y;
static_assert(WS_ACT + (size_t)NSLOT * 256 * 2 <= WS_Y, "moe alias");
static_assert(WS_YE + (size_t)NSLOT * D * 2 <= WS_END, "moe alias 2");

constexpr int CW_BAR = 0;
constexpr int CW_CNT = 4096;

#define XB_TMO      128
#define XB_XCNT(j)  (256  + 64 * (j))
#define XB_XSUB(j)  (1280 + 64 * (j))
#define XB_XGEN(j)  (2304 + 64 * (j))
#define XB_TOP      3328
#define XB_TOPGEN   3392
#define XCD_BAR_WORDS 3456
#define XB_SPIN_CAP (1u << 18)
#define LAS __attribute__((address_space(3)))

__device__ __forceinline__ unsigned xb_ld(unsigned* p)              { return __hip_atomic_load(p, __ATOMIC_RELAXED, __HIP_MEMORY_SCOPE_AGENT); }
__device__ __forceinline__ unsigned xb_add(unsigned* p, unsigned v) { return __hip_atomic_fetch_add(p, v, __ATOMIC_RELAXED, __HIP_MEMORY_SCOPE_AGENT); }
__device__ __forceinline__ unsigned xb_xcc_id() { return (unsigned)__builtin_amdgcn_s_getreg((3 << 11) | 20) & 0xFu; }
#define XB_SPIN(cond, bar) do { unsigned _sp = 0; while (cond) { __builtin_amdgcn_s_sleep(1); \
    if ((++_sp & 255u) == 0u) { if (xb_ld(&(bar)[XB_TMO])) break; if (_sp > XB_SPIN_CAP) { atomicAdd(&(bar)[XB_TMO], 1u); break; } } } } while (0)

struct XcdBarrier { unsigned* bar; unsigned x; volatile LAS unsigned* st; };

__device__ __forceinline__ XcdBarrier xcd_barrier_post(unsigned* bar, volatile LAS unsigned* st) {
    XcdBarrier b; b.bar = bar; b.x = xb_xcc_id(); b.st = st;
    if (threadIdx.x == 0) (void)xb_add(&bar[XB_XCNT(b.x)], 1u);
    return b;
}
__device__ __forceinline__ void xcd_barrier_complete(unsigned* bar, unsigned x, unsigned& nloc, unsigned& nx) {
    const unsigned G = gridDim.x * gridDim.y * gridDim.z;
    unsigned sum, cnt, mine, sp = 0u;
    for (;;) {
        sum = 0u; cnt = 0u; mine = 0u;
#pragma unroll
        for (unsigned j = 0; j < 16; ++j) { const unsigned c = xb_ld(&bar[XB_XCNT(j)]); sum += c; cnt += (c > 0u) ? 1u : 0u; mine = (j == x) ? c : mine; }
        if (sum == G) break;
        __builtin_amdgcn_s_sleep(1);
        if ((++sp & 255u) == 0u) { if (xb_ld(&bar[XB_TMO])) break; if (sp > XB_SPIN_CAP) { atomicAdd(&bar[XB_TMO], 1u); break; } }
    }
    nloc = mine > 0u ? mine : 1u; nx = cnt > 0u ? cnt : 1u;
}
__device__ __forceinline__ void xcd_barrier(const XcdBarrier& b) {
    asm volatile("s_waitcnt vmcnt(0)" ::: "memory");
    __syncthreads();
    if (threadIdx.x == 0) {
        unsigned* bar = b.bar;
        __builtin_amdgcn_s_waitcnt(0);
        unsigned nloc = b.st[0], nx = b.st[1];
        if (nloc == 0u) { xcd_barrier_complete(bar, b.x, nloc, nx); b.st[0] = nloc; b.st[1] = nx; }
        const unsigned old = xb_add(&bar[XB_XSUB(b.x)], 1u);
        const unsigned gen = old / nloc;
        if (old + 1u == (gen + 1u) * nloc) {
            __builtin_amdgcn_fence(__ATOMIC_RELEASE, "agent");
            asm volatile("s_waitcnt vmcnt(0)" ::: "memory");
            const unsigned og = xb_add(&bar[XB_TOP], 1u);
            const unsigned tg = og / nx;
            if (og + 1u == (tg + 1u) * nx) xb_add(&bar[XB_TOPGEN], 1u);
            else XB_SPIN(xb_ld(&bar[XB_TOPGEN]) == tg, bar);
            __builtin_amdgcn_fence(__ATOMIC_ACQUIRE, "agent");
            xb_add(&bar[XB_XGEN(b.x)], 1u);
            asm volatile("s_waitcnt vmcnt(0)" ::: "memory");
        } else {
            XB_SPIN(xb_ld(&bar[XB_XGEN(b.x)]) == gen, bar);
            __builtin_amdgcn_fence(__ATOMIC_ACQUIRE, "agent");
            asm volatile("s_waitcnt vmcnt(0)" ::: "memory");
        }
    }
    __syncthreads();
}

__device__ __forceinline__ bf16_t f2bf(float f) { unsigned u = __float_as_uint(f); u += 0x7FFFu + ((u >> 16) & 1u); return (bf16_t)(u >> 16); }
__device__ __forceinline__ float bf2f(bf16_t b) { return __uint_as_float(((unsigned)b) << 16); }
__device__ __forceinline__ unsigned pack2(float a, float b) { return (unsigned)f2bf(a) | ((unsigned)f2bf(b) << 16); }
__device__ __forceinline__ float lo2f(unsigned u) { return __uint_as_float(u << 16); }
__device__ __forceinline__ float hi2f(unsigned u) { return __uint_as_float(u & 0xFFFF0000u); }
__device__ __forceinline__ float sigm(float x) { return 1.f / (1.f + __expf(-x)); }
__device__ __forceinline__ float silu_(float x) { return x * sigm(x); }
__device__ __forceinline__ float softplus_(float x) { return x > 20.f ? x : log1pf(__expf(x)); }
__device__ __forceinline__ float gelu_tanh(float x) { const float u = 0.7978845608f * (x + 0.044715f * x * x * x); return 0.5f * x * (1.f + tanhf(u)); }

struct Args { const float* in[42]; float* out; unsigned char* ws; int ph_lo, ph_hi; };
struct P {
    const Args& a; int bid, nblk, tid, lane, wid;
    __device__ __forceinline__ P(const Args& a_) : a(a_) {}
    __device__ __forceinline__ const float* x() const { return a.in[0]; }
    __device__ __forceinline__ const float* c() const { return a.in[1]; }
    __device__ __forceinline__ const float* ctx() const { return a.in[2]; }
    __device__ __forceinline__ const float* c_ctx() const { return a.in[3]; }
    __device__ __forceinline__ const float* w_mod() const { return a.in[4]; }
    __device__ __forceinline__ const float* b_mod() const { return a.in[5]; }
    __device__ __forceinline__ const float* norm1_g() const { return a.in[6]; }
    __device__ __forceinline__ const float* norm2_g() const { return a.in[7]; }
    __device__ __forceinline__ const float* w_in() const { return a.in[8]; }
    __device__ __forceinline__ const float* rw_mu() const { return a.in[9]; }
    __device__ __forceinline__ const float* rw_w0() const { return a.in[10]; }
    __device__ __forceinline__ const float* rw_w_up() const { return a.in[11]; }
    __device__ __forceinline__ const float* rw_a0() const { return a.in[12]; }
    __device__ __forceinline__ const float* rw_a_up() const { return a.in[13]; }
    __device__ __forceinline__ const float* rw_k_k() const { return a.in[14]; }
    __device__ __forceinline__ const float* rw_k_a() const { return a.in[15]; }
    __device__ __forceinline__ const float* rw_r_k() const { return a.in[16]; }
    __device__ __forceinline__ const float* rw_g_up() const { return a.in[17]; }
    __device__ __forceinline__ const float* rw_ln_g() const { return a.in[18]; }
    __device__ __forceinline__ const float* rw_ln_b() const { return a.in[19]; }
    __device__ __forceinline__ const float* dn_conv() const { return a.in[20]; }
    __device__ __forceinline__ const float* dn_a_log() const { return a.in[21]; }
    __device__ __forceinline__ const float* dn_dt_bias() const { return a.in[22]; }
    __device__ __forceinline__ const float* dn_norm_g() const { return a.in[23]; }
    __device__ __forceinline__ const float* s5_lam_re() const { return a.in[24]; }
    __device__ __forceinline__ const float* s5_lam_im() const { return a.in[25]; }
    __device__ __forceinline__ const float* s5_log_step() const { return a.in[26]; }
    __device__ __forceinline__ const float* s5_b_re() const { return a.in[27]; }
    __device__ __forceinline__ const float* s5_b_im() const { return a.in[28]; }
    __device__ __forceinline__ const float* s5_c_re() const { return a.in[29]; }
    __device__ __forceinline__ const float* s5_c_im() const { return a.in[30]; }
    __device__ __forceinline__ const float* s5_d() const { return a.in[31]; }
    __device__ __forceinline__ const float* s5_w_glu() const { return a.in[32]; }
    __device__ __forceinline__ const float* s5_b_glu() const { return a.in[33]; }
    __device__ __forceinline__ const float* w_branch() const { return a.in[34]; }
    __device__ __forceinline__ const float* w_out() const { return a.in[35]; }
    __device__ __forceinline__ const float* router_w() const { return a.in[36]; }
    __device__ __forceinline__ const float* router_b() const { return a.in[37]; }
    __device__ __forceinline__ const float* moe_w1() const { return a.in[38]; }
    __device__ __forceinline__ const float* moe_w3() const { return a.in[39]; }
    __device__ __forceinline__ const float* moe_w2() const { return a.in[40]; }
    __device__ __forceinline__ const float* final_g() const { return a.in[41]; }
    __device__ __forceinline__ float* out() const { return a.out; }
    __device__ __forceinline__ unsigned* ctl() const { return (unsigned*)(a.ws + WS_CTL); }
    __device__ __forceinline__ float* MOD() const { return (float*)(a.ws + WS_MOD); }
    __device__ __forceinline__ float2* LAMB() const { return (float2*)(a.ws + WS_LAMB); }
    __device__ __forceinline__ float2* BBAR() const { return (float2*)(a.ws + WS_BBAR); }
    __device__ __forceinline__ int4* TOK() const { return (int4*)(a.ws + WS_TOK); }
    __device__ __forceinline__ int2* SLOT() const { return (int2*)(a.ws + WS_SLOT); }
    __device__ __forceinline__ float* XC() const { return (float*)(a.ws + WS_XC); }
    __device__ __forceinline__ bf16_t* WINT() const { return (bf16_t*)(a.ws + WS_WINT); }
    __device__ __forceinline__ bf16_t* WGT() const { return (bf16_t*)(a.ws + WS_WGT); }
    __device__ __forceinline__ bf16_t* WBT() const { return (bf16_t*)(a.ws + WS_WBT); }
    __device__ __forceinline__ bf16_t* WOT() const { return (bf16_t*)(a.ws + WS_WOT); }
    __device__ __forceinline__ bf16_t* W13T() const { return (bf16_t*)(a.ws + WS_W13T); }
    __device__ __forceinline__ bf16_t* W2T() const { return (bf16_t*)(a.ws + WS_W2T); }
    __device__ __forceinline__ bf16_t* WGLUT() const { return (bf16_t*)(a.ws + WS_WGLUT); }
    __device__ __forceinline__ bf16_t* H() const { return (bf16_t*)(a.ws + WS_H); }
    __device__ __forceinline__ bf16_t* PM() const { return (bf16_t*)(a.ws + WS_PM); }
    __device__ __forceinline__ bf16_t* Y() const { return (bf16_t*)(a.ws + WS_Y); }
    __device__ __forceinline__ bf16_t* YS() const { return (bf16_t*)(a.ws + WS_YS); }
    __device__ __forceinline__ bf16_t* MM() const { return (bf16_t*)(a.ws + WS_MM); }
    __device__ __forceinline__ bf16_t* XS() const { return (bf16_t*)(a.ws + WS_XS); }
    __device__ __forceinline__ bf16_t* ACT() const { return (bf16_t*)(a.ws + WS_ACT); }
    __device__ __forceinline__ bf16_t* YE() const { return (bf16_t*)(a.ws + WS_YE); }
};

__device__ __forceinline__ float* xrow(const P& p, int r) { return r < RL ? p.out() + (size_t)r * D : p.XC() + (size_t)(r - RL) * D; }
__device__ __forceinline__ int modrow(int r) { return r < RL ? (r >> 12) : 8; }

constexpr int LDT = 72;
__device__ __forceinline__ void gemm_128x128(const bf16_t* __restrict__ A, long lda, const bf16_t* __restrict__ Bt, long ldb, int K,
                                             f32x4 (&acc)[4][2], bf16_t* sA, bf16_t* sB) {
    const int tid = threadIdx.x, lane = tid & 63, wid = tid >> 6, wr = wid >> 2, wc = wid & 3, fr = lane & 15, fq = lane >> 4;
    const int r0 = tid >> 3, kc = (tid & 7) * 8;
    const bf16_t* ga0 = A + (long)r0 * lda + kc; const bf16_t* ga1 = A + (long)(r0 + 64) * lda + kc;
    const bf16_t* gb0 = Bt + (long)r0 * ldb + kc; const bf16_t* gb1 = Bt + (long)(r0 + 64) * ldb + kc;
    uint4 ra0 = *(const uint4*)ga0, ra1 = *(const uint4*)ga1, rb0 = *(const uint4*)gb0, rb1 = *(const uint4*)gb1;
    __syncthreads();
    for (int k0 = 0; k0 < K; k0 += 64) {
        *(uint4*)(sA + r0 * LDT + kc) = ra0; *(uint4*)(sA + (r0 + 64) * LDT + kc) = ra1;
        *(uint4*)(sB + r0 * LDT + kc) = rb0; *(uint4*)(sB + (r0 + 64) * LDT + kc) = rb1;
        __syncthreads();
        if (k0 + 64 < K) { ra0 = *(const uint4*)(ga0 + k0 + 64); ra1 = *(const uint4*)(ga1 + k0 + 64); rb0 = *(const uint4*)(gb0 + k0 + 64); rb1 = *(const uint4*)(gb1 + k0 + 64); }
#pragma unroll
        for (int ks = 0; ks < 2; ++ks) {
            bf16x8 af[4], bfg[2];
#pragma unroll
            for (int mi = 0; mi < 4; ++mi) af[mi] = *(const bf16x8*)(sA + (wr * 64 + mi * 16 + fr) * LDT + ks * 32 + fq * 8);
#pragma unroll
            for (int ni = 0; ni < 2; ++ni) bfg[ni] = *(const bf16x8*)(sB + (wc * 32 + ni * 16 + fr) * LDT + ks * 32 + fq * 8);
#pragma unroll
            for (int mi = 0; mi < 4; ++mi)
#pragma unroll
                for (int ni = 0; ni < 2; ++ni) acc[mi][ni] = __builtin_amdgcn_mfma_f32_16x16x32_bf16(bfg[ni], af[mi], acc[mi][ni], 0, 0, 0);
        }
        __syncthreads();
    }
}
__device__ __forceinline__ void zero_acc(f32x4 (&acc)[4][2]) {
#pragma unroll
    for (int mi = 0; mi < 4; ++mi)
#pragma unroll
        for (int ni = 0; ni < 2; ++ni) acc[mi][ni] = (f32x4){0.f, 0.f, 0.f, 0.f};
}
#define TILE_COORDS const int lane_ = threadIdx.x & 63, wid_ = threadIdx.x >> 6, wr_ = wid_ >> 2, wc_ = wid_ & 3, fr_ = lane_ & 15, fq_ = lane_ >> 4
#define TROW(tm, mi) ((tm) * 128 + wr_ * 64 + (mi) * 16 + fr_)
#define TCOL(tn, ni) ((tn) * 128 + wc_ * 32 + (ni) * 16 + fq_ * 4)

__device__ __forceinline__ void phase_prologue(const P& p, unsigned char* smem) {
    float* cs = (float*)smem;
    float* red = cs + 9 * 1024;
    for (int i = p.tid; i < 9 * 1024; i += NTHR) { const int r = i >> 10, k = i & 1023; const float v = r < 8 ? p.c()[r * 1024 + k] : p.c_ctx()[k]; cs[i] = silu_(v); }
    __syncthreads();
    for (int item = p.bid; item < 192; item += p.nblk) {
        const int layer = item / 96, cc = (item % 96) * 64, cl = p.tid & 63, kg = p.tid >> 6;
        const float* w = p.w_mod() + (size_t)layer * 1024 * 6144 + cc + cl;
        float acc[9];
#pragma unroll
        for (int r = 0; r < 9; ++r) acc[r] = 0.f;
        for (int k = kg * 128; k < kg * 128 + 128; ++k) { const float wv = w[(size_t)k * 6144];
#pragma unroll
            for (int r = 0; r < 9; ++r) acc[r] += cs[r * 1024 + k] * wv; }
#pragma unroll
        for (int r = 0; r < 9; ++r) red[(kg * 9 + r) * 64 + cl] = acc[r];
        __syncthreads();
        for (int o = p.tid; o < 576; o += NTHR) { const int r = o >> 6, c2 = o & 63; float s = p.b_mod()[layer * 6144 + cc + c2];
            for (int k2 = 0; k2 < 8; ++k2) s += red[(k2 * 9 + r) * 64 + c2];
            p.MOD()[(size_t)(layer * 9 + r) * 6144 + cc + c2] = s; }
        __syncthreads();
    }
    for (int i = p.bid * NTHR + p.tid; i < 4096; i += p.nblk * NTHR) {
        const int g = (i >> 6) & 15, d = (i >> 10) & 1, layer = i >> 11;
        const float lr = p.s5_lam_re()[i], li = p.s5_lam_im()[i], st = expf(p.s5_log_step()[(layer * 2 + d) * 16 + g]);
        const float mag = expf(lr * st); float sn, cn; sincosf(li * st, &sn, &cn);
        const float lbr = mag * cn, lbi = mag * sn;
        p.LAMB()[i] = make_float2(lbr, lbi);
        const float nr = lbr - 1.f, ni = lbi, den = lr * lr + li * li;
        const float qr = (nr * lr + ni * li) / den, qi = (ni * lr - nr * li) / den;
        for (int h = 0; h < 16; ++h) { const float br = p.s5_b_re()[(size_t)i * 16 + h], bi = p.s5_b_im()[(size_t)i * 16 + h];
            p.BBAR()[(size_t)i * 16 + h] = make_float2(qr * br - qi * bi, qr * bi + qi * br); }
    }
}

template <int MAP>
__device__ __forceinline__ void tjob(const P& p, const float* src, long ld, int K, int ncols, bf16_t* dst, float* tile) {
    const int ntn = (ncols + 63) >> 6, ntk = K >> 6;
    for (int it = p.bid; it < ntn * ntk; it += p.nblk) {
        const int tn = it % ntn, tk = it / ntn, n0 = tn * 64, k0 = tk * 64;
#pragma unroll
        for (int ps = 0; ps < 2; ++ps) { const int kk = ps * 32 + (p.tid >> 4), n4 = (p.tid & 15) * 4;
            float4 v = make_float4(0.f, 0.f, 0.f, 0.f);
            if (n0 + n4 < ncols) v = *(const float4*)(src + (size_t)(k0 + kk) * ld + n0 + n4);
            tile[kk * 65 + n4 + 0] = v.x; tile[kk * 65 + n4 + 1] = v.y; tile[kk * 65 + n4 + 2] = v.z; tile[kk * 65 + n4 + 3] = v.w; }
        __syncthreads();
        { const int n = p.tid >> 3, k8 = (p.tid & 7) * 8;
          if (n0 + n < ncols) {
              uint4 w; w.x = pack2(tile[(k8 + 0) * 65 + n], tile[(k8 + 1) * 65 + n]); w.y = pack2(tile[(k8 + 2) * 65 + n], tile[(k8 + 3) * 65 + n]);
              w.z = pack2(tile[(k8 + 4) * 65 + n], tile[(k8 + 5) * 65 + n]); w.w = pack2(tile[(k8 + 6) * 65 + n], tile[(k8 + 7) * 65 + n]);
              int row = n0 + n;
              if (MAP == 1) row = (row >> 4) * 32 + (row & 15);
              if (MAP == 2) row = (row >> 4) * 32 + 16 + (row & 15);
              *(uint4*)(dst + (size_t)row * K + k0 + k8) = w; } }
        __syncthreads();
    }
}

__device__ __forceinline__ void phase_wprep(const P& p, int layer, unsigned char* smem) {
    float* tile = (float*)smem;
    float2* tw = (float2*)(smem + 20480);
    if (p.tid < 64) { float s, c; sincospif(2.f * p.tid / 64.f, &s, &c); tw[p.tid] = make_float2(c, s); }
    __syncthreads();
    const float* win = p.w_in() + (size_t)layer * 1024 * NIN;
    tjob<0>(p, win + 256, NIN, 1024, 2192, p.WINT() + (size_t)512 * 1024, tile);
    tjob<0>(p, win + 2448, NIN, 1024, 4096, p.WGT(), tile);
    for (int i = 0; i < 4; ++i) tjob<0>(p, p.w_branch() + ((size_t)layer * 4 + i) * 256 * 1024, 1024, 256, 1024, p.WBT() + (size_t)i * 1024 * 256, tile);
    tjob<0>(p, p.w_out() + (size_t)layer * 1024 * 1024, 1024, 1024, 1024, p.WOT(), tile);
    for (int e = 0; e < 16; ++e) {
        tjob<1>(p, p.moe_w1() + ((size_t)layer * 16 + e) * 1024 * 256, 256, 1024, 256, p.W13T() + (size_t)e * 512 * 1024, tile);
        tjob<2>(p, p.moe_w3() + ((size_t)layer * 16 + e) * 1024 * 256, 256, 1024, 256, p.W13T() + (size_t)e * 512 * 1024, tile);
        tjob<0>(p, p.moe_w2() + ((size_t)layer * 16 + e) * 256 * 1024, 1024, 256, 1024, p.W2T() + (size_t)e * 1024 * 256, tile);
    }
    tjob<0>(p, p.s5_w_glu() + (size_t)layer * 65536, 256, 256, 256, p.WGLUT(), tile);
    for (int it = p.bid; it < 1024; it += p.nblk) {
        const int n = it >> 1, k = (it & 1) * 512 + p.tid, s = n >> 8, g = (n >> 6) & 3, cp = n & 63;
        const float* src = win + (size_t)k * NIN + g * 64;
        float acc = 0.f;
        for (int c4 = 0; c4 < 64; c4 += 4) { const float4 v = *(const float4*)(src + c4);
            const float2 t0 = tw[((c4 + 0) * cp) & 63], t1 = tw[((c4 + 1) * cp) & 63], t2 = tw[((c4 + 2) * cp) & 63], t3 = tw[((c4 + 3) * cp) & 63];
            acc += s ? (v.x * t0.y + v.y * t1.y + v.z * t2.y + v.w * t3.y) : (v.x * t0.x + v.y * t1.x + v.z * t2.x + v.w * t3.x); }
        p.WINT()[(size_t)n * 1024 + k] = f2bf(acc);
    }
    for (int i = p.bid * NTHR + p.tid; i < 112 * 1024; i += p.nblk * NTHR) p.WINT()[(size_t)2704 * 1024 + i] = 0;
}

__device__ __forceinline__ void phase_norm1(const P& p, int mode) {
    const int gw = p.bid * 8 + p.wid, nw = p.nblk * 8;
    const int nrows = (mode == 2) ? RL : RT;
    const int layer = (mode == 0) ? 0 : 1;
    for (int r = gw; r < nrows; r += nw) {
        const int mr = modrow(r);
        float v[16];
        float* xr = xrow(p, r);
        if (mode == 0) {
            const float* src = r < RL ? p.x() + (size_t)r * D : p.ctx() + (size_t)(r - RL) * D;
#pragma unroll
            for (int j = 0; j < 4; ++j) { const float4 t = *(const float4*)(src + j * 256 + p.lane * 4); v[j * 4] = t.x; v[j * 4 + 1] = t.y; v[j * 4 + 2] = t.z; v[j * 4 + 3] = t.w; }
        } else {
            const int pl = mode - 1;
            const bool has = (pl == 0) || (r < RL);
            const float* g2 = p.MOD() + (size_t)(pl * 9 + mr) * 6144 + 5 * 1024;
            int4 tk = make_int4(0, 0, 0, 0); int2 sl = make_int2(0, 0);
            if (has) { tk = p.TOK()[r]; sl = p.SLOT()[r]; }
            const float w0 = __int_as_float(tk.z), w1 = __int_as_float(tk.w);
#pragma unroll
            for (int j = 0; j < 4; ++j) { const int k = j * 256 + p.lane * 4; const float4 t = *(const float4*)(xr + k);
                float a0 = t.x, a1 = t.y, a2 = t.z, a3 = t.w;
                if (has) { const uint2 y0 = *(const uint2*)(p.YE() + (size_t)sl.x * D + k), y1 = *(const uint2*)(p.YE() + (size_t)sl.y * D + k);
                    const float4 gg = *(const float4*)(g2 + k);
                    a0 += gg.x * (w0 * lo2f(y0.x) + w1 * lo2f(y1.x)); a1 += gg.y * (w0 * hi2f(y0.x) + w1 * hi2f(y1.x));
                    a2 += gg.z * (w0 * lo2f(y0.y) + w1 * lo2f(y1.y)); a3 += gg.w * (w0 * hi2f(y0.y) + w1 * hi2f(y1.y)); }
                v[j * 4] = a0; v[j * 4 + 1] = a1; v[j * 4 + 2] = a2; v[j * 4 + 3] = a3; }
        }
        float ss = 0.f;
#pragma unroll
        for (int i = 0; i < 16; ++i) ss += v[i] * v[i];
#pragma unroll
        for (int o = 32; o >= 1; o >>= 1) ss += __shfl_xor(ss, o);
        const float rstd = rsqrtf(ss * (1.f / 1024.f) + 1e-6f);
        if (mode == 2) {
#pragma unroll
            for (int j = 0; j < 4; ++j) { const int k = j * 256 + p.lane * 4; const float4 g = *(const float4*)(p.final_g() + k);
                *(float4*)(p.out() + (size_t)r * D + k) = make_float4(v[j * 4] * rstd * g.x, v[j * 4 + 1] * rstd * g.y, v[j * 4 + 2] * rstd * g.z, v[j * 4 + 3] * rstd * g.w); }
        } else {
            const float* md = p.MOD() + (size_t)(layer * 9 + mr) * 6144;
#pragma unroll
            for (int j = 0; j < 4; ++j) { const int k = j * 256 + p.lane * 4;
                *(float4*)(xr + k) = make_float4(v[j * 4], v[j * 4 + 1], v[j * 4 + 2], v[j * 4 + 3]);
                const float4 g = *(const float4*)(p.norm1_g() + layer * 1024 + k), sh = *(const float4*)(md + k), sc = *(const float4*)(md + 1024 + k);
                uint2 o; o.x = pack2(v[j * 4] * rstd * g.x * (1.f + sc.x) + sh.x, v[j * 4 + 1] * rstd * g.y * (1.f + sc.y) + sh.y);
                o.y = pack2(v[j * 4 + 2] * rstd * g.z * (1.f + sc.z) + sh.z, v[j * 4 + 3] * rstd * g.w * (1.f + sc.w) + sh.w);
                *(uint2*)(p.H() + (size_t)r * D + k) = o; }
        }
    }
}

__device__ __forceinline__ void phase_gemm1(const P& p, unsigned char* smem) {
    bf16_t* sA = (bf16_t*)smem; bf16_t* sB = sA + 128 * LDT;
    TILE_COORDS;
    const int ntm = RT / 128, ntn = NP / 128;
    for (int u = p.bid; u < ntm * ntn; u += p.nblk) {
        const int tm = u / ntn, tn = u % ntn;
        f32x4 acc[4][2]; zero_acc(acc);
        gemm_128x128(p.H() + (size_t)tm * 128 * D, D, p.WINT() + (size_t)tn * 128 * 1024, 1024, 1024, acc, sA, sB);
#pragma unroll
        for (int mi = 0; mi < 4; ++mi)
#pragma unroll
            for (int ni = 0; ni < 2; ++ni) { uint2 o; o.x = pack2(acc[mi][ni][0], acc[mi][ni][1]); o.y = pack2(acc[mi][ni][2], acc[mi][ni][3]);
                *(uint2*)(p.PM() + (size_t)TROW(tm, mi) * NP + TCOL(tn, ni)) = o; }
    }
}

__device__ __forceinline__ void scan_pos(int b, int d, int s, int& base, int& l, int& len) {
    if (s < LC) { base = RL + b * LC; len = LC; l = d ? (LC - 1 - s) : s; }
    else { base = b * L; len = L; const int i = s - LC; l = d ? (L - 1 - i) : i; }
}
__device__ __forceinline__ int s5_row(int b, int d, int s) {
    if (s < LC) return RL + b * LC + (d ? (LC - 1 - s) : s);
    int i = s - LC; if (d) i = L - 1 - i;
    return b * L + (i & 63) * 64 + (i >> 6);
}

constexpr int SCT = 32;
__device__ __forceinline__ void dplr_chunk(float* SST, const float* W, const float* KK, const float* BB, const float* KW, const float* VV, const float* RR, float* YO, int lane) {
    float S[64];
#pragma unroll
    for (int i = 0; i < 64; ++i) S[i] = SST[i * 64 + lane];
    for (int t = 0; t < SCT; ++t) {
        const float4* kk4 = (const float4*)(KK + t * 64); const float4* w4 = (const float4*)(W + t * 64); const float4* b4 = (const float4*)(BB + t * 64);
        const float4* kw4 = (const float4*)(KW + t * 64); const float4* r4 = (const float4*)(RR + t * 64);
        float d0 = 0.f, d1 = 0.f, d2 = 0.f, d3 = 0.f;
#pragma unroll
        for (int q = 0; q < 16; ++q) { const float4 k = kk4[q]; d0 += S[4 * q] * k.x; d1 += S[4 * q + 1] * k.y; d2 += S[4 * q + 2] * k.z; d3 += S[4 * q + 3] * k.w; }
        const float skk = -((d0 + d1) + (d2 + d3));
        const float v = VV[t * 64 + lane];
        float y0 = 0.f, y1 = 0.f, y2 = 0.f, y3 = 0.f;
#pragma unroll
        for (int q = 0; q < 16; ++q) { const float4 w = w4[q], b = b4[q], kw = kw4[q], r = r4[q];
            S[4 * q] = S[4 * q] * w.x + skk * b.x + v * kw.x; y0 += S[4 * q] * r.x;
            S[4 * q + 1] = S[4 * q + 1] * w.y + skk * b.y + v * kw.y; y1 += S[4 * q + 1] * r.y;
            S[4 * q + 2] = S[4 * q + 2] * w.z + skk * b.z + v * kw.z; y2 += S[4 * q + 2] * r.z;
            S[4 * q + 3] = S[4 * q + 3] * w.w + skk * b.w + v * kw.w; y3 += S[4 * q + 3] * r.w; }
        YO[t * 64 + lane] = (y0 + y1) + (y2 + y3);
    }
#pragma unroll
    for (int i = 0; i < 64; ++i) SST[i * 64 + lane] = S[i];
}

__device__ __forceinline__ float rw_shift(const P& p, const float* mu, int base, int l, int len, int cidx) {
    const bf16_t* q = p.PM() + (size_t)(base + l) * NP + PC_RW + cidx;
    const float p0 = bf2f(q[0]);
    const float pm = l > 0 ? bf2f(*(q - NP)) : 0.f;
    const float pn = l < len - 1 ? bf2f(*(q + NP)) : 0.f;
    return p0 + mu[cidx] * (pm - p0) + mu[896 + cidx] * (pn - p0);
}

__device__ __forceinline__ float4 rw_shift4(const P& p, const float* mu, int base, int l, int len, int cidx) {
    const bf16_t* q = p.PM() + (size_t)(base + l) * NP + PC_RW + cidx;
    const uint2 a = *(const uint2*)q;
    uint2 m = make_uint2(0u, 0u), n = make_uint2(0u, 0u);
    if (l > 0) m = *(const uint2*)(q - NP);
    if (l < len - 1) n = *(const uint2*)(q + NP);
    const float4 m0 = *(const float4*)(mu + cidx), m1 = *(const float4*)(mu + 896 + cidx);
    float4 r;
    { const float p0 = lo2f(a.x); r.x = p0 + m0.x * (lo2f(m.x) - p0) + m1.x * (lo2f(n.x) - p0); }
    { const float p0 = hi2f(a.x); r.y = p0 + m0.y * (hi2f(m.x) - p0) + m1.y * (hi2f(n.x) - p0); }
    { const float p0 = lo2f(a.y); r.z = p0 + m0.z * (lo2f(m.y) - p0) + m1.z * (lo2f(n.y) - p0); }
    { const float p0 = hi2f(a.y); r.w = p0 + m0.w * (hi2f(m.y) - p0) + m1.w * (hi2f(n.y) - p0); }
    return r;
}

template <bool is_dn>
__device__ __forceinline__ void scan_rwkv_dn(const P& p, int layer, int chain, unsigned char* smem) {
    const int d = chain & 1, h = (chain >> 1) & 3, b = chain >> 3;
    float* W = (float*)smem; float* KK = W + SCT * 64; float* BB = KK + SCT * 64; float* KW = BB + SCT * 64; float* VV = KW + SCT * 64; float* RR = VV + SCT * 64;
    float* YO = RR + SCT * 64; float* TW = YO + SCT * 64; float* TA = TW + SCT * 32; float* WU = TA + SCT * 32; float* AU = WU + 32 * 64; float* SST = AU + 32 * 64;
    const int t = p.tid >> 4, q = p.tid & 15;
    const float* mu = p.rw_mu() + (size_t)layer * 2 * 896;
    if (!is_dn) {
        for (int i = p.tid; i < 32 * 64; i += NTHR) { const int i2 = i >> 6, j = i & 63;
            WU[i] = p.rw_w_up()[((size_t)(layer * 2 + d) * 32 + i2) * 256 + h * 64 + j]; AU[i] = p.rw_a_up()[((size_t)(layer * 2 + d) * 32 + i2) * 256 + h * 64 + j]; }
    }
    for (int i = p.tid; i < 64 * 64; i += NTHR) SST[i] = 0.f;
    bf16_t* yout = p.YS() + (size_t)((is_dn ? 2 : 0) + d) * RT * 256;
    const float dn_A = is_dn ? expf(p.dn_a_log()[(layer * 2 + d) * 4 + h]) : 0.f;
    const float dn_dtb = is_dn ? p.dn_dt_bias()[(layer * 2 + d) * 4 + h] : 0.f;
    __syncthreads();
    for (int ch = 0; ch < (L + LC) / SCT; ++ch) {
        int base, l, len; scan_pos(b, d, ch * SCT + t, base, l, len);
        if (!is_dn) {
            { const float4 sv = rw_shift4(p, mu, base, l, len, 768 + q * 4);
              if (q < 8) { TW[t * 32 + q * 4] = tanhf(sv.x); TW[t * 32 + q * 4 + 1] = tanhf(sv.y); TW[t * 32 + q * 4 + 2] = tanhf(sv.z); TW[t * 32 + q * 4 + 3] = tanhf(sv.w); }
              else { *(float4*)(TA + t * 32 + (q - 8) * 4) = sv; } }
            __syncthreads();
            const int c4 = h * 64 + q * 4;
            float4 lwv = *(const float4*)(p.rw_w0() + (layer * 2 + d) * 256 + c4), apv = *(const float4*)(p.rw_a0() + (layer * 2 + d) * 256 + c4);
#pragma unroll 2
            for (int i2 = 0; i2 < 32; ++i2) { const float tw_ = TW[t * 32 + i2], ta_ = TA[t * 32 + i2]; const float4 wu = *(const float4*)(WU + i2 * 64 + q * 4), au = *(const float4*)(AU + i2 * 64 + q * 4);
                lwv.x += tw_ * wu.x; lwv.y += tw_ * wu.y; lwv.z += tw_ * wu.z; lwv.w += tw_ * wu.w; apv.x += ta_ * au.x; apv.y += ta_ * au.y; apv.z += ta_ * au.z; apv.w += ta_ * au.w; }
            const float4 av = make_float4(sigm(apv.x), sigm(apv.y), sigm(apv.z), sigm(apv.w));
            *(float4*)(W + t * 64 + q * 4) = make_float4(__expf(-0.6065306597f * sigm(lwv.x)), __expf(-0.6065306597f * sigm(lwv.y)), __expf(-0.6065306597f * sigm(lwv.z)), __expf(-0.6065306597f * sigm(lwv.w)));
            *(float4*)(RR + t * 64 + q * 4) = rw_shift4(p, mu, base, l, len, c4);
            *(float4*)(VV + t * 64 + q * 4) = rw_shift4(p, mu, base, l, len, 512 + c4);
            const float4 ks = rw_shift4(p, mu, base, l, len, 256 + c4);
            const float4 kkm = *(const float4*)(p.rw_k_k() + layer * 256 + c4), kam = *(const float4*)(p.rw_k_a() + layer * 256 + c4);
            float4 kk = make_float4(ks.x * kkm.x, ks.y * kkm.y, ks.z * kkm.z, ks.w * kkm.w);
            float ssq = (kk.x * kk.x + kk.y * kk.y) + (kk.z * kk.z + kk.w * kk.w);
            ssq += __shfl_xor(ssq, 1); ssq += __shfl_xor(ssq, 2); ssq += __shfl_xor(ssq, 4); ssq += __shfl_xor(ssq, 8);
            const float rn = rsqrtf(ssq + 1e-6f);
            kk.x *= rn; kk.y *= rn; kk.z *= rn; kk.w *= rn;
            *(float4*)(KK + t * 64 + q * 4) = kk;
            *(float4*)(BB + t * 64 + q * 4) = make_float4(kk.x * av.x, kk.y * av.y, kk.z * av.z, kk.w * av.w);
            *(float4*)(KW + t * 64 + q * 4) = make_float4(ks.x * (1.f + (av.x - 1.f) * kam.x), ks.y * (1.f + (av.y - 1.f) * kam.y), ks.z * (1.f + (av.z - 1.f) * kam.z), ks.w * (1.f + (av.w - 1.f) * kam.w));
        } else {
            float u[3][4]; float sq = 0.f, sk = 0.f;
#pragma unroll
            for (int s3 = 0; s3 < 3; ++s3) { const int cc = s3 * 256 + h * 64 + q * 4; float a0 = 0.f, a1 = 0.f, a2 = 0.f, a3 = 0.f;
#pragma unroll 1
                for (int tap = 0; tap < 5; ++tap) { const int ll = l + tap - 2;
                    if (ll >= 0 && ll < len) { const float4 cw = *(const float4*)(p.dn_conv() + ((size_t)layer * 5 + tap) * 768 + cc); const uint2 xv = *(const uint2*)(p.PM() + (size_t)(base + ll) * NP + PC_DQKV + cc);
                        a0 += cw.x * lo2f(xv.x); a1 += cw.y * hi2f(xv.x); a2 += cw.z * lo2f(xv.y); a3 += cw.w * hi2f(xv.y); } }
                u[s3][0] = silu_(a0); u[s3][1] = silu_(a1); u[s3][2] = silu_(a2); u[s3][3] = silu_(a3); }
#pragma unroll
            for (int i = 0; i < 4; ++i) { sq += u[0][i] * u[0][i]; sk += u[1][i] * u[1][i]; }
            sq += __shfl_xor(sq, 1); sq += __shfl_xor(sq, 2); sq += __shfl_xor(sq, 4); sq += __shfl_xor(sq, 8);
            sk += __shfl_xor(sk, 1); sk += __shfl_xor(sk, 2); sk += __shfl_xor(sk, 4); sk += __shfl_xor(sk, 8);
            const float qn = rsqrtf(sq + 1e-6f) * 0.125f, kn = rsqrtf(sk + 1e-6f);
            const float al = bf2f(p.PM()[(size_t)(base + l) * NP + PC_DAL + d * 4 + h]), be = bf2f(p.PM()[(size_t)(base + l) * NP + PC_DBE + d * 4 + h]);
            const float a = __expf(-dn_A * softplus_(al + dn_dtb)), beta = sigm(be);
#pragma unroll
            for (int i = 0; i < 4; ++i) { const int j = q * 4 + i; const float k = u[1][i] * kn;
                W[t * 64 + j] = a; KK[t * 64 + j] = k; BB[t * 64 + j] = a * beta * k; KW[t * 64 + j] = beta * k; VV[t * 64 + j] = u[2][i]; RR[t * 64 + j] = u[0][i] * qn; }
        }
        __syncthreads();
        if (p.wid == 0) dplr_chunk(SST, W, KK, BB, KW, VV, RR, YO, p.lane);
        __syncthreads();
        { uint2 o; o.x = pack2(YO[t * 64 + q * 4], YO[t * 64 + q * 4 + 1]); o.y = pack2(YO[t * 64 + q * 4 + 2], YO[t * 64 + q * 4 + 3]);
          *(uint2*)(yout + (size_t)(base + l) * 256 + h * 64 + q * 4) = o; }
    }
}

constexpr int S5T = 16;
__device__ __forceinline__ void scan_s5(const P& p, int layer, int blk, unsigned char* smem) {
    const int w = p.wid, chain = blk * 4 + (w & 3), d = chain & 1, g = (chain >> 1) & 15, b = chain >> 5;
    float* U = (float*)smem + (w & 3) * 4480;
    float2* SS = (float2*)(U + 256);
    float2* CC = SS + 16 * 65;
    const int lane = p.lane;
    const size_t pidx = ((size_t)(layer * 2 + d) * 16 + g) * 64 + lane;
    float2 lam = make_float2(0.f, 0.f); float2 bb[16]; float sr = 0.f, si = 0.f;
    if (w < 4) {
        lam = p.LAMB()[pidx];
#pragma unroll
        for (int h = 0; h < 16; ++h) bb[h] = p.BBAR()[pidx * 16 + h];
        for (int h = 0; h < 16; ++h) { const size_t ci = (((size_t)(layer * 2 + d) * 16 + g) * 16 + h) * 64 + lane; CC[h * 65 + lane] = make_float2(p.s5_c_re()[ci], p.s5_c_im()[ci]); }
    }
    bf16_t* yout = p.YS() + (size_t)(4 + d) * RT * 256;
    __syncthreads();
    for (int ch = 0; ch < (L + LC) / S5T; ++ch) {
        if (w < 4) { const int t = lane >> 2, h4 = (lane & 3) * 4; const int row = s5_row(b, d, ch * S5T + t);
            const uint2 v = *(const uint2*)(p.PM() + (size_t)row * NP + PC_S5 + g * 16 + h4);
            U[t * 16 + h4] = lo2f(v.x); U[t * 16 + h4 + 1] = hi2f(v.x); U[t * 16 + h4 + 2] = lo2f(v.y); U[t * 16 + h4 + 3] = hi2f(v.y); }
        __syncthreads();
        if (w < 4) {
            for (int t = 0; t < S5T; ++t) {
                const float4* u4 = (const float4*)(U + t * 16);
                float br = 0.f, bi = 0.f;
#pragma unroll
                for (int q = 0; q < 4; ++q) { const float4 u = u4[q];
                    br += bb[4 * q].x * u.x + bb[4 * q + 1].x * u.y + bb[4 * q + 2].x * u.z + bb[4 * q + 3].x * u.w;
                    bi += bb[4 * q].y * u.x + bb[4 * q + 1].y * u.y + bb[4 * q + 2].y * u.z + bb[4 * q + 3].y * u.w; }
                const float nr = lam.x * sr - lam.y * si + br, ni = lam.x * si + lam.y * sr + bi;
                sr = nr; si = ni;
                SS[t * 65 + lane] = make_float2(nr, ni);
            }
        }
        __syncthreads();
        if (w < 4) {
            const int h = lane & 15, tq = lane >> 4;
#pragma unroll 1
            for (int i = 0; i < 4; ++i) { const int t = tq + 4 * i; float y = 0.f;
#pragma unroll 8
                for (int pp = 0; pp < 64; ++pp) { const float2 c = CC[h * 65 + pp], s = SS[t * 65 + pp]; y += c.x * s.x - c.y * s.y; }
                const int row = s5_row(b, d, ch * S5T + t);
                yout[(size_t)row * 256 + g * 16 + h] = f2bf(y); }
        }
        __syncthreads();
    }
}

__device__ __forceinline__ void fourier_a(const P& p, int item, unsigned char* smem) {
    float* ZC = (float*)smem; float* ZS = ZC + 64 * 64; float2* tw = (float2*)(ZS + 64 * 64);
    const int chb = item & 3, q = (item >> 2) & 63, b = item >> 8;
    if (p.tid < 64) { float s, c; sincospif(2.f * p.tid / 64.f, &s, &c); tw[p.tid] = make_float2(c, s); }
    { const int pp = p.tid >> 3, c8 = (p.tid & 7) * 8; const size_t row = (size_t)b * L + 64 * pp + q;
      const uint4 a = *(const uint4*)(p.PM() + row * NP + PC_FC + chb * 64 + c8), s = *(const uint4*)(p.PM() + row * NP + PC_FS + chb * 64 + c8);
      float* zc = ZC + pp * 64 + c8; float* zs = ZS + pp * 64 + c8;
      zc[0] = lo2f(a.x); zc[1] = hi2f(a.x); zc[2] = lo2f(a.y); zc[3] = hi2f(a.y); zc[4] = lo2f(a.z); zc[5] = hi2f(a.z); zc[6] = lo2f(a.w); zc[7] = hi2f(a.w);
      zs[0] = lo2f(s.x); zs[1] = hi2f(s.x); zs[2] = lo2f(s.y); zs[3] = hi2f(s.y); zs[4] = lo2f(s.z); zs[5] = hi2f(s.z); zs[6] = lo2f(s.w); zs[7] = hi2f(s.w); }
    __syncthreads();
    const int ch = p.tid & 63, qg = p.tid >> 6;
    float xr[8], xi[8];
#pragma unroll
    for (int i = 0; i < 8; ++i) { xr[i] = 0.f; xi[i] = 0.f; }
    for (int pp = 0; pp < 64; ++pp) {
        const float zr = ZC[pp * 64 + ch], zi = -ZS[pp * 64 + ch];
#pragma unroll
        for (int i = 0; i < 8; ++i) { const float2 t = tw[(pp * (qg * 8 + i)) & 63];
            xr[i] += zr * t.x + zi * t.y; xi[i] += zi * t.x - zr * t.y; }
    }
    __syncthreads();
#pragma unroll
    for (int i = 0; i < 8; ++i) { const int q2 = qg * 8 + i; float s, c; sincospif(2.f * (float)(q * q2) / 4096.f, &s, &c);
        const float yr = xr[i] * c + xi[i] * s, yi = xi[i] * c - xr[i] * s;
        const size_t row = (size_t)b * L + 64 * q2 + q;
        p.PM()[row * NP + PC_FC + chb * 64 + ch] = f2bf(yr); p.PM()[row * NP + PC_FS + chb * 64 + ch] = f2bf(yi); }
    __syncthreads();
}
__device__ __forceinline__ void fourier_b(const P& p, int item, unsigned char* smem) {
    float* XR = (float*)smem; float* XI = XR + 64 * 64; float2* tw = (float2*)(XI + 64 * 64);
    const int chb = item & 3, q2 = (item >> 2) & 63, b = item >> 8;
    if (p.tid < 64) { float s, c; sincospif(2.f * p.tid / 64.f, &s, &c); tw[p.tid] = make_float2(c, s); }
    { const int q = p.tid >> 3, c8 = (p.tid & 7) * 8; const size_t row = (size_t)b * L + 64 * q2 + q;
      const uint4 a = *(const uint4*)(p.PM() + row * NP + PC_FC + chb * 64 + c8), s = *(const uint4*)(p.PM() + row * NP + PC_FS + chb * 64 + c8);
      float* zc = XR + q * 64 + c8; float* zs = XI + q * 64 + c8;
      zc[0] = lo2f(a.x); zc[1] = hi2f(a.x); zc[2] = lo2f(a.y); zc[3] = hi2f(a.y); zc[4] = lo2f(a.z); zc[5] = hi2f(a.z); zc[6] = lo2f(a.w); zc[7] = hi2f(a.w);
      zs[0] = lo2f(s.x); zs[1] = hi2f(s.x); zs[2] = lo2f(s.y); zs[3] = hi2f(s.y); zs[4] = lo2f(s.z); zs[5] = hi2f(s.z); zs[6] = lo2f(s.w); zs[7] = hi2f(s.w); }
    __syncthreads();
    const int ch = p.tid & 63, pg = p.tid >> 6;
    float yr[8];
#pragma unroll
    for (int i = 0; i < 8; ++i) yr[i] = 0.f;
    for (int q = 0; q < 64; ++q) {
        const float xr = XR[q * 64 + ch], xi = XI[q * 64 + ch];
#pragma unroll
        for (int i = 0; i < 8; ++i) { const float2 t = tw[(q * (pg * 8 + i)) & 63]; yr[i] += xr * t.x + xi * t.y; }
    }
#pragma unroll
    for (int i = 0; i < 8; ++i) { const int p2 = pg * 8 + i; const size_t row = (size_t)b * L + 64 * p2 + q2;
        p.Y()[row * D + chb * 64 + ch] = f2bf(yr[i] * (1.f / 512.f)); }
    __syncthreads();
}
__device__ __forceinline__ void fourier_ctx(const P& p, int item, unsigned char* smem) {
    float* ZC = (float*)smem; float* ZS = ZC + 256 * 32; float2* tw = (float2*)(ZS + 256 * 32);
    const int chb = item & 7, b = item >> 3;
    if (p.tid < 256) { float s, c; sincospif(2.f * p.tid / 256.f, &s, &c); tw[p.tid] = make_float2(c, s); }
    for (int i = p.tid; i < 256 * 4; i += NTHR) { const int l = i >> 2, c8 = (i & 3) * 8; const size_t row = (size_t)RL + b * LC + l;
        const uint4 a = *(const uint4*)(p.PM() + row * NP + PC_FC + chb * 32 + c8), s = *(const uint4*)(p.PM() + row * NP + PC_FS + chb * 32 + c8);
        float* zc = ZC + l * 32 + c8; float* zs = ZS + l * 32 + c8;
        zc[0] = lo2f(a.x); zc[1] = hi2f(a.x); zc[2] = lo2f(a.y); zc[3] = hi2f(a.y); zc[4] = lo2f(a.z); zc[5] = hi2f(a.z); zc[6] = lo2f(a.w); zc[7] = hi2f(a.w);
        zs[0] = lo2f(s.x); zs[1] = hi2f(s.x); zs[2] = lo2f(s.y); zs[3] = hi2f(s.y); zs[4] = lo2f(s.z); zs[5] = hi2f(s.z); zs[6] = lo2f(s.w); zs[7] = hi2f(s.w); }
    __syncthreads();
    const int ch = p.tid & 31, lg = p.tid >> 5;
    float yr[16];
#pragma unroll
    for (int i = 0; i < 16; ++i) yr[i] = 0.f;
    for (int l = 0; l < 256; ++l) {
        const float zc = ZC[l * 32 + ch], zs = ZS[l * 32 + ch];
#pragma unroll
        for (int i = 0; i < 16; ++i) { const float2 t = tw[(l * (lg * 16 + i)) & 255]; yr[i] += zc * t.x - zs * t.y; }
    }
#pragma unroll
    for (int i = 0; i < 16; ++i) { const size_t row = (size_t)RL + b * LC + lg * 16 + i; p.Y()[row * D + chb * 32 + ch] = f2bf(yr[i] * (1.f / 128.f)); }
    __syncthreads();
}

__device__ __forceinline__ void phase_mixA(const P& p, int layer, unsigned char* smem) {
    if (p.bid < 64) scan_rwkv_dn<false>(p, layer, p.bid, smem);
    else if (p.bid < 128) scan_rwkv_dn<true>(p, layer, p.bid - 64, smem);
    else if (p.bid < 192) scan_s5(p, layer, p.bid - 128, smem);
    else {
        const int fb = p.bid - 192, nf = p.nblk - 192;
        for (int it = fb; it < 2048; it += nf) fourier_a(p, it, smem);
        if (layer == 0) for (int it = fb; it < 64; it += nf) fourier_ctx(p, it, smem);
    }
}

__device__ __forceinline__ void phase_mixB(const P& p, int layer, unsigned char* smem) {
    const int nrows = layer == 0 ? RT : RL;
    for (int it = p.bid; it < 2048; it += p.nblk) fourier_b(p, it, smem);
    float* GU = (float*)smem;
    float* SG = GU + 64 * 256;
    for (int i = p.tid; i < 64 * 256; i += NTHR) GU[i] = p.rw_g_up()[(size_t)layer * 64 * 256 + i];
    __syncthreads();
    const float* mu = p.rw_mu() + (size_t)layer * 2 * 896;
    const int gw = p.bid * 8 + p.wid, nw = p.nblk * 8;
    const bf16_t* Y0 = p.YS(); const bf16_t* Y1 = p.YS() + (size_t)RT * 256;
    const bf16_t* D0 = p.YS() + (size_t)2 * RT * 256; const bf16_t* D1 = p.YS() + (size_t)3 * RT * 256;
    const bf16_t* S0 = p.YS() + (size_t)4 * RT * 256; const bf16_t* S1 = p.YS() + (size_t)5 * RT * 256;
    for (int r = gw; r < nrows; r += nw) {
        int base, l, len;
        if (r < RL) { base = (r >> 12) << 12; l = r & 4095; len = L; } else { const int rr = r - RL; base = RL + ((rr >> 8) << 8); l = rr & 255; len = LC; }
        const int c0 = p.lane * 4, hh = p.lane >> 4;
        { SG[p.wid * 64 + p.lane] = sigm(rw_shift(p, mu, base, l, len, 832 + p.lane));
          const uint2 a = *(const uint2*)(Y0 + (size_t)r * 256 + c0), bq = *(const uint2*)(Y1 + (size_t)r * 256 + c0);
          float y[4] = {lo2f(a.x) + lo2f(bq.x), hi2f(a.x) + hi2f(bq.x), lo2f(a.y) + lo2f(bq.y), hi2f(a.y) + hi2f(bq.y)};
          float sm = (y[0] + y[1]) + (y[2] + y[3]);
          sm += __shfl_xor(sm, 1); sm += __shfl_xor(sm, 2); sm += __shfl_xor(sm, 4); sm += __shfl_xor(sm, 8);
          const float mean = sm * (1.f / 64.f);
          float vq = 0.f;
#pragma unroll
          for (int i = 0; i < 4; ++i) { const float dd = y[i] - mean; vq += dd * dd; }
          vq += __shfl_xor(vq, 1); vq += __shfl_xor(vq, 2); vq += __shfl_xor(vq, 4); vq += __shfl_xor(vq, 8);
          const float rstd = rsqrtf(vq * (1.f / 64.f) + 64e-5f);
          float rs[4], ks[4], vs[4], bsum = 0.f;
#pragma unroll
          for (int i = 0; i < 4; ++i) { const int c = c0 + i; rs[i] = rw_shift(p, mu, base, l, len, c); ks[i] = rw_shift(p, mu, base, l, len, 256 + c); vs[i] = rw_shift(p, mu, base, l, len, 512 + c);
              bsum += rs[i] * ks[i] * p.rw_r_k()[layer * 256 + c]; }
          bsum += __shfl_xor(bsum, 1); bsum += __shfl_xor(bsum, 2); bsum += __shfl_xor(bsum, 4); bsum += __shfl_xor(bsum, 8);
          float g[4] = {0.f, 0.f, 0.f, 0.f};
          for (int i2 = 0; i2 < 64; ++i2) { const float sg = SG[p.wid * 64 + i2]; const float4 gu = *(const float4*)(GU + i2 * 256 + c0);
              g[0] += sg * gu.x; g[1] += sg * gu.y; g[2] += sg * gu.z; g[3] += sg * gu.w; }
          float o[4];
#pragma unroll
          for (int i = 0; i < 4; ++i) { const int c = c0 + i; const float yn = (y[i] - mean) * rstd * p.rw_ln_g()[layer * 256 + c] + p.rw_ln_b()[layer * 256 + c];
              o[i] = (yn + bsum * vs[i]) * g[i]; }
          uint2 w; w.x = pack2(o[0], o[1]); w.y = pack2(o[2], o[3]);
          *(uint2*)(p.Y() + (size_t)r * D + 256 + c0) = w; }
        { const uint2 a = *(const uint2*)(D0 + (size_t)r * 256 + c0), bq = *(const uint2*)(D1 + (size_t)r * 256 + c0);
          float y[4] = {lo2f(a.x) + lo2f(bq.x), hi2f(a.x) + hi2f(bq.x), lo2f(a.y) + lo2f(bq.y), hi2f(a.y) + hi2f(bq.y)};
          float sq = (y[0] * y[0] + y[1] * y[1]) + (y[2] * y[2] + y[3] * y[3]);
          sq += __shfl_xor(sq, 1); sq += __shfl_xor(sq, 2); sq += __shfl_xor(sq, 4); sq += __shfl_xor(sq, 8);
          const float rstd = rsqrtf(sq * (1.f / 64.f) + 1e-6f);
          const uint2 gt = *(const uint2*)(p.PM() + (size_t)r * NP + PC_DG + c0);
          const float gv[4] = {lo2f(gt.x), hi2f(gt.x), lo2f(gt.y), hi2f(gt.y)};
          float o[4];
#pragma unroll
          for (int i = 0; i < 4; ++i) o[i] = y[i] * rstd * p.dn_norm_g()[layer * 64 + ((c0 + i) & 63)] * silu_(gv[i]);
          uint2 w; w.x = pack2(o[0], o[1]); w.y = pack2(o[2], o[3]);
          *(uint2*)(p.Y() + (size_t)r * D + 512 + c0) = w; }
        { const uint2 a = *(const uint2*)(S0 + (size_t)r * 256 + c0), bq = *(const uint2*)(S1 + (size_t)r * 256 + c0);
          const uint2 uu = *(const uint2*)(p.PM() + (size_t)r * NP + PC_S5 + c0);
          const float4 dd = *(const float4*)(p.s5_d() + layer * 256 + c0);
          const float z0 = gelu_tanh(lo2f(uu.x) * dd.x + lo2f(a.x) + lo2f(bq.x)), z1 = gelu_tanh(hi2f(uu.x) * dd.y + hi2f(a.x) + hi2f(bq.x));
          const float z2 = gelu_tanh(lo2f(uu.y) * dd.z + lo2f(a.y) + lo2f(bq.y)), z3 = gelu_tanh(hi2f(uu.y) * dd.w + hi2f(a.y) + hi2f(bq.y));
          uint2 w; w.x = pack2(z0, z1); w.y = pack2(z2, z3);
          *(uint2*)(p.PM() + (size_t)r * NP + PC_S5 + c0) = w; }
        (void)hh;
    }
}

__device__ __forceinline__ void phase_glu(const P& p, int layer, unsigned char* smem) {
    bf16_t* sA = (bf16_t*)smem; bf16_t* sB = sA + 128 * LDT;
    TILE_COORDS;
    const int ntm = (layer == 0 ? RT : RL) / 128;
    for (int u = p.bid; u < ntm * 2; u += p.nblk) {
        const int tm = u >> 1, tn = u & 1;
        f32x4 acc[4][2]; zero_acc(acc);
        gemm_128x128(p.PM() + (size_t)tm * 128 * NP + PC_S5, NP, p.WGLUT() + (size_t)tn * 128 * 256, 256, 256, acc, sA, sB);
#pragma unroll
        for (int mi = 0; mi < 4; ++mi)
#pragma unroll
            for (int ni = 0; ni < 2; ++ni) { const int row = TROW(tm, mi), col = TCOL(tn, ni);
                const uint2 zz = *(const uint2*)(p.PM() + (size_t)row * NP + PC_S5 + col);
                const float4 bg = *(const float4*)(p.s5_b_glu() + layer * 256 + col);
                uint2 o; o.x = pack2(lo2f(zz.x) * sigm(acc[mi][ni][0] + bg.x), hi2f(zz.x) * sigm(acc[mi][ni][1] + bg.y));
                o.y = pack2(lo2f(zz.y) * sigm(acc[mi][ni][2] + bg.z), hi2f(zz.y) * sigm(acc[mi][ni][3] + bg.w));
                *(uint2*)(p.Y() + (size_t)row * D + 768 + col) = o; }
    }
}

__device__ __forceinline__ void phase_merge(const P& p, int layer, unsigned char* smem) {
    bf16_t* sA = (bf16_t*)smem; bf16_t* sB = sA + 128 * LDT;
    TILE_COORDS;
    const int ntm = (layer == 0 ? RT : RL) / 128;
    for (int u = p.bid; u < ntm * 8; u += p.nblk) {
        const int tm = u >> 3, tn = u & 7;
        f32x4 am[4][2]; zero_acc(am);
        for (int i = 0; i < 4; ++i) {
            f32x4 ag[4][2], ay[4][2]; zero_acc(ag); zero_acc(ay);
            gemm_128x128(p.H() + (size_t)tm * 128 * D, D, p.WGT() + ((size_t)i * 1024 + tn * 128) * 1024, 1024, 1024, ag, sA, sB);
            gemm_128x128(p.Y() + (size_t)tm * 128 * D + i * 256, D, p.WBT() + ((size_t)i * 1024 + tn * 128) * 256, 256, 256, ay, sA, sB);
#pragma unroll
            for (int mi = 0; mi < 4; ++mi)
#pragma unroll
                for (int ni = 0; ni < 2; ++ni)
#pragma unroll
                    for (int j = 0; j < 4; ++j) am[mi][ni][j] += sigm(ag[mi][ni][j]) * ay[mi][ni][j];
        }
#pragma unroll
        for (int mi = 0; mi < 4; ++mi)
#pragma unroll
            for (int ni = 0; ni < 2; ++ni) { uint2 o; o.x = pack2(am[mi][ni][0], am[mi][ni][1]); o.y = pack2(am[mi][ni][2], am[mi][ni][3]);
                *(uint2*)(p.MM() + (size_t)TROW(tm, mi) * D + TCOL(tn, ni)) = o; }
    }
}

__device__ __forceinline__ void phase_outproj(const P& p, int layer, unsigned char* smem) {
    bf16_t* sA = (bf16_t*)smem; bf16_t* sB = sA + 128 * LDT;
    TILE_COORDS;
    const int ntm = (layer == 0 ? RT : RL) / 128;
    for (int u = p.bid; u < ntm * 8; u += p.nblk) {
        const int tm = u >> 3, tn = u & 7;
        f32x4 acc[4][2]; zero_acc(acc);
        gemm_128x128(p.MM() + (size_t)tm * 128 * D, D, p.WOT() + (size_t)tn * 128 * 1024, 1024, 1024, acc, sA, sB);
#pragma unroll
        for (int mi = 0; mi < 4; ++mi)
#pragma unroll
            for (int ni = 0; ni < 2; ++ni) { const int row = TROW(tm, mi), col = TCOL(tn, ni);
                const float4 g = *(const float4*)(p.MOD() + (size_t)(layer * 9 + modrow(row)) * 6144 + 2 * 1024 + col);
                float* xr = xrow(p, row) + col; float4 xv = *(float4*)xr;
                xv.x += g.x * acc[mi][ni][0]; xv.y += g.y * acc[mi][ni][1]; xv.z += g.z * acc[mi][ni][2]; xv.w += g.w * acc[mi][ni][3];
                *(float4*)xr = xv; }
    }
}

__device__ __forceinline__ void phase_norm2_router(const P& p, int layer, unsigned char* smem) {
    float* RW = (float*)smem;
    unsigned* lcnt = (unsigned*)(RW + 1024 * 20);
    for (int i = p.tid; i < 1024 * 16; i += NTHR) RW[(i >> 4) * 20 + (i & 15)] = p.router_w()[i];
    if (p.tid < 16) lcnt[p.tid] = 0u;
    __syncthreads();
    const int nrows = layer == 0 ? RT : RL;
    const int gw = p.bid * 8 + p.wid, nw = p.nblk * 8;
    float rb[16];
#pragma unroll
    for (int e = 0; e < 16; ++e) rb[e] = p.router_b()[e];
    for (int r = gw; r < nrows; r += nw) {
        const float* xr = xrow(p, r); const float* md = p.MOD() + (size_t)(layer * 9 + modrow(r)) * 6144;
        float v[16]; float ss = 0.f;
#pragma unroll
        for (int j = 0; j < 16; ++j) { v[j] = xr[j * 64 + p.lane]; ss += v[j] * v[j]; }
#pragma unroll
        for (int o = 32; o >= 1; o >>= 1) ss += __shfl_xor(ss, o);
        const float rstd = rsqrtf(ss * (1.f / 1024.f) + 1e-6f);
        float lg[16];
#pragma unroll
        for (int e = 0; e < 16; ++e) lg[e] = 0.f;
#pragma unroll
        for (int j = 0; j < 16; ++j) { const int k = j * 64 + p.lane;
            const float h2 = v[j] * rstd * p.norm2_g()[layer * 1024 + k] * (1.f + md[4 * 1024 + k]) + md[3 * 1024 + k];
            p.H()[(size_t)r * D + k] = f2bf(h2);
            const float4* rw4 = (const float4*)(RW + k * 20);
#pragma unroll
            for (int e4 = 0; e4 < 4; ++e4) { const float4 w = rw4[e4]; lg[e4 * 4] += h2 * w.x; lg[e4 * 4 + 1] += h2 * w.y; lg[e4 * 4 + 2] += h2 * w.z; lg[e4 * 4 + 3] += h2 * w.w; } }
        const int ln = p.lane;
#pragma unroll
        for (int i = 0; i < 8; ++i) { const bool up = (ln & 32) != 0; const float send = up ? lg[i] : lg[i + 8], keep = up ? lg[i + 8] : lg[i]; lg[i] = keep + __shfl_xor(send, 32); }
#pragma unroll
        for (int i = 0; i < 4; ++i) { const bool up = (ln & 16) != 0; const float send = up ? lg[i] : lg[i + 4], keep = up ? lg[i + 4] : lg[i]; lg[i] = keep + __shfl_xor(send, 16); }
#pragma unroll
        for (int i = 0; i < 2; ++i) { const bool up = (ln & 8) != 0; const float send = up ? lg[i] : lg[i + 2], keep = up ? lg[i + 2] : lg[i]; lg[i] = keep + __shfl_xor(send, 8); }
        { const bool up = (ln & 4) != 0; const float send = up ? lg[0] : lg[1], keep = up ? lg[1] : lg[0]; lg[0] = keep + __shfl_xor(send, 4); }
        lg[0] += __shfl_xor(lg[0], 2); lg[0] += __shfl_xor(lg[0], 1);
        float sc[16], sel[16];
#pragma unroll
        for (int e = 0; e < 16; ++e) { sc[e] = sigm(__shfl(lg[0], 4 * e)); sel[e] = sc[e] + rb[e]; }
        int best = 0; float bestv = -1e30f;
#pragma unroll
        for (int g = 0; g < 4; ++g) { float m1 = -1e30f, m2 = -1e30f;
#pragma unroll
            for (int i = 0; i < 4; ++i) { const float s = sel[g * 4 + i]; if (s > m1) { m2 = m1; m1 = s; } else if (s > m2) m2 = s; }
            const float gs = m1 + m2; if (gs > bestv) { bestv = gs; best = g; } }
        int i1 = 0, i2 = 0; float s1 = -1e30f, s2 = -1e30f;
#pragma unroll
        for (int g = 0; g < 4; ++g)
#pragma unroll
            for (int i = 0; i < 4; ++i) if (g == best) { const float s = sel[g * 4 + i]; const int e = g * 4 + i;
                if (s > s1) { s2 = s1; i2 = i1; s1 = s; i1 = e; } else if (s > s2) { s2 = s; i2 = e; } }
        float w1 = 0.f, w2 = 0.f;
#pragma unroll
        for (int e = 0; e < 16; ++e) { if (e == i1) w1 = sc[e]; if (e == i2) w2 = sc[e]; }
        const float inv = 1.f / (w1 + w2);
        if (p.lane == 0) { p.TOK()[r] = make_int4(i1, i2, __float_as_int(w1 * inv), __float_as_int(w2 * inv)); atomicAdd(&lcnt[i1], 1u); atomicAdd(&lcnt[i2], 1u); }
    }
    __syncthreads();
    if (p.tid < 16 && lcnt[p.tid]) atomicAdd(p.ctl() + CW_CNT + layer * 64 + p.tid, lcnt[p.tid]);
}

__device__ __forceinline__ void load_segments(const P& p, int layer, int* seg  , int* cnt  ) {
    if (p.tid == 0) { int s = 0; for (int e = 0; e < 16; ++e) { const int c = (int)__hip_atomic_load(p.ctl() + CW_CNT + layer * 64 + e, __ATOMIC_RELAXED, __HIP_MEMORY_SCOPE_AGENT); cnt[e] = c; seg[e] = s; s += (c + 127) & ~127; } seg[16] = s; }
    __syncthreads();
}

__device__ __forceinline__ void phase_scatter(const P& p, int layer, unsigned char* smem) {
    int* seg = (int*)smem; int* cnt = seg + 32;
    load_segments(p, layer, seg, cnt);
    const int nrows = layer == 0 ? RT : RL;
    const int gw = p.bid * 8 + p.wid, nw = p.nblk * 8;
    for (int r = gw; r < nrows; r += nw) {
        int s0 = 0, s1 = 0;
        if (p.lane == 0) { const int4 tk = p.TOK()[r];
            s0 = seg[tk.x] + (int)atomicAdd(p.ctl() + CW_CNT + layer * 64 + 32 + tk.x, 1u);
            s1 = seg[tk.y] + (int)atomicAdd(p.ctl() + CW_CNT + layer * 64 + 32 + tk.y, 1u);
            p.SLOT()[r] = make_int2(s0, s1); }
        s0 = __shfl(s0, 0); s1 = __shfl(s1, 0);
        const uint4* src = (const uint4*)(p.H() + (size_t)r * D);
        const uint4 a = src[p.lane], b = src[64 + p.lane];
        uint4* d0 = (uint4*)(p.XS() + (size_t)s0 * D); uint4* d1 = (uint4*)(p.XS() + (size_t)s1 * D);
        d0[p.lane] = a; d0[64 + p.lane] = b; d1[p.lane] = a; d1[64 + p.lane] = b;
    }
}

__device__ __forceinline__ void phase_moe1(const P& p, int layer, unsigned char* smem) {
    bf16_t* sA = (bf16_t*)smem; bf16_t* sB = sA + 128 * LDT; int* seg = (int*)(smem + 2 * 128 * LDT * 2); int* cnt = seg + 32;
    load_segments(p, layer, seg, cnt);
    TILE_COORDS;
    const int ntm_all = seg[16] >> 7;
    for (int u = p.bid; u < ntm_all * 4; u += p.nblk) {
        const int tmg = u >> 2, tn = u & 3;
        int e = 0;
#pragma unroll
        for (int i = 1; i < 16; ++i) if ((seg[i] >> 7) <= tmg) e = i;
        f32x4 acc[4][2]; zero_acc(acc);
        gemm_128x128(p.XS() + (size_t)tmg * 128 * D, D, p.W13T() + ((size_t)e * 512 + tn * 128) * 1024, 1024, 1024, acc, sA, sB);
#pragma unroll
        for (int mi = 0; mi < 4; ++mi) { const int row = TROW(tmg, mi), col = tn * 32 + wc_ * 8 + 0;
            (void)col;
            const int j0 = (tn * 128 + wc_ * 32) / 2 + fq_ * 4;
            uint2 o; o.x = pack2(silu_(acc[mi][0][0]) * acc[mi][1][0], silu_(acc[mi][0][1]) * acc[mi][1][1]);
            o.y = pack2(silu_(acc[mi][0][2]) * acc[mi][1][2], silu_(acc[mi][0][3]) * acc[mi][1][3]);
            *(uint2*)(p.ACT() + (size_t)row * 256 + j0) = o; }
    }
}
__device__ __forceinline__ void phase_moe2(const P& p, int layer, unsigned char* smem) {
    bf16_t* sA = (bf16_t*)smem; bf16_t* sB = sA + 128 * LDT; int* seg = (int*)(smem + 2 * 128 * LDT * 2); int* cnt = seg + 32;
    load_segments(p, layer, seg, cnt);
    TILE_COORDS;
    const int ntm_all = seg[16] >> 7;
    for (int u = p.bid; u < ntm_all * 8; u += p.nblk) {
        const int tmg = u >> 3, tn = u & 7;
        int e = 0;
#pragma unroll
        for (int i = 1; i < 16; ++i) if ((seg[i] >> 7) <= tmg) e = i;
        f32x4 acc[4][2]; zero_acc(acc);
        gemm_128x128(p.ACT() + (size_t)tmg * 128 * 256, 256, p.W2T() + ((size_t)e * 1024 + tn * 128) * 256, 256, 256, acc, sA, sB);
#pragma unroll
        for (int mi = 0; mi < 4; ++mi)
#pragma unroll
            for (int ni = 0; ni < 2; ++ni) { uint2 o; o.x = pack2(acc[mi][ni][0], acc[mi][ni][1]); o.y = pack2(acc[mi][ni][2], acc[mi][ni][3]);
                *(uint2*)(p.YE() + (size_t)TROW(tmg, mi) * D + TCOL(tn, ni)) = o; }
    }
}

constexpr int NPH_LAYER = 11;
constexpr int NPHASE = 1 + 2 * NPH_LAYER + 1;

__global__ void __launch_bounds__(NTHR, 2) fwd(Args a) {
    extern __shared__ __attribute__((aligned(16))) unsigned char smem[];
    P p(a);
    p.bid = blockIdx.x; p.nblk = gridDim.x; p.tid = threadIdx.x; p.lane = threadIdx.x & 63; p.wid = threadIdx.x >> 6;

    volatile LAS unsigned* xbw = (volatile LAS unsigned*)(smem + LDS_BYTES - 16);
    const bool multi = (a.ph_hi - a.ph_lo) > 1;
    XcdBarrier bar; bar.bar = p.ctl() + CW_BAR; bar.x = 0; bar.st = xbw;
    if (multi) {
        if (threadIdx.x == 0) { xbw[0] = 0u; xbw[1] = 0u; xbw[2] = 0u; xbw[3] = 0u; }
        __syncthreads();
        bar = xcd_barrier_post(p.ctl() + CW_BAR, xbw);
    }
    const int lo = a.ph_lo, hi = a.ph_hi;
#define IN(k) (lo <= (k) && (k) < hi)
#define SEAM(k) do { if (IN((k) + 1)) xcd_barrier(bar); } while (0)

    if (IN(0)) { phase_prologue(p, smem); SEAM(0); }
    {
        if (IN(1 + 0)) { phase_wprep(p, 0, smem); phase_norm1(p, 0); SEAM(1 + 0); }
        if (IN(1 + 1)) { phase_gemm1(p, smem); SEAM(1 + 1); }
        if (IN(1 + 2)) { phase_mixA(p, 0, smem); SEAM(1 + 2); }
        if (IN(1 + 3)) { phase_mixB(p, 0, smem); SEAM(1 + 3); }
        if (IN(1 + 4)) { phase_glu(p, 0, smem); SEAM(1 + 4); }
        if (IN(1 + 5)) { phase_merge(p, 0, smem); SEAM(1 + 5); }
        if (IN(1 + 6)) { phase_outproj(p, 0, smem); SEAM(1 + 6); }
        if (IN(1 + 7)) { phase_norm2_router(p, 0, smem); SEAM(1 + 7); }
        if (IN(1 + 8)) { phase_scatter(p, 0, smem); SEAM(1 + 8); }
        if (IN(1 + 9)) { phase_moe1(p, 0, smem); SEAM(1 + 9); }
        if (IN(1 + 10)) { phase_moe2(p, 0, smem); SEAM(1 + 10); }
    }
    {
        if (IN(12 + 0)) { phase_wprep(p, 1, smem); phase_norm1(p, 1); SEAM(12 + 0); }
        if (IN(12 + 1)) { phase_gemm1(p, smem); SEAM(12 + 1); }
        if (IN(12 + 2)) { phase_mixA(p, 1, smem); SEAM(12 + 2); }
        if (IN(12 + 3)) { phase_mixB(p, 1, smem); SEAM(12 + 3); }
        if (IN(12 + 4)) { phase_glu(p, 1, smem); SEAM(12 + 4); }
        if (IN(12 + 5)) { phase_merge(p, 1, smem); SEAM(12 + 5); }
        if (IN(12 + 6)) { phase_outproj(p, 1, smem); SEAM(12 + 6); }
        if (IN(12 + 7)) { phase_norm2_router(p, 1, smem); SEAM(12 + 7); }
        if (IN(12 + 8)) { phase_scatter(p, 1, smem); SEAM(12 + 8); }
        if (IN(12 + 9)) { phase_moe1(p, 1, smem); SEAM(12 + 9); }
        if (IN(12 + 10)) { phase_moe2(p, 1, smem); SEAM(12 + 10); }
    }
    if (IN(NPHASE - 1)) { phase_norm1(p, 2); }
#undef IN
#undef SEAM
}

}

extern "C" void kernel_launch(void* const* d_in, const int* in_sizes, int n_in, void* d_out, int out_size, void* d_ws, size_t ws_size, hipStream_t stream) {
    static int ready = 0;
    if (ready == 0) {
        if (n_in != 42 || out_size != RL * D || ws_size < WS_END) { fprintf(stderr, "kernel_launch: unexpected shapes n_in=%d out=%d ws=%zu need=%zu\n", n_in, out_size, ws_size, (size_t)WS_END); ready = -1; return; }
        if (hipFuncSetAttribute((const void*)fwd, hipFuncAttributeMaxDynamicSharedMemorySize, LDS_BYTES) != hipSuccess) { fprintf(stderr, "kernel_launch: hipFuncSetAttribute failed\n"); ready = -1; return; }
        int per_cu = 0; (void)hipOccupancyMaxActiveBlocksPerMultiprocessor(&per_cu, (const void*)fwd, NTHR, LDS_BYTES); (void)hipGetLastError();
        if (per_cu < 1) fprintf(stderr, "kernel_launch: occupancy query says %d blocks/CU\n", per_cu);
        ready = 1;
    }
    if (ready < 0) return;
    (void)in_sizes;
    (void)hipMemsetAsync((char*)d_ws + WS_CTL, 0, CTL_BYTES, stream);
    Args a{};
    for (int i = 0; i < 42; ++i) a.in[i] = (const float*)d_in[i];
    a.out = (float*)d_out; a.ws = (unsigned char*)d_ws;
    const int grid = 256;
#if MK_SINGLE
    a.ph_lo = 0; a.ph_hi = NPHASE;
    hipLaunchKernelGGL(fwd, dim3(grid), dim3(NTHR), LDS_BYTES, stream, a);
#else
    for (int ph = 0; ph < NPHASE; ++ph) { a.ph_lo = ph; a.ph_hi = ph + 1; hipLaunchKernelGGL(fwd, dim3(grid), dim3(NTHR), LDS_BYTES, stream, a); }
#endif
}
```

```cpp
#include <hip/hip_runtime.h>
#include <stdio.h>
#include <stdint.h>

#ifndef MK_SINGLE
#define MK_SINGLE 1
#endif

namespace {

typedef unsigned short bf16_t;
typedef short bf16x8 __attribute__((ext_vector_type(8)));
typedef float f32x4 __attribute__((ext_vector_type(4)));

constexpr int D = 1024, NB = 8, L = 4096, LC = 256;
constexpr int RL = NB * L, RC = NB * LC, RT = RL + RC;
constexpr int NP = 2816;
constexpr int NIN = 6544;
constexpr int NTHR = 512;
constexpr int NSLOT = 73728;
constexpr int LDS_RING = 131072;
constexpr int LDS_BYTES = 159744;
constexpr int PC_FC = 0, PC_FS = 256, PC_RW = 512, PC_DQKV = 1408, PC_DG = 2176, PC_DAL = 2432, PC_DBE = 2440, PC_S5 = 2448;

constexpr size_t al256(size_t x) { return (x + 255) & ~(size_t)255; }
constexpr size_t WS_CTL = 0;
constexpr size_t CTL_BYTES = 65536;
constexpr size_t WS_MOD = WS_CTL + CTL_BYTES;
constexpr size_t WS_LAMB = al256(WS_MOD + 2 * 9 * 6144 * 4);
constexpr size_t WS_BBAR = al256(WS_LAMB + 2 * 2 * 16 * 64 * 8);
constexpr size_t WS_TOK = al256(WS_BBAR + 2 * 2 * 16 * 64 * 16 * 8);
constexpr size_t WS_SLOT = al256(WS_TOK + (size_t)RT * 16);
constexpr size_t WS_XC = al256(WS_SLOT + (size_t)RT * 8);
constexpr size_t WS_WINT = al256(WS_XC + (size_t)RC * D * 4);
constexpr size_t WS_WGT = al256(WS_WINT + (size_t)NP * 1024 * 2);
constexpr size_t WS_WBT = al256(WS_WGT + (size_t)4096 * 1024 * 2);
constexpr size_t WS_WOT = al256(WS_WBT + (size_t)4 * 1024 * 256 * 2);
constexpr size_t WS_W13T = al256(WS_WOT + (size_t)1024 * 1024 * 2);
constexpr size_t WS_W2T = al256(WS_W13T + (size_t)16 * 512 * 1024 * 2);
constexpr size_t WS_WGLUT = al256(WS_W2T + (size_t)16 * 1024 * 256 * 2);
constexpr size_t WS_S5TT = al256(WS_WGLUT + (size_t)256 * 256 * 2);
constexpr size_t WS_S5GG = al256(WS_S5TT + (size_t)2 * 16 * 256 * 512 * 2);
constexpr size_t WS_H = al256(WS_S5GG + (size_t)2 * 16 * 256 * 256 * 2);
constexpr size_t WS_PM = al256(WS_H + (size_t)RT * D * 2);
constexpr size_t WS_YS = al256(WS_PM + (size_t)RT * NP * 2);
constexpr int S5ROWS = 2304;
constexpr size_t WS_AC = al256(WS_YS + (size_t)4 * RT * 256 * 2);
constexpr size_t WS_V = al256(WS_AC + (size_t)16 * S5ROWS * 512 * 2);
constexpr size_t WS_Y = al256(WS_V + (size_t)16 * S5ROWS * 256 * 2);
constexpr size_t WS_END = al256(WS_Y + (size_t)RT * D * 2);
constexpr size_t WS_GB = WS_PM;
constexpr size_t WS_MM = WS_H;
constexpr size_t WS_XS = WS_PM;
constexpr size_t WS_ACT = WS_XS + (size_t)NSLOT * D * 2;
constexpr size_t WS_YE = WS_ACT + (size_t)NSLOT * 256 * 2;
static_assert(WS_GB + (size_t)RT * 4096 * 2 <= WS_Y, "gate alias");
static_assert(WS_YE + (size_t)NSLOT * D * 2 <= WS_END, "moe alias");

constexpr int CW_BAR = 0;
constexpr int CW_CNT = 4096;
constexpr int CW_S5F = 6144;
constexpr int CW_MOEF = 5120;

#define XB_TMO      128
#define XB_XCNT(j)  (256  + 64 * (j))
#define XB_XSUB(j)  (1280 + 64 * (j))
#define XB_XGEN(j)  (2304 + 64 * (j))
#define XB_TOP      3328
#define XB_TOPGEN   3392
#define XCD_BAR_WORDS 3456
#define XB_SPIN_CAP (1u << 18)
#define LAS __attribute__((address_space(3)))

__device__ __forceinline__ unsigned xb_ld(unsigned* p)              { return __hip_atomic_load(p, __ATOMIC_RELAXED, __HIP_MEMORY_SCOPE_AGENT); }
__device__ __forceinline__ unsigned xb_add(unsigned* p, unsigned v) { return __hip_atomic_fetch_add(p, v, __ATOMIC_RELAXED, __HIP_MEMORY_SCOPE_AGENT); }
__device__ __forceinline__ unsigned xb_xcc_id() { return (unsigned)__builtin_amdgcn_s_getreg((3 << 11) | 20) & 0xFu; }
#define XB_SPIN(cond, bar) do { unsigned _sp = 0; while (cond) { __builtin_amdgcn_s_sleep(1); \
    if ((++_sp & 255u) == 0u) { if (xb_ld(&(bar)[XB_TMO])) break; if (_sp > XB_SPIN_CAP) { atomicAdd(&(bar)[XB_TMO], 1u); break; } } } } while (0)

struct XcdBarrier { unsigned* bar; unsigned x; volatile LAS unsigned* st; };

__device__ __forceinline__ XcdBarrier xcd_barrier_post(unsigned* bar, volatile LAS unsigned* st) {
    XcdBarrier b; b.bar = bar; b.x = xb_xcc_id(); b.st = st;
    if (threadIdx.x == 0) (void)xb_add(&bar[XB_XCNT(b.x)], 1u);
    return b;
}
__device__ __forceinline__ void xcd_barrier_complete(unsigned* bar, unsigned x, unsigned& nloc, unsigned& nx) {
    const unsigned G = gridDim.x * gridDim.y * gridDim.z;
    unsigned sum, cnt, mine, sp = 0u;
    for (;;) {
        sum = 0u; cnt = 0u; mine = 0u;
#pragma unroll
        for (unsigned j = 0; j < 16; ++j) { const unsigned c = xb_ld(&bar[XB_XCNT(j)]); sum += c; cnt += (c > 0u) ? 1u : 0u; mine = (j == x) ? c : mine; }
        if (sum == G) break;
        __builtin_amdgcn_s_sleep(1);
        if ((++sp & 255u) == 0u) { if (xb_ld(&bar[XB_TMO])) break; if (sp > XB_SPIN_CAP) { atomicAdd(&bar[XB_TMO], 1u); break; } }
    }
    nloc = mine > 0u ? mine : 1u; nx = cnt > 0u ? cnt : 1u;
}
__device__ __forceinline__ void xcd_barrier(const XcdBarrier& b) {
    asm volatile("s_waitcnt vmcnt(0)" ::: "memory");
    __syncthreads();
    if (threadIdx.x == 0) {
        unsigned* bar = b.bar;
        __builtin_amdgcn_s_waitcnt(0);
        unsigned nloc = b.st[0], nx = b.st[1];
        if (nloc == 0u) { xcd_barrier_complete(bar, b.x, nloc, nx); b.st[0] = nloc; b.st[1] = nx; }
        const unsigned old = xb_add(&bar[XB_XSUB(b.x)], 1u);
        const unsigned gen = old / nloc;
        if (old + 1u == (gen + 1u) * nloc) {
            __builtin_amdgcn_fence(__ATOMIC_RELEASE, "agent");
            asm volatile("s_waitcnt vmcnt(0)" ::: "memory");
            const unsigned og = xb_add(&bar[XB_TOP], 1u);
            const unsigned tg = og / nx;
            if (og + 1u == (tg + 1u) * nx) xb_add(&bar[XB_TOPGEN], 1u);
            else XB_SPIN(xb_ld(&bar[XB_TOPGEN]) == tg, bar);
            __builtin_amdgcn_fence(__ATOMIC_ACQUIRE, "agent");
            xb_add(&bar[XB_XGEN(b.x)], 1u);
            asm volatile("s_waitcnt vmcnt(0)" ::: "memory");
        } else {
            XB_SPIN(xb_ld(&bar[XB_XGEN(b.x)]) == gen, bar);
            __builtin_amdgcn_fence(__ATOMIC_ACQUIRE, "agent");
            asm volatile("s_waitcnt vmcnt(0)" ::: "memory");
        }
    }
    __syncthreads();
}

__device__ __forceinline__ bf16_t f2bf(float f) { return __builtin_bit_cast(bf16_t, (__bf16)f); }
__device__ __forceinline__ float bf2f(bf16_t b) { return __uint_as_float(((unsigned)b) << 16); }
typedef __bf16 bf16v2g_t __attribute__((ext_vector_type(2)));
__device__ __forceinline__ unsigned pack2(float a, float b) { const bf16v2g_t v = {(__bf16)a, (__bf16)b}; return __builtin_bit_cast(unsigned, v); }
__device__ __forceinline__ float lo2f(unsigned u) { return __uint_as_float(u << 16); }
__device__ __forceinline__ float hi2f(unsigned u) { return __uint_as_float(u & 0xFFFF0000u); }
__device__ __forceinline__ float sigm(float x) { return __builtin_amdgcn_rcpf(1.f + __expf(-x)); }
__device__ __forceinline__ float fast_tanh(float x) { const float e = __expf(-2.f * fabsf(x)); const float t = (1.f - e) * __builtin_amdgcn_rcpf(1.f + e); return x < 0.f ? -t : t; }
__device__ __forceinline__ float silu_(float x) { return x * sigm(x); }
__device__ __forceinline__ float softplus_(float x) { return x > 20.f ? x : __logf(1.f + __expf(x)); }
__device__ __forceinline__ float gelu_tanh(float x) { const float u = 0.7978845608f * (x + 0.044715f * x * x * x); return 0.5f * x * (1.f + tanhf(u)); }

struct Args { const float* in[42]; float* out; unsigned char* ws; int ph_lo, ph_hi; };
struct P {
    const Args& a;
    __device__ __forceinline__ int bid() const { return (int)blockIdx.x; }
    __device__ __forceinline__ int nblk() const { return (int)gridDim.x; }
    __device__ __forceinline__ int tid() const { return (int)threadIdx.x; }
    __device__ __forceinline__ int lane() const { return (int)(threadIdx.x & 63); }
    __device__ __forceinline__ int wid() const { return (int)(threadIdx.x >> 6); }
    __device__ __forceinline__ P(const Args& a_) : a(a_) {}
    __device__ __forceinline__ const float* x() const { return a.in[0]; }
    __device__ __forceinline__ const float* c() const { return a.in[1]; }
    __device__ __forceinline__ const float* ctx() const { return a.in[2]; }
    __device__ __forceinline__ const float* c_ctx() const { return a.in[3]; }
    __device__ __forceinline__ const float* w_mod() const { return a.in[4]; }
    __device__ __forceinline__ const float* b_mod() const { return a.in[5]; }
    __device__ __forceinline__ const float* norm1_g() const { return a.in[6]; }
    __device__ __forceinline__ const float* norm2_g() const { return a.in[7]; }
    __device__ __forceinline__ const float* w_in() const { return a.in[8]; }
    __device__ __forceinline__ const float* rw_mu() const { return a.in[9]; }
    __device__ __forceinline__ const float* rw_w0() const { return a.in[10]; }
    __device__ __forceinline__ const float* rw_w_up() const { return a.in[11]; }
    __device__ __forceinline__ const float* rw_a0() const { return a.in[12]; }
    __device__ __forceinline__ const float* rw_a_up() const { return a.in[13]; }
    __device__ __forceinline__ const float* rw_k_k() const { return a.in[14]; }
    __device__ __forceinline__ const float* rw_k_a() const { return a.in[15]; }
    __device__ __forceinline__ const float* rw_r_k() const { return a.in[16]; }
    __device__ __forceinline__ const float* rw_g_up() const { return a.in[17]; }
    __device__ __forceinline__ const float* rw_ln_g() const { return a.in[18]; }
    __device__ __forceinline__ const float* rw_ln_b() const { return a.in[19]; }
    __device__ __forceinline__ const float* dn_conv() const { return a.in[20]; }
    __device__ __forceinline__ const float* dn_a_log() const { return a.in[21]; }
    __device__ __forceinline__ const float* dn_dt_bias() const { return a.in[22]; }
    __device__ __forceinline__ const float* dn_norm_g() const { return a.in[23]; }
    __device__ __forceinline__ const float* s5_lam_re() const { return a.in[24]; }
    __device__ __forceinline__ const float* s5_lam_im() const { return a.in[25]; }
    __device__ __forceinline__ const float* s5_log_step() const { return a.in[26]; }
    __device__ __forceinline__ const float* s5_b_re() const { return a.in[27]; }
    __device__ __forceinline__ const float* s5_b_im() const { return a.in[28]; }
    __device__ __forceinline__ const float* s5_c_re() const { return a.in[29]; }
    __device__ __forceinline__ const float* s5_c_im() const { return a.in[30]; }
    __device__ __forceinline__ const float* s5_d() const { return a.in[31]; }
    __device__ __forceinline__ const float* s5_w_glu() const { return a.in[32]; }
    __device__ __forceinline__ const float* s5_b_glu() const { return a.in[33]; }
    __device__ __forceinline__ const float* w_branch() const { return a.in[34]; }
    __device__ __forceinline__ const float* w_out() const { return a.in[35]; }
    __device__ __forceinline__ const float* router_w() const { return a.in[36]; }
    __device__ __forceinline__ const float* router_b() const { return a.in[37]; }
    __device__ __forceinline__ const float* moe_w1() const { return a.in[38]; }
    __device__ __forceinline__ const float* moe_w3() const { return a.in[39]; }
    __device__ __forceinline__ const float* moe_w2() const { return a.in[40]; }
    __device__ __forceinline__ const float* final_g() const { return a.in[41]; }
    __device__ __forceinline__ float* out() const { return a.out; }
    __device__ __forceinline__ unsigned* ctl() const { return (unsigned*)(a.ws + WS_CTL); }
    __device__ __forceinline__ float* MOD() const { return (float*)(a.ws + WS_MOD); }
    __device__ __forceinline__ float2* LAMB() const { return (float2*)(a.ws + WS_LAMB); }
    __device__ __forceinline__ float2* BBAR() const { return (float2*)(a.ws + WS_BBAR); }
    __device__ __forceinline__ int4* TOK() const { return (int4*)(a.ws + WS_TOK); }
    __device__ __forceinline__ int2* SLOT() const { return (int2*)(a.ws + WS_SLOT); }
    __device__ __forceinline__ float* XC() const { return (float*)(a.ws + WS_XC); }
    __device__ __forceinline__ bf16_t* WINT() const { return (bf16_t*)(a.ws + WS_WINT); }
    __device__ __forceinline__ bf16_t* WGT() const { return (bf16_t*)(a.ws + WS_WGT); }
    __device__ __forceinline__ bf16_t* WBT() const { return (bf16_t*)(a.ws + WS_WBT); }
    __device__ __forceinline__ bf16_t* WOT() const { return (bf16_t*)(a.ws + WS_WOT); }
    __device__ __forceinline__ bf16_t* W13T() const { return (bf16_t*)(a.ws + WS_W13T); }
    __device__ __forceinline__ bf16_t* W2T() const { return (bf16_t*)(a.ws + WS_W2T); }
    __device__ __forceinline__ bf16_t* WGLUT() const { return (bf16_t*)(a.ws + WS_WGLUT); }
    __device__ __forceinline__ bf16_t* H() const { return (bf16_t*)(a.ws + WS_H); }
    __device__ __forceinline__ bf16_t* PM() const { return (bf16_t*)(a.ws + WS_PM); }
    __device__ __forceinline__ bf16_t* Y() const { return (bf16_t*)(a.ws + WS_Y); }
    __device__ __forceinline__ bf16_t* YS() const { return (bf16_t*)(a.ws + WS_YS); }
    __device__ __forceinline__ bf16_t* S5TT() const { return (bf16_t*)(a.ws + WS_S5TT); }
    __device__ __forceinline__ bf16_t* S5GG() const { return (bf16_t*)(a.ws + WS_S5GG); }
    __device__ __forceinline__ bf16_t* AC() const { return (bf16_t*)(a.ws + WS_AC); }
    __device__ __forceinline__ bf16_t* V() const { return (bf16_t*)(a.ws + WS_V); }
    __device__ __forceinline__ bf16_t* GB() const { return (bf16_t*)(a.ws + WS_GB); }
    __device__ __forceinline__ bf16_t* MM() const { return (bf16_t*)(a.ws + WS_MM); }
    __device__ __forceinline__ bf16_t* XS() const { return (bf16_t*)(a.ws + WS_XS); }
    __device__ __forceinline__ bf16_t* ACT() const { return (bf16_t*)(a.ws + WS_ACT); }
    __device__ __forceinline__ bf16_t* YE() const { return (bf16_t*)(a.ws + WS_YE); }
};

__device__ __forceinline__ float* xrow(const P& p, int r) { return r < RL ? p.out() + (size_t)r * D : p.XC() + (size_t)(r - RL) * D; }
__device__ __forceinline__ int modrow(int r) { return r < RL ? (r >> 12) : 8; }

namespace pg8 {
#define PG8_LAS __attribute__((address_space(3)))
typedef unsigned u32x4 __attribute__((ext_vector_type(4)));
typedef unsigned u32x2 __attribute__((ext_vector_type(2)));
constexpr int BM = 256, BK = 64, HALF = 128, HTB = HALF * BK * 2, STAGE_BYTES = 8 * HTB, NXCD = 8, WGM = 8;
__host__ __device__ __forceinline__ int lds_byte(int r, int c) { const int st = (r >> 4) * 2 + (c >> 5), rr = r & 15, cc = c & 31, ob = rr * 64 + cc * 2; return st * 1024 + (ob ^ (((ob >> 9) & 1) << 5)); }
__host__ __device__ __forceinline__ void stage_rc(int b, int& R, int& C) { const int st = b / 1024, sb = b % 1024, swz = sb ^ (((sb >> 9) & 1) << 5); R = (st >> 1) * 16 + swz / 64; C = (st & 1) * 32 + (swz % 64) / 2; }
__host__ __device__ __forceinline__ int perm32(int rho) { const int n = rho >> 4, i = rho & 15; return 8 * (i >> 2) + 4 * n + (i & 3); }
struct Unit { int pm, pn, aux, pad; size_t a_off, b_off; };
struct Gemm { const bf16_t* A; const bf16_t* Bt; int lda, ldb, K; };

struct GridOrder {
    static constexpr int A_AUX = 0;
    int nM, nN, nwg, G, c; size_t astep, bstep;
    __device__ void init(int M, int N, int G_, int c_, int lda, int ldb) { nM = M / BM; nN = N / BM; nwg = nM * nN; G = G_; c = c_; astep = (size_t)BM * lda * 2; bstep = (size_t)BM * ldb * 2; }
    __device__ bool tile(long Lidx, int& pm, int& pn) const {
        if (Lidx >= nwg) return false;
        int wgid = (int)Lidx; { const int q = nwg / NXCD, r = nwg % NXCD, xcd = wgid % NXCD, off = wgid / NXCD; wgid = (xcd < r ? xcd * (q + 1) : r * (q + 1) + (xcd - r) * q) + off; }
        const int nig = WGM * nN, gid = wgid / nig, fm = gid * WGM, gsz = (nM - fm) < WGM ? (nM - fm) : WGM;
        pm = fm + ((wgid % nig) % gsz); pn = (wgid % nig) / gsz; return true;
    }
    __device__ bool next(int i, Unit& u) const { int pm, pn; if (!tile((long)i * G + c, pm, pn)) return false; u.pm = pm; u.pn = pn; u.aux = 0; u.pad = 0; u.a_off = pm * astep; u.b_off = pn * bstep; return true; }
    __device__ __forceinline__ void a_ready(const Unit&) const {}
    __device__ __forceinline__ void done(const Unit&) const {}
};
struct MergeOrder : GridOrder {
    __device__ int full_tiles() const { return (nwg / G) * G; }
    __device__ bool next(int j, Unit& u) const { int pm, pn, i4, sp = 0; const int ft = full_tiles(), f4 = 4 * (ft / G);
        if (j < f4) { if (!tile((long)(j >> 2) * G + c, pm, pn)) return false; i4 = j & 3; }
        else { const long U = (long)(j - f4) * G + c; if (U >= (long)(nwg - ft) * 4) return false; if (!tile((long)ft + (U >> 2), pm, pn)) return false; i4 = (int)(U & 3); sp = 4; }
        u.pm = pm; u.pn = pn; u.aux = i4 | sp; u.pad = 0;
        u.a_off = pm * astep + (size_t)i4 * 256 * 2; u.b_off = ((size_t)i4 * 1024 + (size_t)pn * 256) * 256 * 2; return true; }
};
struct GateMergeOrder : GridOrder {
    size_t dA, dB;
    __device__ int full_tiles() const { return (nwg / G) * G; }
    __device__ bool next(int j, Unit& u) const { int pm, pn, i4, kind, sp = 0, lt = 0; const int ft = full_tiles(), f8 = 8 * (ft / G);
        if (j < f8) { if (!tile((long)(j >> 3) * G + c, pm, pn)) return false; i4 = (j >> 1) & 3; kind = j & 1; }
        else { const int jj = j - f8; const long U = (long)(jj >> 1) * G + c; if (U >= (long)(nwg - ft) * 4) return false; lt = (int)(U >> 2); if (!tile((long)ft + lt, pm, pn)) return false; i4 = (int)(U & 3); kind = jj & 1; sp = 4; }
        u.pm = pm; u.pn = pn; u.aux = i4 | sp | (kind << 3) | (lt << 4); u.pad = kind ? 16 : 4;
        if (kind) { u.a_off = pm * astep; u.b_off = ((size_t)i4 * 1024 + (size_t)pn * 256) * 1024 * 2; }
        else { u.a_off = dA + pm * astep + (size_t)i4 * 256 * 2; u.b_off = dB + ((size_t)i4 * 1024 + (size_t)pn * 256) * 256 * 2; }
        return true; }
};
struct MoeOrder {
    static constexpr int A_AUX = 0;
    const int* seg; int nN, brows, G, c; size_t astep, bstep_row;
    __device__ void init(const int* seg_, int nN_, int brows_, int G_, int c_, int lda, int ldb) { seg = seg_; nN = nN_; brows = brows_; G = G_; c = c_; astep = (size_t)BM * lda * 2; bstep_row = (size_t)ldb * 2; }
    __device__ bool next(int i, Unit& u) const {
        const long Lidx = (long)i * G + c; const int ntm = __builtin_amdgcn_readfirstlane(seg[16] >> 8);
        if (Lidx >= (long)ntm * nN) return false;
        const int pm = (int)(Lidx / nN), pn = (int)(Lidx % nN);
        int e = 0;
#pragma unroll
        for (int k = 1; k < 16; ++k) if ((seg[k] >> 8) <= pm) e = k;
        e = __builtin_amdgcn_readfirstlane(e);
        u.pm = pm; u.pn = pn; u.aux = e; u.pad = 0; u.a_off = pm * astep; u.b_off = ((size_t)e * brows + (size_t)pn * 256) * bstep_row; return true;
    }
    __device__ __forceinline__ void a_ready(const Unit&) const {}
    __device__ __forceinline__ void done(const Unit&) const {}
};
struct Moe1Order : MoeOrder {
    unsigned* flags;
    __device__ __forceinline__ void done(const Unit& u) const { asm volatile("s_waitcnt vmcnt(0)" ::: "memory"); if ((threadIdx.x & 63) == 0) (void)xb_add(flags + u.pm, 1u); }
};
struct Moe2Order : MoeOrder {
    static constexpr int A_AUX = 16;
    unsigned* flags; unsigned* bar;
    int r1;
    __device__ bool next(int i, Unit& u) const {
        const int Lg = G - r1; long U;
        if (c < r1) U = 2L * Lg + (long)i * G + c;
        else U = i < 2 ? (long)i * Lg + (c - r1) : 2L * Lg + (long)(i - 2) * G + c;
        const int ntm = __builtin_amdgcn_readfirstlane(seg[16] >> 8);
        if (U >= (long)ntm * nN) return false;
        const int pm = (int)(U / nN), pn = (int)(U % nN);
        int e = 0;
#pragma unroll
        for (int k = 1; k < 16; ++k) if ((seg[k] >> 8) <= pm) e = k;
        e = __builtin_amdgcn_readfirstlane(e);
        u.pm = pm; u.pn = pn; u.aux = e; u.pad = 0; u.a_off = pm * astep; u.b_off = ((size_t)e * brows + (size_t)pn * 256) * bstep_row; return true;
    }
    __device__ __forceinline__ void a_ready(const Unit& u) const {
        unsigned sp = 0u;
        for (;;) { const unsigned v = __builtin_amdgcn_readfirstlane(xb_ld(flags + u.pm)); if (v >= 16u) break; __builtin_amdgcn_s_sleep(1);
            if ((++sp & 255u) == 0u) { if (xb_ld(&bar[XB_TMO])) break; if (sp > XB_SPIN_CAP) { atomicAdd(&bar[XB_TMO], 1u); break; } } }
    }
};
typedef __bf16 bf16v2_t __attribute__((ext_vector_type(2)));
struct S5Order {
    static constexpr int A_AUX = 0;
    int G, c; size_t bgstride;
    __device__ void init(int G_, int c_, size_t bgstride_) { G = G_; c = c_; bgstride = bgstride_; }
    __device__ bool next(int i, Unit& u) const { const long Lidx = (long)i * G + c; if (Lidx >= 144) return false; const int g = (int)Lidx / 9, pm = (int)Lidx % 9;
        u.pm = pm; u.pn = 0; u.aux = g; u.pad = 0; u.a_off = ((size_t)g * 2304 + (size_t)pm * 256) * 512 * 2; u.b_off = (size_t)g * bgstride; return true; }
    __device__ __forceinline__ void a_ready(const Unit&) const {}
    __device__ __forceinline__ void done(const Unit&) const {}
};
struct S5FlowOrder : S5Order {
    static constexpr int A_AUX = 16;
    unsigned* flag; unsigned* bar;
    __device__ __forceinline__ void a_ready(const Unit&) const {
        unsigned sp = 0u;
        for (;;) { const unsigned v = __builtin_amdgcn_readfirstlane(xb_ld(flag)); if (v >= 32u) break; __builtin_amdgcn_s_sleep(1);
            if ((++sp & 255u) == 0u) { if (xb_ld(&bar[XB_TMO])) break; if (sp > XB_SPIN_CAP) { atomicAdd(&bar[XB_TMO], 1u); break; } } }
    }
};
__device__ __forceinline__ unsigned cvt_pk_bf16(float lo, float hi) { const bf16v2_t v = {(__bf16)lo, (__bf16)hi}; return __builtin_bit_cast(unsigned, v); }
template <class Epi, class Sched>
__device__ __forceinline__ void gemm_phase(PG8_LAS unsigned char* lds, const Gemm g, const Sched& S, const Epi& E) {
    const int tid = threadIdx.x, wid = __builtin_amdgcn_readfirstlane(tid >> 6), lane = tid & 63, wr = wid >> 2, wc = wid & 3, fr = lane & 15, fq = lane >> 4;
    int K_ = g.K; asm volatile("" : "+s"(K_));
    const int K = K_, nt = K / BK;
    unsigned voffA[2], voffB[2];
#pragma unroll
    for (int i = 0; i < 2; ++i) { int R, C; stage_rc(tid * 16 + i * 8192, R, C); const int Rb = Epi::PERM ? ((R & ~31) + perm32(R & 31)) : R;
        voffA[i] = (unsigned)(R * g.lda + C) * 2u; voffB[i] = (unsigned)(Rb * g.ldb + C) * 2u; }
    const size_t kstep = (size_t)(BK * 2);
    const size_t hstepA = (size_t)HALF * g.lda * 2, hstepB = (size_t)HALF * g.ldb * 2;
    const unsigned ldsw = (unsigned)wid * 1024u;
    const int aoff = lds_byte(wr * 64 + fr, fq * 8), boff = lds_byte(wc * 32 + fr, fq * 8);
#define PG8_SA(b, h) (((b) * 2 + (h)) * HTB)
#define PG8_SB(b, h) ((4 + (b) * 2 + (h)) * HTB)
#define PG8_STAGE(bufoff, gbase, voff) do { _Pragma("unroll") for (int _i = 0; _i < 2; ++_i) \
        __builtin_amdgcn_global_load_lds((const unsigned*)((const char*)(gbase) + (voff)[_i]), (PG8_LAS unsigned*)(lds + (bufoff) + ldsw + _i * 8192), 16, 0, 0); } while (0)
#define PG8_STAGE_A(bufoff, gbase, voff) do { _Pragma("unroll") for (int _i = 0; _i < 2; ++_i) \
        __builtin_amdgcn_global_load_lds((const unsigned*)((const char*)(gbase) + (voff)[_i]), (PG8_LAS unsigned*)(lds + (bufoff) + ldsw + _i * 8192), 16, 0, Sched::A_AUX); } while (0)
#define PG8_LDA(dst, b, h) do { _Pragma("unroll") for (int m = 0; m < 4; ++m) _Pragma("unroll") for (int k = 0; k < 2; ++k) dst[m][k] = *(const PG8_LAS bf16x8*)(lds + PG8_SA(b, h) + aoff + m * 2048 + k * 1024); } while (0)
#define PG8_LDB(dst, b, h) do { _Pragma("unroll") for (int n = 0; n < 2; ++n) _Pragma("unroll") for (int k = 0; k < 2; ++k) dst[n][k] = *(const PG8_LAS bf16x8*)(lds + PG8_SB(b, h) + boff + n * 2048 + k * 1024); } while (0)
#define PG8_MMA(ai, bj, At, Bt) do { __builtin_amdgcn_s_setprio(1); _Pragma("unroll") for (int m = 0; m < 4; ++m) _Pragma("unroll") for (int n = 0; n < 2; ++n) _Pragma("unroll") for (int k = 0; k < 2; ++k) \
        acc[ai][bj][m][n] = __builtin_amdgcn_mfma_f32_16x16x32_bf16(Bt[n][k], At[m][k], acc[ai][bj][m][n], 0, 0, 0); __builtin_amdgcn_s_setprio(0); } while (0)
#define PG8_WAIT_V(n) asm volatile("s_waitcnt vmcnt(" #n ")" ::: "memory")
#define PG8_WAIT_L(n) asm volatile("s_waitcnt lgkmcnt(" #n ")" ::: "memory")
#define PG8_BAR __builtin_amdgcn_s_barrier()
#define PG8_SCHED __builtin_amdgcn_sched_barrier(0)
    Unit cur, nxt; int ui = 0;
    if (!S.next(0, cur)) return;
    f32x4 acc[2][2][4][2];
#pragma unroll
    for (int a = 0; a < 2; ++a)
#pragma unroll
        for (int b = 0; b < 2; ++b)
#pragma unroll
            for (int m = 0; m < 4; ++m)
#pragma unroll
                for (int n = 0; n < 2; ++n) acc[a][b][m][n] = (f32x4){0.f, 0.f, 0.f, 0.f};
    bf16x8 At[4][2], B0[2][2], B1[2][2];
    const char* cA = (const char*)g.A + cur.a_off; const char* cB = (const char*)g.Bt + cur.b_off;
    S.a_ready(cur);
    PG8_STAGE(PG8_SB(0, 0), cB, voffB); PG8_STAGE_A(PG8_SA(0, 0), cA, voffA); PG8_STAGE(PG8_SB(0, 1), cB + hstepB, voffB); PG8_STAGE_A(PG8_SA(0, 1), cA + hstepA, voffA);
    if (wr == 1) PG8_BAR;
    PG8_WAIT_V(4); PG8_BAR;
    PG8_STAGE(PG8_SB(1, 0), cB + kstep, voffB); PG8_STAGE_A(PG8_SA(1, 0), cA + kstep, voffA); PG8_STAGE(PG8_SB(1, 1), cB + hstepB + kstep, voffB);
    PG8_WAIT_V(6); PG8_BAR;
    for (;;) {
        const bool has_next = S.next(ui + 1, nxt);
        const char* nA = has_next ? (const char*)g.A + nxt.a_off : cA; const char* nB = has_next ? (const char*)g.Bt + nxt.b_off : cB;
        for (int t = 0; t < nt; t += 2) {
            const bool last = (t == nt - 2);
            const char* a1 = cA + (size_t)(t + 1) * kstep;
            const char* a2 = last ? nA : cA + (size_t)(t + 2) * kstep; const char* b2 = last ? nB : cB + (size_t)(t + 2) * kstep;
            const char* a3 = a2 + kstep; const char* b3 = b2 + kstep;
            if (last && has_next) S.a_ready(nxt);
            PG8_LDB(B0, 0, 0); PG8_SCHED; PG8_LDA(At, 0, 0); PG8_STAGE_A(PG8_SA(1, 1), a1 + hstepA, voffA);
            PG8_WAIT_L(8); PG8_BAR; PG8_WAIT_L(0); PG8_MMA(0, 0, At, B0); PG8_BAR; PG8_SCHED;
            PG8_LDB(B1, 0, 1); PG8_STAGE(PG8_SB(0, 0), b2, voffB);
            PG8_BAR; PG8_WAIT_L(0); PG8_MMA(0, 1, At, B1); PG8_BAR;
            PG8_LDA(At, 0, 1); PG8_STAGE_A(PG8_SA(0, 0), a2, voffA);
            PG8_BAR; PG8_WAIT_L(0); PG8_MMA(1, 0, At, B0); PG8_BAR; PG8_SCHED;
            PG8_STAGE(PG8_SB(0, 1), b2 + hstepB, voffB);
            PG8_WAIT_V(6); PG8_BAR; PG8_MMA(1, 1, At, B1); PG8_BAR;
            PG8_LDB(B0, 1, 0); PG8_SCHED; PG8_LDA(At, 1, 0); PG8_STAGE_A(PG8_SA(0, 1), a2 + hstepA, voffA);
            PG8_WAIT_L(8); PG8_BAR; PG8_WAIT_L(0); PG8_MMA(0, 0, At, B0); PG8_BAR; PG8_SCHED;
            PG8_LDB(B1, 1, 1); PG8_STAGE(PG8_SB(1, 0), b3, voffB);
            PG8_BAR; PG8_WAIT_L(0); PG8_MMA(0, 1, At, B1); PG8_BAR;
            PG8_LDA(At, 1, 1); PG8_STAGE_A(PG8_SA(1, 0), a3, voffA);
            PG8_BAR; PG8_WAIT_L(0); PG8_MMA(1, 0, At, B0); PG8_BAR; PG8_SCHED;
            PG8_STAGE(PG8_SB(1, 1), b3 + hstepB, voffB);
            PG8_WAIT_V(6); PG8_BAR; PG8_MMA(1, 1, At, B1); PG8_BAR;
        }
        if constexpr (!Epi::AFTER_DRAIN) { E(acc, cur, wr, wc, fr, fq); S.done(cur); }
        if (!has_next) break;
#pragma unroll
        for (int a = 0; a < 2; ++a)
#pragma unroll
            for (int b = 0; b < 2; ++b)
#pragma unroll
                for (int m = 0; m < 4; ++m)
#pragma unroll
                    for (int n = 0; n < 2; ++n) acc[a][b][m][n] = (f32x4){0.f, 0.f, 0.f, 0.f};
        cur = nxt; cA = nA; cB = nB; ++ui;
    }
    PG8_WAIT_V(0);
    if (wr == 0) PG8_BAR;
    PG8_BAR;
    if constexpr (Epi::AFTER_DRAIN) { E.fused(acc, cur, wr, wc, fr, fq, lds, wid, lane); S.done(cur); }
#undef PG8_SA
#undef PG8_SB
#undef PG8_STAGE
#undef PG8_STAGE_A
#undef PG8_LDA
#undef PG8_LDB
#undef PG8_MMA
#undef PG8_WAIT_V
#undef PG8_WAIT_L
#undef PG8_BAR
#undef PG8_SCHED
}

template <class Epi, class Sched>
__device__ __forceinline__ void gemm_phase_gm(PG8_LAS unsigned char* lds, const Gemm g, const Sched& S, const Epi& E) {
    const int tid = threadIdx.x, wid = __builtin_amdgcn_readfirstlane(tid >> 6), lane = tid & 63, wr = wid >> 2, wc = wid & 3, fr = lane & 15, fq = lane >> 4;
    (void)g.K;
    unsigned voffA[2], voffBP[2], voffBG[2];
#pragma unroll
    for (int i = 0; i < 2; ++i) { int R, C; stage_rc(tid * 16 + i * 8192, R, C); const int Rb = Epi::PERM ? ((R & ~31) + perm32(R & 31)) : R;
        voffA[i] = (unsigned)(R * g.lda + C) * 2u; voffBP[i] = (unsigned)(Rb * 256 + C) * 2u; voffBG[i] = (unsigned)(Rb * 1024 + C) * 2u; }
    const size_t kstep = (size_t)(BK * 2);
    const size_t hstepA = (size_t)HALF * g.lda * 2, hstepBP = (size_t)HALF * 256 * 2, hstepBG = (size_t)HALF * 1024 * 2;
    const unsigned ldsw = (unsigned)wid * 1024u;
    const int aoff = lds_byte(wr * 64 + fr, fq * 8), boff = lds_byte(wc * 32 + fr, fq * 8);
#define PG8_SA(b, h) (((b) * 2 + (h)) * HTB)
#define PG8_SB(b, h) ((4 + (b) * 2 + (h)) * HTB)
#define PG8_STAGE(bufoff, gbase, voff) do { _Pragma("unroll") for (int _i = 0; _i < 2; ++_i) \
        __builtin_amdgcn_global_load_lds((const unsigned*)((const char*)(gbase) + (voff)[_i]), (PG8_LAS unsigned*)(lds + (bufoff) + ldsw + _i * 8192), 16, 0, 0); } while (0)
#define PG8_STAGE_A(bufoff, gbase, voff) do { _Pragma("unroll") for (int _i = 0; _i < 2; ++_i) \
        __builtin_amdgcn_global_load_lds((const unsigned*)((const char*)(gbase) + (voff)[_i]), (PG8_LAS unsigned*)(lds + (bufoff) + ldsw + _i * 8192), 16, 0, Sched::A_AUX); } while (0)
#define PG8_LDA(dst, b, h) do { _Pragma("unroll") for (int m = 0; m < 4; ++m) _Pragma("unroll") for (int k = 0; k < 2; ++k) dst[m][k] = *(const PG8_LAS bf16x8*)(lds + PG8_SA(b, h) + aoff + m * 2048 + k * 1024); } while (0)
#define PG8_LDB(dst, b, h) do { _Pragma("unroll") for (int n = 0; n < 2; ++n) _Pragma("unroll") for (int k = 0; k < 2; ++k) dst[n][k] = *(const PG8_LAS bf16x8*)(lds + PG8_SB(b, h) + boff + n * 2048 + k * 1024); } while (0)
#define PG8_MMA(ai, bj, At, Bt) do { __builtin_amdgcn_s_setprio(1); _Pragma("unroll") for (int m = 0; m < 4; ++m) _Pragma("unroll") for (int n = 0; n < 2; ++n) _Pragma("unroll") for (int k = 0; k < 2; ++k) \
        acc[ai][bj][m][n] = __builtin_amdgcn_mfma_f32_16x16x32_bf16(Bt[n][k], At[m][k], acc[ai][bj][m][n], 0, 0, 0); __builtin_amdgcn_s_setprio(0); } while (0)
#define PG8_WAIT_V(n) asm volatile("s_waitcnt vmcnt(" #n ")" ::: "memory")
#define PG8_WAIT_L(n) asm volatile("s_waitcnt lgkmcnt(" #n ")" ::: "memory")
#define PG8_BAR __builtin_amdgcn_s_barrier()
#define PG8_SCHED __builtin_amdgcn_sched_barrier(0)
    Unit cur, nxt; int ui = 0;
    if (!S.next(0, cur)) return;
    f32x4 acc[2][2][4][2];
#pragma unroll
    for (int a = 0; a < 2; ++a)
#pragma unroll
        for (int b = 0; b < 2; ++b)
#pragma unroll
            for (int m = 0; m < 4; ++m)
#pragma unroll
                for (int n = 0; n < 2; ++n) acc[a][b][m][n] = (f32x4){0.f, 0.f, 0.f, 0.f};
    bf16x8 At[4][2], B0[2][2], B1[2][2];
    const char* cA = (const char*)g.A + cur.a_off; const char* cB = (const char*)g.Bt + cur.b_off;
    S.a_ready(cur);
    unsigned voffB[2]; size_t hstepB;
    { const bool kg = (cur.aux & 8) != 0; voffB[0] = kg ? voffBG[0] : voffBP[0]; voffB[1] = kg ? voffBG[1] : voffBP[1]; hstepB = kg ? hstepBG : hstepBP; }
    PG8_STAGE(PG8_SB(0, 0), cB, voffB); PG8_STAGE_A(PG8_SA(0, 0), cA, voffA); PG8_STAGE(PG8_SB(0, 1), cB + hstepB, voffB); PG8_STAGE_A(PG8_SA(0, 1), cA + hstepA, voffA);
    if (wr == 1) PG8_BAR;
    PG8_WAIT_V(4); PG8_BAR;
    PG8_STAGE(PG8_SB(1, 0), cB + kstep, voffB); PG8_STAGE_A(PG8_SA(1, 0), cA + kstep, voffA); PG8_STAGE(PG8_SB(1, 1), cB + hstepB + kstep, voffB);
    PG8_WAIT_V(6); PG8_BAR;
    for (;;) {
        const bool has_next = S.next(ui + 1, nxt);
        const char* nA = has_next ? (const char*)g.A + nxt.a_off : cA; const char* nB = has_next ? (const char*)g.Bt + nxt.b_off : cB;
        int nt_ = cur.pad; asm volatile("" : "+s"(nt_)); const int nt = nt_;
        const bool ckg = (cur.aux & 8) != 0, nkg = has_next ? ((nxt.aux & 8) != 0) : ckg;
        for (int t = 0; t < nt; t += 2) {
            const bool last = (t == nt - 2);
            { const bool kg = last ? nkg : ckg;
              voffB[0] = kg ? voffBG[0] : voffBP[0]; voffB[1] = kg ? voffBG[1] : voffBP[1]; hstepB = kg ? hstepBG : hstepBP; }
            const char* a1 = cA + (size_t)(t + 1) * kstep;
            const char* a2 = last ? nA : cA + (size_t)(t + 2) * kstep; const char* b2 = last ? nB : cB + (size_t)(t + 2) * kstep;
            const char* a3 = a2 + kstep; const char* b3 = b2 + kstep;
            if (last && has_next) S.a_ready(nxt);
            PG8_LDB(B0, 0, 0); PG8_SCHED; PG8_LDA(At, 0, 0); PG8_STAGE_A(PG8_SA(1, 1), a1 + hstepA, voffA);
            PG8_WAIT_L(8); PG8_BAR; PG8_WAIT_L(0); PG8_MMA(0, 0, At, B0); PG8_BAR; PG8_SCHED;
            PG8_LDB(B1, 0, 1); PG8_STAGE(PG8_SB(0, 0), b2, voffB);
            PG8_BAR; PG8_WAIT_L(0); PG8_MMA(0, 1, At, B1); PG8_BAR;
            PG8_LDA(At, 0, 1); PG8_STAGE_A(PG8_SA(0, 0), a2, voffA);
            PG8_BAR; PG8_WAIT_L(0); PG8_MMA(1, 0, At, B0); PG8_BAR; PG8_SCHED;
            PG8_STAGE(PG8_SB(0, 1), b2 + hstepB, voffB);
            PG8_WAIT_V(6); PG8_BAR; PG8_MMA(1, 1, At, B1); PG8_BAR;
            PG8_LDB(B0, 1, 0); PG8_SCHED; PG8_LDA(At, 1, 0); PG8_STAGE_A(PG8_SA(0, 1), a2 + hstepA, voffA);
            PG8_WAIT_L(8); PG8_BAR; PG8_WAIT_L(0); PG8_MMA(0, 0, At, B0); PG8_BAR; PG8_SCHED;
            PG8_LDB(B1, 1, 1); PG8_STAGE(PG8_SB(1, 0), b3, voffB);
            PG8_BAR; PG8_WAIT_L(0); PG8_MMA(0, 1, At, B1); PG8_BAR;
            PG8_LDA(At, 1, 1); PG8_STAGE_A(PG8_SA(1, 0), a3, voffA);
            PG8_BAR; PG8_WAIT_L(0); PG8_MMA(1, 0, At, B0); PG8_BAR; PG8_SCHED;
            PG8_STAGE(PG8_SB(1, 1), b3 + hstepB, voffB);
            PG8_WAIT_V(6); PG8_BAR; PG8_MMA(1, 1, At, B1); PG8_BAR;
        }
        if constexpr (!Epi::AFTER_DRAIN) { E(acc, cur, wr, wc, fr, fq); S.done(cur); }
        if (!has_next) break;
#pragma unroll
        for (int a = 0; a < 2; ++a)
#pragma unroll
            for (int b = 0; b < 2; ++b)
#pragma unroll
                for (int m = 0; m < 4; ++m)
#pragma unroll
                    for (int n = 0; n < 2; ++n) acc[a][b][m][n] = (f32x4){0.f, 0.f, 0.f, 0.f};
        cur = nxt; cA = nA; cB = nB; ++ui;
    }
    PG8_WAIT_V(0);
    if (wr == 0) PG8_BAR;
    PG8_BAR;
    if constexpr (Epi::AFTER_DRAIN) { E.fused(acc, cur, wr, wc, fr, fq, lds, wid, lane); S.done(cur); }
#undef PG8_SA
#undef PG8_SB
#undef PG8_STAGE
#undef PG8_STAGE_A
#undef PG8_LDA
#undef PG8_LDB
#undef PG8_MMA
#undef PG8_WAIT_V
#undef PG8_WAIT_L
#undef PG8_BAR
#undef PG8_SCHED
}
}

struct EpiStoreBf16 {
    static constexpr bool PERM = true, AFTER_DRAIN = false;
    bf16_t* O; int ldc; int act; size_t aux_stride; bf16_t* ac;
    __device__ __forceinline__ void operator()(const f32x4 (&acc)[2][2][4][2], const pg8::Unit& u, int wr_, int wc_, int fr_, int fq_) const {
        int t_ = threadIdx.x; asm volatile("" : "+v"(t_)); const int fr = t_ & 15, fq = (t_ >> 4) & 3, wc = (t_ >> 6) & 3, wr = t_ >> 8; (void)wr_; (void)wc_; (void)fr_; (void)fq_;
        const int row0 = u.pm * 256 + wr * 64 + fr, col0 = u.pn * 256 + wc * 32 + 8 * fq;
#pragma unroll
        for (int ai = 0; ai < 2; ++ai)
#pragma unroll
            for (int m = 0; m < 4; ++m) { const int r = row0 + ai * 128 + m * 16; bf16_t* rowp = O + (size_t)u.aux * aux_stride + (size_t)r * ldc + col0;
#pragma unroll
                for (int bj = 0; bj < 2; ++bj) { f32x4 v0 = acc[ai][bj][m][0], v1 = acc[ai][bj][m][1];
                    if (act == 1) {
#pragma unroll
                        for (int j = 0; j < 4; ++j) { v0[j] = sigm(v0[j]); v1[j] = sigm(v1[j]); } }
                    pg8::u32x4 w; w.x = pg8::cvt_pk_bf16(v0[0], v0[1]); w.y = pg8::cvt_pk_bf16(v0[2], v0[3]); w.z = pg8::cvt_pk_bf16(v1[0], v1[1]); w.w = pg8::cvt_pk_bf16(v1[2], v1[3]);
                    *(pg8::u32x4*)(rowp + bj * 128) = w;
                    if (ac) { const int c = col0 + bj * 128;
                        if (c >= PC_S5 && c < PC_S5 + 256) { const int g = (c - PC_S5) >> 4, h0 = (c - PC_S5) & 15; int b, s;
                            if (r < RL) { b = r >> 12; const int l = r & 4095; s = LC + (l & 63) * 64 + (l >> 6); } else { const int rr = r - RL; b = rr >> 8; s = rr & 255; }
                            *(pg8::u32x4*)(ac + ((size_t)g * S5ROWS + b * 272 + (s >> 4)) * 512 + (s & 15) * 16 + h0) = w; } } } }
    }
};
struct EpiMergeY {
    static constexpr bool PERM = true, AFTER_DRAIN = false;
    bf16_t* GB; bf16_t* M;
    template <bool LAST>
    __device__ __forceinline__ void run(const f32x4 (&acc)[2][2][4][2], const pg8::Unit& u, int row0, int col0) const {
        uint4 g[2][4][2];
        const unsigned e0 = (unsigned)row0 * 4096u + (unsigned)((u.aux & 3) * 1024 + col0), em = (unsigned)row0 * 1024u + (unsigned)col0;
#pragma unroll
        for (int ai = 0; ai < 2; ++ai)
#pragma unroll
            for (int m = 0; m < 4; ++m)
#pragma unroll
                for (int bj = 0; bj < 2; ++bj) g[ai][m][bj] = *(const uint4*)(GB + (size_t)(e0 + (unsigned)((ai * 128 + m * 16) * 4096 + bj * 128)));
        asm volatile("" ::: "memory");
        if (!LAST) {
#pragma unroll
            for (int ai = 0; ai < 2; ++ai)
#pragma unroll
                for (int m = 0; m < 4; ++m)
#pragma unroll
                    for (int bj = 0; bj < 2; ++bj) { const uint4 q = g[ai][m][bj]; const f32x4 v0 = acc[ai][bj][m][0], v1 = acc[ai][bj][m][1];
                        pg8::u32x4 w; w.x = pg8::cvt_pk_bf16(lo2f(q.x) * v0[0], hi2f(q.x) * v0[1]); w.y = pg8::cvt_pk_bf16(lo2f(q.y) * v0[2], hi2f(q.y) * v0[3]);
                        w.z = pg8::cvt_pk_bf16(lo2f(q.z) * v1[0], hi2f(q.z) * v1[1]); w.w = pg8::cvt_pk_bf16(lo2f(q.w) * v1[2], hi2f(q.w) * v1[3]);
                        *(pg8::u32x4*)(GB + (size_t)(e0 + (unsigned)((ai * 128 + m * 16) * 4096 + bj * 128))) = w; }
        } else {
            f32x4 o[2][4][2][2];
#pragma unroll
            for (int ai = 0; ai < 2; ++ai)
#pragma unroll
                for (int m = 0; m < 4; ++m)
#pragma unroll
                    for (int bj = 0; bj < 2; ++bj) { const uint4 q = g[ai][m][bj]; const f32x4 v0 = acc[ai][bj][m][0], v1 = acc[ai][bj][m][1];
                        o[ai][m][bj][0] = (f32x4){lo2f(q.x) * v0[0], hi2f(q.x) * v0[1], lo2f(q.y) * v0[2], hi2f(q.y) * v0[3]};
                        o[ai][m][bj][1] = (f32x4){lo2f(q.z) * v1[0], hi2f(q.z) * v1[1], lo2f(q.w) * v1[2], hi2f(q.w) * v1[3]}; }
#pragma unroll 1
            for (int t = 0; t < 3; ++t) {
                asm volatile("" ::: "memory");
                const unsigned et = (unsigned)row0 * 4096u + (unsigned)(t * 1024 + col0);
#pragma unroll
                for (int ai = 0; ai < 2; ++ai)
#pragma unroll
                    for (int m = 0; m < 4; ++m)
#pragma unroll
                        for (int bj = 0; bj < 2; ++bj) g[ai][m][bj] = *(const uint4*)(GB + (size_t)(et + (unsigned)((ai * 128 + m * 16) * 4096 + bj * 128)));
                asm volatile("" ::: "memory");
#pragma unroll
                for (int ai = 0; ai < 2; ++ai)
#pragma unroll
                    for (int m = 0; m < 4; ++m)
#pragma unroll
                        for (int bj = 0; bj < 2; ++bj) { const uint4 q = g[ai][m][bj];
                            o[ai][m][bj][0] += (f32x4){lo2f(q.x), hi2f(q.x), lo2f(q.y), hi2f(q.y)}; o[ai][m][bj][1] += (f32x4){lo2f(q.z), hi2f(q.z), lo2f(q.w), hi2f(q.w)}; }
            }
#pragma unroll
            for (int ai = 0; ai < 2; ++ai)
#pragma unroll
                for (int m = 0; m < 4; ++m)
#pragma unroll
                    for (int bj = 0; bj < 2; ++bj) { const f32x4 a0 = o[ai][m][bj][0], a1 = o[ai][m][bj][1];
                        pg8::u32x4 w; w.x = pg8::cvt_pk_bf16(a0[0], a0[1]); w.y = pg8::cvt_pk_bf16(a0[2], a0[3]); w.z = pg8::cvt_pk_bf16(a1[0], a1[1]); w.w = pg8::cvt_pk_bf16(a1[2], a1[3]);
                        *(pg8::u32x4*)(M + (size_t)(em + (unsigned)((ai * 128 + m * 16) * 1024 + bj * 128))) = w; }
        }
    }
    __device__ __forceinline__ void operator()(const f32x4 (&acc)[2][2][4][2], const pg8::Unit& u, int wr_, int wc_, int fr_, int fq_) const {
        int t_ = threadIdx.x; asm volatile("" : "+v"(t_)); const int fr = t_ & 15, fq = (t_ >> 4) & 3, wc = (t_ >> 6) & 3, wr = t_ >> 8; (void)wr_; (void)wc_; (void)fr_; (void)fq_;
        const int row0 = u.pm * 256 + wr * 64 + fr, col0 = u.pn * 256 + wc * 32 + 8 * fq;
        if (u.aux == 3) run<true>(acc, u, row0, col0); else run<false>(acc, u, row0, col0);
    }
};
struct EpiGateMerge {
    static constexpr bool PERM = true, AFTER_DRAIN = false;
    unsigned char* scrP; unsigned char* scrS; bf16_t* TL; bf16_t* M;
    __device__ __forceinline__ void operator()(const f32x4 (&acc)[2][2][4][2], const pg8::Unit& u, int wr_, int wc_, int fr_, int fq_) const {
        int t_ = threadIdx.x; asm volatile("" : "+v"(t_)); const int fr = t_ & 15, fq = (t_ >> 4) & 3, wc = (t_ >> 6) & 3, wr = t_ >> 8; (void)wr_; (void)wc_; (void)fr_; (void)fq_;
        const unsigned lo = (unsigned)blockIdx.x * 131072u + (unsigned)t_ * 16u;
        if (!(u.aux & 8)) {
#pragma unroll
            for (int ai = 0; ai < 2; ++ai)
#pragma unroll
                for (int m = 0; m < 4; ++m)
#pragma unroll
                    for (int bj = 0; bj < 2; ++bj) { const f32x4 v0 = acc[ai][bj][m][0], v1 = acc[ai][bj][m][1];
                        pg8::u32x4 w; w.x = pg8::cvt_pk_bf16(v0[0], v0[1]); w.y = pg8::cvt_pk_bf16(v0[2], v0[3]); w.z = pg8::cvt_pk_bf16(v1[0], v1[1]); w.w = pg8::cvt_pk_bf16(v1[2], v1[3]);
                        *(pg8::u32x4*)(scrP + (size_t)(lo + (unsigned)(((ai * 4 + m) * 2 + bj) * 8192))) = w; }
            return;
        }
        const int br = u.aux & 3; const bool spread = (u.aux & 4) != 0, addS = !spread && br != 0;
        const int lr0 = wr * 64 + fr, lc0 = wc * 32 + 8 * fq;
        unsigned char* dbase; unsigned dstep_m, dstep_ai, dstep_bj, d0;
        if (spread) { dbase = (unsigned char*)TL; d0 = ((unsigned)(((u.aux >> 4) * 4 + br) * 65536 + lr0 * 256 + lc0)) * 2u; dstep_m = 16 * 256 * 2; dstep_ai = 128 * 256 * 2; dstep_bj = 128 * 2; }
        else if (br == 3) { dbase = (unsigned char*)M; d0 = ((unsigned)(u.pm * 256 + lr0) * 1024u + (unsigned)(u.pn * 256 + lc0)) * 2u; dstep_m = 16 * 1024 * 2; dstep_ai = 128 * 1024 * 2; dstep_bj = 128 * 2; }
        else { dbase = scrS; d0 = lo; dstep_m = 2 * 8192; dstep_ai = 8 * 8192; dstep_bj = 8192; }
#pragma unroll
        for (int ai = 0; ai < 2; ++ai) {
            uint4 g[4][2];
#pragma unroll
            for (int m = 0; m < 4; ++m)
#pragma unroll
                for (int bj = 0; bj < 2; ++bj) g[m][bj] = *(const uint4*)(scrP + (size_t)(lo + (unsigned)(((ai * 4 + m) * 2 + bj) * 8192)));
            asm volatile("" ::: "memory");
            f32x4 o[4][2][2];
#pragma unroll
            for (int m = 0; m < 4; ++m)
#pragma unroll
                for (int bj = 0; bj < 2; ++bj) { const uint4 q = g[m][bj]; const f32x4 v0 = acc[ai][bj][m][0], v1 = acc[ai][bj][m][1];
                    o[m][bj][0] = (f32x4){sigm(v0[0]) * lo2f(q.x), sigm(v0[1]) * hi2f(q.x), sigm(v0[2]) * lo2f(q.y), sigm(v0[3]) * hi2f(q.y)};
                    o[m][bj][1] = (f32x4){sigm(v1[0]) * lo2f(q.z), sigm(v1[1]) * hi2f(q.z), sigm(v1[2]) * lo2f(q.w), sigm(v1[3]) * hi2f(q.w)}; }
            if (addS) {
                asm volatile("" ::: "memory");
#pragma unroll
                for (int m = 0; m < 4; ++m)
#pragma unroll
                    for (int bj = 0; bj < 2; ++bj) g[m][bj] = *(const uint4*)(scrS + (size_t)(lo + (unsigned)(((ai * 4 + m) * 2 + bj) * 8192)));
                asm volatile("" ::: "memory");
#pragma unroll
                for (int m = 0; m < 4; ++m)
#pragma unroll
                    for (int bj = 0; bj < 2; ++bj) { const uint4 q = g[m][bj];
                        o[m][bj][0] += (f32x4){lo2f(q.x), hi2f(q.x), lo2f(q.y), hi2f(q.y)}; o[m][bj][1] += (f32x4){lo2f(q.z), hi2f(q.z), lo2f(q.w), hi2f(q.w)}; }
            }
#pragma unroll
            for (int m = 0; m < 4; ++m)
#pragma unroll
                for (int bj = 0; bj < 2; ++bj) { const f32x4 a0 = o[m][bj][0], a1 = o[m][bj][1];
                    pg8::u32x4 w; w.x = pg8::cvt_pk_bf16(a0[0], a0[1]); w.y = pg8::cvt_pk_bf16(a0[2], a0[3]); w.z = pg8::cvt_pk_bf16(a1[0], a1[1]); w.w = pg8::cvt_pk_bf16(a1[2], a1[3]);
                    *(pg8::u32x4*)(dbase + (size_t)(d0 + (unsigned)ai * dstep_ai + (unsigned)m * dstep_m + (unsigned)bj * dstep_bj)) = w; }
            asm volatile("" ::: "memory");
        }
    }
};
struct EpiOut {
    static constexpr bool PERM = false, AFTER_DRAIN = false;
    float* xl; float* xc; const float* mod;
    __device__ __forceinline__ void operator()(const f32x4 (&acc)[2][2][4][2], const pg8::Unit& u, int wr_, int wc_, int fr_, int fq_) const {
        int t_ = threadIdx.x; asm volatile("" : "+v"(t_)); const int fr = t_ & 15, fq = (t_ >> 4) & 3, wc = (t_ >> 6) & 3, wr = t_ >> 8; (void)wr_; (void)wc_; (void)fr_; (void)fq_;
        const int tr = u.pm * 256, col0 = u.pn * 256 + wc * 32 + 4 * fq;
        float* xb = tr < RL ? xl : xc - (size_t)RL * D; const float* gr = mod + (size_t)modrow(tr) * 6144 + col0;
        const unsigned e0 = (unsigned)(tr + wr * 64 + fr) * (unsigned)D + (unsigned)col0;
        f32x4 g[2][2];
#pragma unroll
        for (int bj = 0; bj < 2; ++bj)
#pragma unroll
            for (int n = 0; n < 2; ++n) g[bj][n] = *(const f32x4*)(gr + bj * 128 + n * 16);
#pragma unroll
        for (int ai = 0; ai < 2; ++ai) {
            f32x4 x[4][2][2];
#pragma unroll
            for (int m = 0; m < 4; ++m)
#pragma unroll
                for (int bj = 0; bj < 2; ++bj)
#pragma unroll
                    for (int n = 0; n < 2; ++n) x[m][bj][n] = *(const f32x4*)(xb + (size_t)(e0 + (unsigned)((ai * 128 + m * 16) * D + bj * 128 + n * 16)));
            asm volatile("" ::: "memory");
#pragma unroll
            for (int m = 0; m < 4; ++m)
#pragma unroll
                for (int bj = 0; bj < 2; ++bj)
#pragma unroll
                    for (int n = 0; n < 2; ++n) *(f32x4*)(xb + (size_t)(e0 + (unsigned)((ai * 128 + m * 16) * D + bj * 128 + n * 16))) = x[m][bj][n] + g[bj][n] * acc[ai][bj][m][n];
            asm volatile("" ::: "memory"); }
    }
};
struct EpiMoe1 {
    static constexpr bool PERM = false, AFTER_DRAIN = false;
    bf16_t* ACT;
    __device__ __forceinline__ void operator()(const f32x4 (&acc)[2][2][4][2], const pg8::Unit& u, int wr_, int wc_, int fr_, int fq_) const {
        int t_ = threadIdx.x; asm volatile("" : "+v"(t_)); const int fr = t_ & 15, fq = (t_ >> 4) & 3, wc = (t_ >> 6) & 3, wr = t_ >> 8; (void)wr_; (void)wc_; (void)fr_; (void)fq_;
        const int row0 = u.pm * 256 + wr * 64 + fr;
#pragma unroll
        for (int ai = 0; ai < 2; ++ai)
#pragma unroll
            for (int m = 0; m < 4; ++m) { bf16_t* rowp = ACT + (size_t)(row0 + ai * 128 + m * 16) * 256;
#pragma unroll
                for (int bj = 0; bj < 2; ++bj) { const int j0 = (u.pn * 256 + bj * 128 + wc * 32) / 2 + 4 * fq; const f32x4 a = acc[ai][bj][m][0], b = acc[ai][bj][m][1];
                    pg8::u32x2 w; w.x = pg8::cvt_pk_bf16(silu_(a[0]) * b[0], silu_(a[1]) * b[1]); w.y = pg8::cvt_pk_bf16(silu_(a[2]) * b[2], silu_(a[3]) * b[3]);
                    __hip_atomic_store((unsigned long long*)(rowp + j0), (unsigned long long)w.x | ((unsigned long long)w.y << 32), __ATOMIC_RELAXED, __HIP_MEMORY_SCOPE_AGENT); } }
    }
};
struct EpiS5Y {
    static constexpr bool PERM = true, AFTER_DRAIN = false;
    bf16_t* PMz; const float* dskip; int ctxrows;
    static __device__ __forceinline__ float gelu_f(float x) { return x * sigm(1.5957691216f * x * (1.f + 0.044715f * x * x)); }
    __device__ __forceinline__ void operator()(const f32x4 (&acc)[2][2][4][2], const pg8::Unit& u, int wr_, int wc_, int fr_, int fq_) const {
        int t_ = threadIdx.x; asm volatile("" : "+v"(t_)); const int fr = t_ & 15, fq = (t_ >> 4) & 3, wc = (t_ >> 6) & 3, wr = t_ >> 8; (void)wr_; (void)wc_; (void)fr_; (void)fq_;
        const int row0 = u.pm * 256 + wr * 64 + fr, col0 = wc * 32 + 8 * fq, g = u.aux;
#pragma unroll
        for (int ai = 0; ai < 2; ++ai) {
        uint4 uu[2][4][2]; unsigned off[2][4][2];
#pragma unroll
            for (int m = 0; m < 4; ++m) { const int rowg = row0 + ai * 128 + m * 16; const bool rv = rowg < 2176; const int rg = rv ? rowg : 0; const int b = rg / 272, cf = rg - b * 272;
#pragma unroll
                for (int bj = 0; bj < 2; ++bj) { const int c = col0 + bj * 128, s = cf * 16 + (c >> 4), h0 = c & 15;
                    int row;
                    if (s < LC) row = RL + b * LC + s; else { const int i = s - LC; row = b * L + (i & 63) * 64 + (i >> 6); }
                    const bool ok = rv && (s >= LC || ctxrows);
                    const unsigned o = (unsigned)row * (unsigned)NP + (unsigned)(PC_S5 + g * 16 + h0);
                    off[ai][m][bj] = ok ? o : 0xffffffffu;
                    uu[ai][m][bj] = *(const uint4*)(PMz + (size_t)(ok ? o : (unsigned)(PC_S5 + g * 16 + h0))); } }
        asm volatile("" ::: "memory");
#pragma unroll
            for (int m = 0; m < 4; ++m)
#pragma unroll
                for (int bj = 0; bj < 2; ++bj) { const int h0 = (col0 + bj * 128) & 15; const uint4 q = uu[ai][m][bj];
                    const f32x4 d0 = *(const f32x4*)(dskip + g * 16 + h0), d1 = *(const f32x4*)(dskip + g * 16 + h0 + 4);
                    const f32x4 v0 = acc[ai][bj][m][0], v1 = acc[ai][bj][m][1];
                    pg8::u32x4 w;
                    w.x = pg8::cvt_pk_bf16(gelu_f(lo2f(q.x) * d0[0] + v0[0]), gelu_f(hi2f(q.x) * d0[1] + v0[1])); w.y = pg8::cvt_pk_bf16(gelu_f(lo2f(q.y) * d0[2] + v0[2]), gelu_f(hi2f(q.y) * d0[3] + v0[3]));
                    w.z = pg8::cvt_pk_bf16(gelu_f(lo2f(q.z) * d1[0] + v1[0]), gelu_f(hi2f(q.z) * d1[1] + v1[1])); w.w = pg8::cvt_pk_bf16(gelu_f(lo2f(q.w) * d1[2] + v1[2]), gelu_f(hi2f(q.w) * d1[3] + v1[3]));
                    if (off[ai][m][bj] != 0xffffffffu) *(pg8::u32x4*)(PMz + (size_t)off[ai][m][bj]) = w; }
        asm volatile("" ::: "memory"); }
    }
};
struct EpiGlu {
    static constexpr bool PERM = true, AFTER_DRAIN = false;
    const bf16_t* PMz; bf16_t* Yo; const float* bglu;
    __device__ __forceinline__ void operator()(const f32x4 (&acc)[2][2][4][2], const pg8::Unit& u, int wr_, int wc_, int fr_, int fq_) const {
        int t_ = threadIdx.x; asm volatile("" : "+v"(t_)); const int fr = t_ & 15, fq = (t_ >> 4) & 3, wc = (t_ >> 6) & 3, wr = t_ >> 8; (void)wr_; (void)wc_; (void)fr_; (void)fq_;
        const int row0 = u.pm * 256 + wr * 64 + fr, col0 = wc * 32 + 8 * fq;
#pragma unroll
        for (int bj = 0; bj < 2; ++bj) { const int c = col0 + bj * 128;
            const f32x4 b0 = *(const f32x4*)(bglu + c), b1 = *(const f32x4*)(bglu + c + 4);
#pragma unroll
            for (int ai = 0; ai < 2; ++ai)
#pragma unroll
                for (int m = 0; m < 4; ++m) { const size_t r = (size_t)(row0 + ai * 128 + m * 16);
                    const uint4 z = *(const uint4*)(PMz + r * NP + PC_S5 + c);
                    const f32x4 v0 = acc[ai][bj][m][0] + b0, v1 = acc[ai][bj][m][1] + b1;
                    pg8::u32x4 w;
                    w.x = pg8::cvt_pk_bf16(lo2f(z.x) * sigm(v0[0]), hi2f(z.x) * sigm(v0[1])); w.y = pg8::cvt_pk_bf16(lo2f(z.y) * sigm(v0[2]), hi2f(z.y) * sigm(v0[3]));
                    w.z = pg8::cvt_pk_bf16(lo2f(z.z) * sigm(v1[0]), hi2f(z.z) * sigm(v1[1])); w.w = pg8::cvt_pk_bf16(lo2f(z.w) * sigm(v1[2]), hi2f(z.w) * sigm(v1[3]));
                    *(pg8::u32x4*)(Yo + r * D + 768 + c) = w;
                    asm volatile("" ::: "memory"); } }
    }
};

__device__ __forceinline__ void phase_prologue(const P& p, unsigned char* smem) {
    float* cs = (float*)smem;
    float* red = cs + 9 * 1024;
    for (int i = p.tid(); i < 9 * 1024; i += NTHR) { const int r = i >> 10, k = i & 1023; const float v = r < 8 ? p.c()[r * 1024 + k] : p.c_ctx()[k]; cs[i] = silu_(v); }
    __syncthreads();
    for (int item = p.bid(); item < 192; item += p.nblk()) {
        const int layer = item / 96, cc = (item % 96) * 64, cl = p.tid() & 63, kg = p.tid() >> 6;
        const float* w = p.w_mod() + (size_t)layer * 1024 * 6144 + cc + cl;
        float acc[9];
#pragma unroll
        for (int r = 0; r < 9; ++r) acc[r] = 0.f;
        for (int k = kg * 128; k < kg * 128 + 128; ++k) { const float wv = w[(size_t)k * 6144];
#pragma unroll
            for (int r = 0; r < 9; ++r) acc[r] += cs[r * 1024 + k] * wv; }
#pragma unroll
        for (int r = 0; r < 9; ++r) red[(kg * 9 + r) * 64 + cl] = acc[r];
        __syncthreads();
        for (int o = p.tid(); o < 576; o += NTHR) { const int r = o >> 6, c2 = o & 63; float s = p.b_mod()[layer * 6144 + cc + c2];
            for (int k2 = 0; k2 < 8; ++k2) s += red[(k2 * 9 + r) * 64 + c2];
            p.MOD()[(size_t)(layer * 9 + r) * 6144 + cc + c2] = s; }
        __syncthreads();
    }
    for (int i = p.bid() * NTHR + p.tid(); i < 4096; i += p.nblk() * NTHR) {
        const int g = (i >> 6) & 15, d = (i >> 10) & 1, layer = i >> 11;
        const float lr = p.s5_lam_re()[i], li = p.s5_lam_im()[i], st = expf(p.s5_log_step()[(layer * 2 + d) * 16 + g]);
        const float mag = expf(lr * st); float sn, cn; sincosf(li * st, &sn, &cn);
        const float lbr = mag * cn, lbi = mag * sn;
        p.LAMB()[i] = make_float2(lbr, lbi);
        const float nr = lbr - 1.f, ni = lbi, den = lr * lr + li * li;
        const float qr = (nr * lr + ni * li) / den, qi = (ni * lr - nr * li) / den;
        for (int h = 0; h < 16; ++h) { const float br = p.s5_b_re()[(size_t)i * 16 + h], bi = p.s5_b_im()[(size_t)i * 16 + h];
            p.BBAR()[(size_t)i * 16 + h] = make_float2(qr * br - qi * bi, qr * bi + qi * br); }
    }
}

template <int MAP>
__device__ __forceinline__ void tjob(const P& p, int vb, int nvb, const float* src, long ld, int K, int ncols, bf16_t* dst, float* tile) {
    const int ntn = (ncols + 63) >> 6, ntk = K >> 6;
    for (int it = vb; it < ntn * ntk; it += nvb) {
        const int tn = it % ntn, tk = it / ntn, n0 = tn * 64, k0 = tk * 64;
#pragma unroll
        for (int ps = 0; ps < 2; ++ps) { const int kk = ps * 32 + (p.tid() >> 4), n4 = (p.tid() & 15) * 4;
            float4 v = make_float4(0.f, 0.f, 0.f, 0.f);
            if (n0 + n4 < ncols) v = *(const float4*)(src + (size_t)(k0 + kk) * ld + n0 + n4);
            tile[kk * 65 + n4 + 0] = v.x; tile[kk * 65 + n4 + 1] = v.y; tile[kk * 65 + n4 + 2] = v.z; tile[kk * 65 + n4 + 3] = v.w; }
        __syncthreads();
        { const int n = p.tid() >> 3, k8 = (p.tid() & 7) * 8;
          if (n0 + n < ncols) {
              uint4 w; w.x = pack2(tile[(k8 + 0) * 65 + n], tile[(k8 + 1) * 65 + n]); w.y = pack2(tile[(k8 + 2) * 65 + n], tile[(k8 + 3) * 65 + n]);
              w.z = pack2(tile[(k8 + 4) * 65 + n], tile[(k8 + 5) * 65 + n]); w.w = pack2(tile[(k8 + 6) * 65 + n], tile[(k8 + 7) * 65 + n]);
              int row = n0 + n;
              if (MAP == 1) row = (row >> 4) * 32 + (row & 15);
              if (MAP == 2) row = (row >> 4) * 32 + 16 + (row & 15);
              *(uint4*)(dst + (size_t)row * K + k0 + k8) = w; } }
        __syncthreads();
    }
}

__device__ __forceinline__ void s5_build_mats(const P& p, unsigned char* smem) {
    float2* pw = (float2*)smem;
    float* Kd = (float*)(smem + 18432);
    float2* CL = (float2*)(smem + 18432 + 32768);
    float2* BL = (float2*)(smem + 18432 + 32768 + 16896);
    for (int lg = p.bid(); lg < 32; lg += p.nblk()) { const int layer = lg >> 4, g = lg & 15;
        if (p.tid() < 128) { const int d = p.tid() >> 6, pp = p.tid() & 63; const float2 lam = p.LAMB()[((size_t)(layer * 2 + d) * 16 + g) * 64 + pp]; float2 cur = make_float2(1.f, 0.f);
            for (int j = 0; j <= 16; ++j) { pw[(d * 17 + j) * 65 + pp] = cur; cur = make_float2(cur.x * lam.x - cur.y * lam.y, cur.x * lam.y + cur.y * lam.x); } }
        for (int i = p.tid(); i < 2 * 16 * 64; i += NTHR) { const int d = i >> 10, h = (i >> 6) & 15, pp = i & 63; const size_t ci_ = (((size_t)(layer * 2 + d) * 16 + g) * 16 + h) * 64 + pp;
            CL[(d * 16 + h) * 65 + pp] = make_float2(p.s5_c_re()[ci_], p.s5_c_im()[ci_]); }
        for (int i = p.tid(); i < 2 * 64 * 16; i += NTHR) { const int d = i >> 10; BL[i] = p.BBAR()[((size_t)(layer * 2 + d) * 16 + g) * 1024 + (i & 1023)]; }
        __syncthreads();
        {
            const int d = p.tid() >> 8, j = (p.tid() >> 4) & 15, h = p.tid() & 15; float acc[16];
#pragma unroll
            for (int i = 0; i < 16; ++i) acc[i] = 0.f;
#pragma unroll 2
            for (int pp = 0; pp < 64; ++pp) { const float2 c = CL[(d * 16 + h) * 65 + pp], w = pw[(d * 17 + j) * 65 + pp];
                const float zr = c.x * w.x - c.y * w.y, zi = c.x * w.y + c.y * w.x; const float4* b4 = (const float4*)(BL + (d * 64 + pp) * 16);
#pragma unroll
                for (int q = 0; q < 8; ++q) { const float4 bb = b4[q]; acc[2 * q] += zr * bb.x - zi * bb.y; acc[2 * q + 1] += zr * bb.z - zi * bb.w; } }
#pragma unroll
            for (int q = 0; q < 4; ++q) *(float4*)(Kd + ((d * 16 + j) * 16 + h) * 16 + 4 * q) = make_float4(acc[4 * q], acc[4 * q + 1], acc[4 * q + 2], acc[4 * q + 3]);
        }
        __syncthreads();
        for (int e = p.tid(); e < 256 * 256; e += NTHR) { const int n = e >> 8, k = (e & 255) * 2, t = n >> 4, h = n & 15; float v0 = 0.f, v1 = 0.f;
            if (k < 256) { const int i = k >> 4, h2 = k & 15;
                if (i <= t) { const float2 q = *(const float2*)(Kd + ((0 * 16 + (t - i)) * 16 + h) * 16 + h2); v0 += q.x; v1 += q.y; }
                if (i >= t) { const float2 q = *(const float2*)(Kd + ((1 * 16 + (i - t)) * 16 + h) * 16 + h2); v0 += q.x; v1 += q.y; } }
            else { const int kk = k - 256, d = kk >> 7, pp = (kk >> 1) & 63, ex = d == 0 ? t + 1 : 16 - t;
                const float2 c = CL[(d * 16 + h) * 65 + pp], w = pw[(d * 17 + ex) * 65 + pp];
                v0 = c.x * w.x - c.y * w.y; v1 = -(c.x * w.y + c.y * w.x); }
            *(unsigned*)(p.S5TT() + ((size_t)lg * 256 + n) * 512 + k) = pack2(v0, v1); }
        for (int e = p.tid(); e < 256 * 128; e += NTHR) { const int n = e >> 7, k = (e & 127) * 2, d = n >> 7, pp = (n >> 1) & 63, ri = n & 1, i = k >> 4, h2 = k & 15, ex = d == 0 ? 15 - i : i;
            const float4 bb = *(const float4*)(BL + (d * 64 + pp) * 16 + h2); const float2 w = pw[(d * 17 + ex) * 65 + pp];
            *(unsigned*)(p.S5GG() + ((size_t)lg * 256 + n) * 256 + k) = ri ? pack2(w.x * bb.y + w.y * bb.x, w.x * bb.w + w.y * bb.z) : pack2(w.x * bb.x - w.y * bb.y, w.x * bb.z - w.y * bb.w); }
        __syncthreads();
    }
}

__device__ __forceinline__ void wprep_items(const P& p, int layer, int vb, int nvb, unsigned char* smem, int parts) {
    float* tile = (float*)smem;
    float2* tw = (float2*)(smem + 20480);
    __syncthreads();
    if (p.tid() < 64) { float s, c; sincospif(2.f * p.tid() / 64.f, &s, &c); tw[p.tid()] = make_float2(c, s); }
    __syncthreads();
    const float* win = p.w_in() + (size_t)layer * 1024 * NIN;
    if (parts & 1) {
        tjob<0>(p, vb, nvb, win + 256, NIN, 1024, 2192, p.WINT() + (size_t)512 * 1024, tile);
        tjob<0>(p, vb, nvb, win + 2448, NIN, 1024, 4096, p.WGT(), tile);
        for (int i = 0; i < 4; ++i) tjob<0>(p, vb, nvb, p.w_branch() + ((size_t)layer * 4 + i) * 256 * 1024, 1024, 256, 1024, p.WBT() + (size_t)i * 1024 * 256, tile);
        tjob<0>(p, vb, nvb, p.s5_w_glu() + (size_t)layer * 65536, 256, 256, 256, p.WGLUT(), tile);
        for (int it = vb; it < 1024; it += nvb) {
            const int n = it >> 1, k = (it & 1) * 512 + p.tid(), s = n >> 8, g = (n >> 6) & 3, cp = n & 63;
            const float* src = win + (size_t)k * NIN + g * 64;
            float acc = 0.f;
            for (int c4 = 0; c4 < 64; c4 += 4) { const float4 v = *(const float4*)(src + c4);
                const float2 t0 = tw[((c4 + 0) * cp) & 63], t1 = tw[((c4 + 1) * cp) & 63], t2 = tw[((c4 + 2) * cp) & 63], t3 = tw[((c4 + 3) * cp) & 63];
                acc += s ? (v.x * t0.y + v.y * t1.y + v.z * t2.y + v.w * t3.y) : (v.x * t0.x + v.y * t1.x + v.z * t2.x + v.w * t3.x); }
            p.WINT()[(size_t)n * 1024 + k] = f2bf(acc);
        }
        for (int i = vb * NTHR + p.tid(); i < 112 * 1024; i += nvb * NTHR) p.WINT()[(size_t)2704 * 1024 + i] = 0;
    }
    if (parts & 2) {
        tjob<0>(p, vb, nvb, p.w_out() + (size_t)layer * 1024 * 1024, 1024, 1024, 1024, p.WOT(), tile);
        for (int e = 0; e < 16; ++e) {
            tjob<1>(p, vb, nvb, p.moe_w1() + ((size_t)layer * 16 + e) * 1024 * 256, 256, 1024, 256, p.W13T() + (size_t)e * 512 * 1024, tile);
            tjob<2>(p, vb, nvb, p.moe_w3() + ((size_t)layer * 16 + e) * 1024 * 256, 256, 1024, 256, p.W13T() + (size_t)e * 512 * 1024, tile);
            tjob<0>(p, vb, nvb, p.moe_w2() + ((size_t)layer * 16 + e) * 256 * 1024, 1024, 256, 1024, p.W2T() + (size_t)e * 1024 * 256, tile);
        }
    }
}
__device__ __forceinline__ void phase_wprep(const P& p, int layer, unsigned char* smem) {
    if (layer == 0 && p.bid() < 32) { s5_build_mats(p, smem); return; }
    if (layer == 0) wprep_items(p, 0, p.bid() - 32, p.nblk() - 32, smem, 3);
    else wprep_items(p, 1, p.bid(), p.nblk(), smem, 2);
}

struct N1Row { float4 x[4]; uint2 y0[4], y1[4]; };
__device__ __forceinline__ N1Row n1_load(const P& p, int mode, int r, int2 sl) {
    N1Row o; const int ln4 = p.lane() * 4;
    if (mode == 0) { const float* src = r < RL ? p.x() + (size_t)r * D : p.ctx() + (size_t)(r - RL) * D;
#pragma unroll
        for (int j = 0; j < 4; ++j) { o.x[j] = *(const float4*)(src + j * 256 + ln4); o.y0[j] = make_uint2(0u, 0u); o.y1[j] = o.y0[j]; }
    } else { const float* xr = xrow(p, r);
#pragma unroll
        for (int j = 0; j < 4; ++j) { const int k = j * 256 + ln4; o.x[j] = *(const float4*)(xr + k);
            o.y0[j] = *(const uint2*)(p.YE() + (size_t)sl.x * D + k); o.y1[j] = *(const uint2*)(p.YE() + (size_t)sl.y * D + k); }
    }
    return o;
}
__device__ __forceinline__ void phase_norm1(const P& p, int mode) {
    const int gw = p.bid() * 8 + p.wid(), nw = p.nblk() * 8;
    const int nrows = (mode == 2) ? RL : RT, last = nrows - 1;
    const int layer = (mode == 0) ? 0 : 1;
    int4 tk = make_int4(0, 0, 0, 0), tk1 = tk; int2 sl = make_int2(0, 0), sl1 = sl;
    if (mode != 0) { const int rb = min(gw + nw, last); tk = p.TOK()[gw]; sl = p.SLOT()[gw]; tk1 = p.TOK()[rb]; sl1 = p.SLOT()[rb]; }
    N1Row cur = n1_load(p, mode, gw, sl);
#pragma unroll 1
    for (int r = gw; r < nrows; r += nw) {
        const N1Row c = cur; const int4 tkc = tk;
        tk = tk1; sl = sl1;
        if (mode != 0) { const int rc = min(r + 2 * nw, last); tk1 = p.TOK()[rc]; sl1 = p.SLOT()[rc]; }
        cur = n1_load(p, mode, min(r + nw, last), sl);
        const int mr = modrow(r);
        float v[16];
        float* xr = xrow(p, r);
        if (mode == 0) {
#pragma unroll
            for (int j = 0; j < 4; ++j) { v[j * 4] = c.x[j].x; v[j * 4 + 1] = c.x[j].y; v[j * 4 + 2] = c.x[j].z; v[j * 4 + 3] = c.x[j].w; }
        } else {
            const int pl = mode - 1;
            const float* g2 = p.MOD() + (size_t)(pl * 9 + mr) * 6144 + 5 * 1024;
            const float w0 = __int_as_float(tkc.z), w1 = __int_as_float(tkc.w);
#pragma unroll
            for (int j = 0; j < 4; ++j) { const int k = j * 256 + p.lane() * 4; const float4 t = c.x[j]; const uint2 y0 = c.y0[j], y1 = c.y1[j];
                const float4 gg = *(const float4*)(g2 + k);
                v[j * 4] = t.x + gg.x * (w0 * lo2f(y0.x) + w1 * lo2f(y1.x)); v[j * 4 + 1] = t.y + gg.y * (w0 * hi2f(y0.x) + w1 * hi2f(y1.x));
                v[j * 4 + 2] = t.z + gg.z * (w0 * lo2f(y0.y) + w1 * lo2f(y1.y)); v[j * 4 + 3] = t.w + gg.w * (w0 * hi2f(y0.y) + w1 * hi2f(y1.y)); }
        }
        float ss = 0.f;
#pragma unroll
        for (int i = 0; i < 16; ++i) ss += v[i] * v[i];
#pragma unroll
        for (int o = 32; o >= 1; o >>= 1) ss += __shfl_xor(ss, o);
        const float rstd = rsqrtf(ss * (1.f / 1024.f) + 1e-6f);
        if (mode == 2) {
#pragma unroll
            for (int j = 0; j < 4; ++j) { const int k = j * 256 + p.lane() * 4; const float4 g = *(const float4*)(p.final_g() + k);
                *(float4*)(p.out() + (size_t)r * D + k) = make_float4(v[j * 4] * rstd * g.x, v[j * 4 + 1] * rstd * g.y, v[j * 4 + 2] * rstd * g.z, v[j * 4 + 3] * rstd * g.w); }
        } else {
            const float* md = p.MOD() + (size_t)(layer * 9 + mr) * 6144;
#pragma unroll
            for (int j = 0; j < 4; ++j) { const int k = j * 256 + p.lane() * 4;
                *(float4*)(xr + k) = make_float4(v[j * 4], v[j * 4 + 1], v[j * 4 + 2], v[j * 4 + 3]);
                const float4 g = *(const float4*)(p.norm1_g() + layer * 1024 + k), sh = *(const float4*)(md + k), sc = *(const float4*)(md + 1024 + k);
                uint2 o; o.x = pack2(v[j * 4] * rstd * g.x * (1.f + sc.x) + sh.x, v[j * 4 + 1] * rstd * g.y * (1.f + sc.y) + sh.y);
                o.y = pack2(v[j * 4 + 2] * rstd * g.z * (1.f + sc.z) + sh.z, v[j * 4 + 3] * rstd * g.w * (1.f + sc.w) + sh.w);
                *(uint2*)(p.H() + (size_t)r * D + k) = o; }
        }
    }
}

__device__ __forceinline__ void phase_gemm1(const P& p, unsigned char* smem) {
    pg8::Gemm g{p.H(), p.WINT(), 1024, 1024, 1024}; pg8::GridOrder S; S.init(RT, NP, p.nblk(), p.bid(), 1024, 1024);
    EpiStoreBf16 E{p.PM(), NP, 0, 0, p.AC()};
    pg8::gemm_phase<EpiStoreBf16, pg8::GridOrder>((PG8_LAS unsigned char*)smem, g, S, E);
}

__device__ __forceinline__ bf16x8 lds_frag(const unsigned char* base, int row, int ld, int col) { return *(const bf16x8*)(base + ((size_t)row * ld + col) * 2); }
__device__ __forceinline__ void st4bf(unsigned char* base, int row, int ld, int col, float a, float b, float c, float d) { uint2 o; o.x = pack2(a, b); o.y = pack2(c, d); *(uint2*)(base + ((size_t)row * ld + col) * 2) = o; }
__device__ __forceinline__ void scan_pos(int b, int d, int s, int& base, int& l, int& len) {
    if (s < LC) { base = RL + b * LC; len = LC; l = d ? (LC - 1 - s) : s; }
    else { base = b * L; len = L; const int i = s - LC; l = d ? (L - 1 - i) : i; }
}
__device__ __forceinline__ int s5_row(int b, int d, int s) {
    if (s < LC) return RL + b * LC + (d ? (LC - 1 - s) : s);
    int i = s - LC; if (d) i = L - 1 - i;
    return b * L + (i & 63) * 64 + (i >> 6);
}

constexpr int SCT = 32;
__device__ __forceinline__ float dpp_sum8(float x) {
    x += __builtin_bit_cast(float, __builtin_amdgcn_update_dpp(0, __builtin_bit_cast(int, x), 0xB1, 0xF, 0xF, true));
    x += __builtin_bit_cast(float, __builtin_amdgcn_update_dpp(0, __builtin_bit_cast(int, x), 0x4E, 0xF, 0xF, true));
    x += __builtin_bit_cast(float, __builtin_amdgcn_update_dpp(0, __builtin_bit_cast(int, x), 0x141, 0xF, 0xF, true));
    return x;
}
__device__ __forceinline__ void dplr_chunk(float (&S)[8], const float* W, const float* KK, const float* BB, const float* KW, const float* VV, const float* RR, float* YO, int vrow, int kg) {
    float4 k0 = *(const float4*)(KK + kg * 8), k1 = *(const float4*)(KK + kg * 8 + 4);
    float4 w0 = *(const float4*)(W + kg * 8), w1 = *(const float4*)(W + kg * 8 + 4), b0 = *(const float4*)(BB + kg * 8), b1 = *(const float4*)(BB + kg * 8 + 4);
    float4 q0 = *(const float4*)(KW + kg * 8), q1 = *(const float4*)(KW + kg * 8 + 4), r0 = *(const float4*)(RR + kg * 8), r1 = *(const float4*)(RR + kg * 8 + 4);
    float v = VV[vrow];
#pragma unroll 2
    for (int t = 0; t < SCT; ++t) {
        const int on = (t + 1 < SCT ? t + 1 : t) * 64 + kg * 8;
        const float4 nk0 = *(const float4*)(KK + on), nk1 = *(const float4*)(KK + on + 4);
        const float4 nw0 = *(const float4*)(W + on), nw1 = *(const float4*)(W + on + 4), nb0 = *(const float4*)(BB + on), nb1 = *(const float4*)(BB + on + 4);
        const float4 nq0 = *(const float4*)(KW + on), nq1 = *(const float4*)(KW + on + 4), nr0 = *(const float4*)(RR + on), nr1 = *(const float4*)(RR + on + 4);
        const float nv = VV[(t + 1 < SCT ? t + 1 : t) * 32 + vrow];
        float d = S[0] * k0.x + S[1] * k0.y; float d2 = S[2] * k0.z + S[3] * k0.w;
        d += S[4] * k1.x + S[5] * k1.y; d2 += S[6] * k1.z + S[7] * k1.w;
        const float skk = -dpp_sum8(d + d2);
        const float c0 = v * q0.x, c1 = v * q0.y, c2 = v * q0.z, c3 = v * q0.w, c4 = v * q1.x, c5 = v * q1.y, c6 = v * q1.z, c7 = v * q1.w;
        S[0] = S[0] * w0.x + (skk * b0.x + c0); S[1] = S[1] * w0.y + (skk * b0.y + c1); S[2] = S[2] * w0.z + (skk * b0.z + c2); S[3] = S[3] * w0.w + (skk * b0.w + c3);
        S[4] = S[4] * w1.x + (skk * b1.x + c4); S[5] = S[5] * w1.y + (skk * b1.y + c5); S[6] = S[6] * w1.z + (skk * b1.z + c6); S[7] = S[7] * w1.w + (skk * b1.w + c7);
        float y = S[0] * r0.x + S[1] * r0.y; float y2 = S[2] * r0.z + S[3] * r0.w;
        y += S[4] * r1.x + S[5] * r1.y; y2 += S[6] * r1.z + S[7] * r1.w;
        y = dpp_sum8(y + y2);
        if (kg == 0) YO[t * 32 + vrow] = y;
        k0 = nk0; k1 = nk1; w0 = nw0; w1 = nw1; b0 = nb0; b1 = nb1; q0 = nq0; q1 = nq1; r0 = nr0; r1 = nr1; v = nv;
    }
}

__device__ __forceinline__ float rw_shift(const P& p, const float* mu, int base, int l, int len, int cidx) {
    const bf16_t* q = p.PM() + (size_t)(base + l) * NP + PC_RW + cidx;
    const bool hm = l > 0, hn = l < len - 1;
    const float p0 = bf2f(q[0]); float pm = bf2f(*(hm ? q - NP : q)), pn = bf2f(*(hn ? q + NP : q));
    if (!hm) pm = 0.f;
    if (!hn) pn = 0.f;
    return p0 + mu[cidx] * (pm - p0) + mu[896 + cidx] * (pn - p0);
}

struct Raw3 { uint2 m, a, n; };
__device__ __forceinline__ Raw3 rw_raw3(const P& p, int base, int l, int len, int cidx) {
    const bf16_t* q = p.PM() + (size_t)(base + l) * NP + PC_RW + cidx; Raw3 r;
    const bool hm = l > 0, hn = l < len - 1;
    r.a = *(const uint2*)q; r.m = *(const uint2*)(hm ? q - NP : q); r.n = *(const uint2*)(hn ? q + NP : q);
    if (!hm) r.m = make_uint2(0u, 0u);
    if (!hn) r.n = make_uint2(0u, 0u);
    return r;
}
__device__ __forceinline__ float4 rw_mix(const Raw3& x, const float4& m0, const float4& m1) {
    float4 r;
    { const float p0 = lo2f(x.a.x); r.x = p0 + m0.x * (lo2f(x.m.x) - p0) + m1.x * (lo2f(x.n.x) - p0); }
    { const float p0 = hi2f(x.a.x); r.y = p0 + m0.y * (hi2f(x.m.x) - p0) + m1.y * (hi2f(x.n.x) - p0); }
    { const float p0 = lo2f(x.a.y); r.z = p0 + m0.z * (lo2f(x.m.y) - p0) + m1.z * (lo2f(x.n.y) - p0); }
    { const float p0 = hi2f(x.a.y); r.w = p0 + m0.w * (hi2f(x.m.y) - p0) + m1.w * (hi2f(x.n.y) - p0); }
    return r;
}
__device__ __forceinline__ float4 rw_shift4(const P& p, const float* mu, int base, int l, int len, int cidx) {
    const bf16_t* q = p.PM() + (size_t)(base + l) * NP + PC_RW + cidx;
    const uint2 a = *(const uint2*)q;
    uint2 m = make_uint2(0u, 0u), n = make_uint2(0u, 0u);
    if (l > 0) m = *(const uint2*)(q - NP);
    if (l < len - 1) n = *(const uint2*)(q + NP);
    const float4 m0 = *(const float4*)(mu + cidx), m1 = *(const float4*)(mu + 896 + cidx);
    float4 r;
    { const float p0 = lo2f(a.x); r.x = p0 + m0.x * (lo2f(m.x) - p0) + m1.x * (lo2f(n.x) - p0); }
    { const float p0 = hi2f(a.x); r.y = p0 + m0.y * (hi2f(m.x) - p0) + m1.y * (hi2f(n.x) - p0); }
    { const float p0 = lo2f(a.y); r.z = p0 + m0.z * (lo2f(m.y) - p0) + m1.z * (lo2f(n.y) - p0); }
    { const float p0 = hi2f(a.y); r.w = p0 + m0.w * (hi2f(m.y) - p0) + m1.w * (hi2f(n.y) - p0); }
    return r;
}

struct RawIn { Raw3 x[4]; uint2 xv[3][5]; float al, be; int base, l; };
struct RawP { Raw3 x[4]; uint2 xv[3][5]; bf16_t alr, ber; };
template <bool is_dn>
__device__ __forceinline__ RawP load_rawp(const P& p, int b, int d, int h, int lq, int lt, int ch) {
    RawP r; int base, l, len; scan_pos(b, d, ch * 32 + lt, base, l, len);
    r.alr = 0; r.ber = 0;
    if (!is_dn) { const int c4 = h * 64 + lq * 4; const int cs[4] = {768 + lq * 4, c4, 512 + c4, 256 + c4};
        const bf16_t* q = p.PM() + (size_t)(base + l) * NP + PC_RW; const bf16_t* qm = l > 0 ? q - NP : q; const bf16_t* qn = l < len - 1 ? q + NP : q;
#pragma unroll
        for (int i = 0; i < 4; ++i) { r.x[i].a = *(const uint2*)(q + cs[i]); r.x[i].m = *(const uint2*)(qm + cs[i]); r.x[i].n = *(const uint2*)(qn + cs[i]); }
#pragma unroll
        for (int s3 = 0; s3 < 3; ++s3)
#pragma unroll
            for (int tap = 0; tap < 5; ++tap) r.xv[s3][tap] = make_uint2(0u, 0u);
    } else {
#pragma unroll
        for (int i = 0; i < 4; ++i) { r.x[i].a = make_uint2(0u, 0u); r.x[i].m = r.x[i].a; r.x[i].n = r.x[i].a; }
#pragma unroll
        for (int tap = 0; tap < 5; ++tap) { int ll = l + tap - 2; ll = ll < 0 ? 0 : (ll > len - 1 ? len - 1 : ll);
            const bf16_t* q = p.PM() + (size_t)(base + ll) * NP + PC_DQKV + h * 64 + lq * 4;
#pragma unroll
            for (int s3 = 0; s3 < 3; ++s3) r.xv[s3][tap] = *(const uint2*)(q + s3 * 256); }
        r.alr = p.PM()[(size_t)(base + l) * NP + PC_DAL + d * 4 + h]; r.ber = p.PM()[(size_t)(base + l) * NP + PC_DBE + d * 4 + h];
    }
    return r;
}
template <bool is_dn>
__device__ __forceinline__ void rawp_fix(RawP& r, int b, int d, int lt, int ch) {
    int base, l, len; scan_pos(b, d, ch * 32 + lt, base, l, len); (void)base;
    const uint2 z = make_uint2(0u, 0u);
    if (!is_dn) {
#pragma unroll
        for (int i = 0; i < 4; ++i) { if (l == 0) r.x[i].m = z; if (l == len - 1) r.x[i].n = z; }
    } else {
#pragma unroll
        for (int tap = 0; tap < 5; ++tap) { const int ll = l + tap - 2; const bool ok = ll >= 0 && ll < len;
#pragma unroll
            for (int s3 = 0; s3 < 3; ++s3) if (!ok) r.xv[s3][tap] = z; }
    }
}
template <bool is_dn, bool EDGE = true>
__device__ __forceinline__ RawIn load_raw_chunk(const P& p, int b, int d, int h, int lq, int lt, int ch) {
    RawIn r; int base, l, len; scan_pos(b, d, ch * 32 + lt, base, l, len);
    r.base = base; r.l = l; r.al = 0.f; r.be = 0.f;
    if (!is_dn) { const int c4 = h * 64 + lq * 4;
        if (EDGE) { r.x[0] = rw_raw3(p, base, l, len, 768 + lq * 4); r.x[1] = rw_raw3(p, base, l, len, c4); r.x[2] = rw_raw3(p, base, l, len, 512 + c4); r.x[3] = rw_raw3(p, base, l, len, 256 + c4); }
        else {
            const bf16_t* q = p.PM() + (size_t)(base + l) * NP + PC_RW; const int cs[4] = {768 + lq * 4, c4, 512 + c4, 256 + c4};
#pragma unroll
            for (int i = 0; i < 4; ++i) { r.x[i].a = *(const uint2*)(q + cs[i]); r.x[i].m = *(const uint2*)(q - NP + cs[i]); r.x[i].n = *(const uint2*)(q + NP + cs[i]); } }
    } else {
#pragma unroll
        for (int s3 = 0; s3 < 3; ++s3)
#pragma unroll
            for (int tap = 0; tap < 5; ++tap) {
                if (EDGE) { const int ll = l + tap - 2; const bool ok = ll >= 0 && ll < len; const int lc_ = ok ? ll : l;
                    r.xv[s3][tap] = *(const uint2*)(p.PM() + (size_t)(base + lc_) * NP + PC_DQKV + s3 * 256 + h * 64 + lq * 4);
                    if (!ok) r.xv[s3][tap] = make_uint2(0u, 0u); }
                else r.xv[s3][tap] = *(const uint2*)(p.PM() + (size_t)(base + l + tap - 2) * NP + PC_DQKV + s3 * 256 + h * 64 + lq * 4); }
        r.al = bf2f(p.PM()[(size_t)(base + l) * NP + PC_DAL + d * 4 + h]); r.be = bf2f(p.PM()[(size_t)(base + l) * NP + PC_DBE + d * 4 + h]);
    }
    return r;
}
template <bool is_dn>
__device__ __forceinline__ void scan_rwkv_dn(const P& p, int layer, int chain, int vhalf, unsigned char* smem) {
    const int d = chain & 1, h = (chain >> 1) & 3, b = chain >> 3;
    float* BUF = (float*)smem;
    float* YOB = BUF + 2 * 11264;
    float* TW = YOB + 2 * 1024; float* TA = TW + SCT * 32; float* WU = TA + SCT * 32; float* AU = WU + 32 * 64;
    const float* mu = p.rw_mu() + (size_t)layer * 2 * 896;
    if (!is_dn) {
        for (int i = p.tid(); i < 32 * 64; i += NTHR) { const int i2 = i >> 6, j = i & 63;
            WU[i] = p.rw_w_up()[((size_t)(layer * 2 + d) * 32 + i2) * 256 + h * 64 + j]; AU[i] = p.rw_a_up()[((size_t)(layer * 2 + d) * 32 + i2) * 256 + h * 64 + j]; }
    }
    float S[8];
#pragma unroll
    for (int i = 0; i < 8; ++i) S[i] = 0.f;
    const bool loader = p.wid() >= 4;
    const int tl = p.tid() & 255;
    const int vrow = (p.wid() & 3) * 8 + (p.lane() >> 3), kg = p.lane() & 7;
    bf16_t* yout = p.YS() + (size_t)((is_dn ? 2 : 0) + d) * RT * 256;
    const float dn_A = is_dn ? expf(p.dn_a_log()[(layer * 2 + d) * 4 + h]) : 0.f;
    const float dn_dtb = is_dn ? p.dn_dt_bias()[(layer * 2 + d) * 4 + h] : 0.f;
    const int lq = p.tid() & 15;
    float4 mu_lo[4], mu_hi[4], inv_w0 = make_float4(0.f, 0.f, 0.f, 0.f), inv_a0 = inv_w0, inv_kk = inv_w0, inv_ka = inv_w0; float4 dn_cw[3][5];
#pragma unroll
    for (int i = 0; i < 4; ++i) { mu_lo[i] = inv_w0; mu_hi[i] = inv_w0; }
#pragma unroll
    for (int s3 = 0; s3 < 3; ++s3)
#pragma unroll
        for (int tap = 0; tap < 5; ++tap) dn_cw[s3][tap] = inv_w0;
    if (!is_dn) { const int c4 = h * 64 + lq * 4; const int cols[4] = {768 + lq * 4, c4, 512 + c4, 256 + c4};
#pragma unroll
        for (int i = 0; i < 4; ++i) { mu_lo[i] = *(const float4*)(mu + cols[i]); mu_hi[i] = *(const float4*)(mu + 896 + cols[i]); }
        inv_w0 = *(const float4*)(p.rw_w0() + (layer * 2 + d) * 256 + c4); inv_a0 = *(const float4*)(p.rw_a0() + (layer * 2 + d) * 256 + c4);
        inv_kk = *(const float4*)(p.rw_k_k() + layer * 256 + c4); inv_ka = *(const float4*)(p.rw_k_a() + layer * 256 + c4);
    } else {
#pragma unroll
        for (int s3 = 0; s3 < 3; ++s3)
#pragma unroll
            for (int tap = 0; tap < 5; ++tap) dn_cw[s3][tap] = *(const float4*)(p.dn_conv() + ((size_t)layer * 5 + tap) * 768 + s3 * 256 + h * 64 + lq * 4);
    }
    __syncthreads();
    constexpr int NCH = (L + LC) / SCT;
    for (int it = 0; it <= NCH; ++it) {
        if (loader) {
            if (it >= 2) {
                const int t = tl >> 3, q = tl & 7; const float* YO = YOB + (it & 1) * 1024;
                int base, l, len; scan_pos(b, d, (it - 2) * SCT + t, base, l, len);
                uint2 o; o.x = pack2(YO[t * 32 + q * 4], YO[t * 32 + q * 4 + 1]); o.y = pack2(YO[t * 32 + q * 4 + 2], YO[t * 32 + q * 4 + 3]);
                *(uint2*)(yout + (size_t)(base + l) * 256 + h * 64 + vhalf * 32 + q * 4) = o;
            }
            if (it < NCH) {
                float* W = BUF + (it & 1) * 11264; float* KK = W + 2048; float* BB = KK + 2048; float* KW = BB + 2048; float* RR = KW + 2048; float* VV = RR + 2048;
#pragma unroll 1
                for (int ps = 0; ps < 2; ++ps) {
                    const int t = ps * 16 + (tl >> 4), q = tl & 15;
                    int base, l, len; scan_pos(b, d, it * SCT + t, base, l, len);
                    if (!is_dn) {
                        const int c4 = h * 64 + q * 4;
                        const Raw3 x0 = rw_raw3(p, base, l, len, 768 + q * 4), x1 = rw_raw3(p, base, l, len, c4), x2 = rw_raw3(p, base, l, len, 512 + c4), x3 = rw_raw3(p, base, l, len, 256 + c4);
                        { const float4 sv = rw_mix(x0, mu_lo[0], mu_hi[0]);
                          if (q < 8) { TW[t * 32 + q * 4] = tanhf(sv.x); TW[t * 32 + q * 4 + 1] = tanhf(sv.y); TW[t * 32 + q * 4 + 2] = tanhf(sv.z); TW[t * 32 + q * 4 + 3] = tanhf(sv.w); }
                          else { *(float4*)(TA + t * 32 + (q - 8) * 4) = sv; } }
                        asm volatile("s_waitcnt lgkmcnt(0)" ::: "memory");
                        float4 lwv = inv_w0, apv = inv_a0;
#pragma unroll 2
                        for (int i2 = 0; i2 < 32; ++i2) { const float tw_ = TW[t * 32 + i2], ta_ = TA[t * 32 + i2]; const float4 wu = *(const float4*)(WU + i2 * 64 + q * 4), au = *(const float4*)(AU + i2 * 64 + q * 4);
                            lwv.x += tw_ * wu.x; lwv.y += tw_ * wu.y; lwv.z += tw_ * wu.z; lwv.w += tw_ * wu.w; apv.x += ta_ * au.x; apv.y += ta_ * au.y; apv.z += ta_ * au.z; apv.w += ta_ * au.w; }
                        const float4 av = make_float4(sigm(apv.x), sigm(apv.y), sigm(apv.z), sigm(apv.w));
                        *(float4*)(W + t * 64 + q * 4) = make_float4(__expf(-0.6065306597f * sigm(lwv.x)), __expf(-0.6065306597f * sigm(lwv.y)), __expf(-0.6065306597f * sigm(lwv.z)), __expf(-0.6065306597f * sigm(lwv.w)));
                        *(float4*)(RR + t * 64 + q * 4) = rw_mix(x1, mu_lo[1], mu_hi[1]);
                        { const float4 vs = rw_mix(x2, mu_lo[2], mu_hi[2]); if ((q >> 3) == vhalf) *(float4*)(VV + t * 32 + (q & 7) * 4) = vs; }
                        const float4 ks = rw_mix(x3, mu_lo[3], mu_hi[3]);
                        const float4 kkm = inv_kk, kam = inv_ka;
                        float4 kk = make_float4(ks.x * kkm.x, ks.y * kkm.y, ks.z * kkm.z, ks.w * kkm.w);
                        float ssq = (kk.x * kk.x + kk.y * kk.y) + (kk.z * kk.z + kk.w * kk.w);
                        ssq += __shfl_xor(ssq, 1); ssq += __shfl_xor(ssq, 2); ssq += __shfl_xor(ssq, 4); ssq += __shfl_xor(ssq, 8);
                        const float rn = rsqrtf(ssq + 1e-6f);
                        kk.x *= rn; kk.y *= rn; kk.z *= rn; kk.w *= rn;
                        *(float4*)(KK + t * 64 + q * 4) = kk;
                        *(float4*)(BB + t * 64 + q * 4) = make_float4(kk.x * av.x, kk.y * av.y, kk.z * av.z, kk.w * av.w);
                        *(float4*)(KW + t * 64 + q * 4) = make_float4(ks.x * (1.f + (av.x - 1.f) * kam.x), ks.y * (1.f + (av.y - 1.f) * kam.y), ks.z * (1.f + (av.z - 1.f) * kam.z), ks.w * (1.f + (av.w - 1.f) * kam.w));
                        asm volatile("s_waitcnt lgkmcnt(0)" ::: "memory");
                    } else {
                        float u[3][4]; float sq = 0.f, sk = 0.f;
                        uint2 xv[3][5];
#pragma unroll
                        for (int s3 = 0; s3 < 3; ++s3)
#pragma unroll
                            for (int tap = 0; tap < 5; ++tap) { const int ll = l + tap - 2; xv[s3][tap] = make_uint2(0u, 0u);
                                if (ll >= 0 && ll < len) xv[s3][tap] = *(const uint2*)(p.PM() + (size_t)(base + ll) * NP + PC_DQKV + s3 * 256 + h * 64 + q * 4); }
                        const float al_raw = bf2f(p.PM()[(size_t)(base + l) * NP + PC_DAL + d * 4 + h]), be_raw = bf2f(p.PM()[(size_t)(base + l) * NP + PC_DBE + d * 4 + h]);
#pragma unroll
                        for (int s3 = 0; s3 < 3; ++s3) { float a0 = 0.f, a1 = 0.f, a2 = 0.f, a3 = 0.f;
#pragma unroll
                            for (int tap = 0; tap < 5; ++tap) { const float4 cw = dn_cw[s3][tap]; const uint2 x = xv[s3][tap];
                                a0 += cw.x * lo2f(x.x); a1 += cw.y * hi2f(x.x); a2 += cw.z * lo2f(x.y); a3 += cw.w * hi2f(x.y); }
                            u[s3][0] = silu_(a0); u[s3][1] = silu_(a1); u[s3][2] = silu_(a2); u[s3][3] = silu_(a3); }
#pragma unroll
                        for (int i = 0; i < 4; ++i) { sq += u[0][i] * u[0][i]; sk += u[1][i] * u[1][i]; }
                        sq += __shfl_xor(sq, 1); sq += __shfl_xor(sq, 2); sq += __shfl_xor(sq, 4); sq += __shfl_xor(sq, 8);
                        sk += __shfl_xor(sk, 1); sk += __shfl_xor(sk, 2); sk += __shfl_xor(sk, 4); sk += __shfl_xor(sk, 8);
                        const float qn = rsqrtf(sq + 1e-6f) * 0.125f, kn = rsqrtf(sk + 1e-6f);
                        const float a = __expf(-dn_A * softplus_(al_raw + dn_dtb)), beta = sigm(be_raw);
#pragma unroll
                        for (int i = 0; i < 4; ++i) { const int j = q * 4 + i; const float k = u[1][i] * kn;
                            W[t * 64 + j] = a; KK[t * 64 + j] = k; BB[t * 64 + j] = a * beta * k; KW[t * 64 + j] = beta * k; RR[t * 64 + j] = u[0][i] * qn;
                            if ((q >> 3) == vhalf) VV[t * 32 + (q & 7) * 4 + i] = u[2][i]; }
                    }
                }
            }
        } else if (it >= 1) {
            const float* W = BUF + ((it - 1) & 1) * 11264; const float* KK = W + 2048; const float* BB = KK + 2048; const float* KW = BB + 2048; const float* RR = KW + 2048; const float* VV = RR + 2048;
            dplr_chunk(S, W, KK, BB, KW, VV, RR, YOB + ((it - 1) & 1) * 1024, vrow, kg);
        }
        __syncthreads();
    }
    if (loader) {
        const int t = tl >> 3, q = tl & 7; const float* YO = YOB + ((NCH - 1) & 1) * 1024;
        int base, l, len; scan_pos(b, d, (NCH - 1) * SCT + t, base, l, len);
        uint2 o; o.x = pack2(YO[t * 32 + q * 4], YO[t * 32 + q * 4 + 1]); o.y = pack2(YO[t * 32 + q * 4 + 2], YO[t * 32 + q * 4 + 3]);
        *(uint2*)(yout + (size_t)(base + l) * 256 + h * 64 + vhalf * 32 + q * 4) = o;
    }
}


constexpr int CT = 32;
constexpr int LD64 = 72, LD32 = 40;
constexpr int O_FLW = 0, O_FKK = 8192, O_FB = 16384, O_FKW = 24576, O_FV = 32768, O_FR = 40960;
constexpr int O_AAB = 0;
constexpr int O_AAK = 4608, O_ARB = 7168, O_ARK = 9728, O_TINV = 12288;
constexpr int O_TINVT = 14848;
constexpr int O_M1T = 16128;
constexpr int O_WT = 17408, O_AVT = 22528, O_U0T = 27648;
constexpr int O_REFF = 32768;
constexpr int O_MC = 37376;
constexpr int O_CS = 49152;
constexpr int O_PT = 51200;
constexpr int O_GM = 51456, O_GG = 51584;
constexpr int O_QK = 51712, O_RQ = 56320, O_BH = 60928, O_KH = 65536;
constexpr int O_QKT = 70144, O_BT = 75264, O_KT = 80384, O_VT = 85504;
constexpr int O_RQS = 90624;
constexpr int O_S0 = 98816;
static_assert(O_S0 + 2 * 9216 <= LDS_RING, "chunk scan LDS");


template <bool is_dn>
__device__ __forceinline__ void scan_dplr_mfma(const P& p, int layer, int chain, unsigned char* smem) {
    const int d = chain & 1, h = (chain >> 1) & 3, b = chain >> 3;
    const int tid = p.tid(), lane = tid & 63, wid = tid >> 6, fr = lane & 15, fq = lane >> 4;
    float* FLW = (float*)(smem + O_FLW); float* FKK = (float*)(smem + O_FKK); float* FB = (float*)(smem + O_FB); float* FKW = (float*)(smem + O_FKW); float* FV = (float*)(smem + O_FV); float* FR = (float*)(smem + O_FR);
    float* CS = (float*)(smem + O_CS); float* PT = (float*)(smem + O_PT); float* GM = (float*)(smem + O_GM); float* GG = (float*)(smem + O_GG); float* RQS = (float*)(smem + O_RQS);
    float* AAB = (float*)(smem + O_AAB);
    float* TW = (float*)(smem + O_REFF); float* TA = TW + CT * 32; float* WU = TA + CT * 32;
    (void)TW; (void)TA; (void)WU;
    unsigned char* TWb = smem + O_QK; unsigned char* TAb = smem + O_QK + 2560;
    unsigned char* WUT = smem + 117248; unsigned char* AUT = smem + 117248 + 5120;
    float* LWP = (float*)(smem + O_RQS); float* APP = (float*)(smem + O_QKT);
    const int lq = tid & 15, lt = tid >> 4;
    const float* mu = p.rw_mu() + (size_t)layer * 2 * 896;
    float4 mu_lo[4], mu_hi[4], inv_w0 = make_float4(0.f, 0.f, 0.f, 0.f), inv_a0 = inv_w0, inv_kk = inv_w0, inv_ka = inv_w0;
    float* CWL = (float*)(smem + 117248);
#pragma unroll
    for (int i = 0; i < 4; ++i) { mu_lo[i] = inv_w0; mu_hi[i] = inv_w0; }
    if (!is_dn) { const int c4 = h * 64 + lq * 4; const int cols[4] = {768 + lq * 4, c4, 512 + c4, 256 + c4};
#pragma unroll
        for (int i = 0; i < 4; ++i) { mu_lo[i] = *(const float4*)(mu + cols[i]); mu_hi[i] = *(const float4*)(mu + 896 + cols[i]); }
        inv_w0 = *(const float4*)(p.rw_w0() + (layer * 2 + d) * 256 + c4); inv_a0 = *(const float4*)(p.rw_a0() + (layer * 2 + d) * 256 + c4);
        inv_kk = *(const float4*)(p.rw_k_k() + layer * 256 + c4); inv_ka = *(const float4*)(p.rw_k_a() + layer * 256 + c4);
    } else {
        for (int i = tid; i < 15 * 64; i += NTHR) { const int st = i >> 6, j = i & 63, s3 = st / 5, tap = st % 5; CWL[i] = p.dn_conv()[((size_t)layer * 5 + tap) * 768 + s3 * 256 + h * 64 + j]; }
    }
    const float dn_A = is_dn ? expf(p.dn_a_log()[(layer * 2 + d) * 4 + h]) : 0.f;
    const float dn_dtb = is_dn ? p.dn_dt_bias()[(layer * 2 + d) * 4 + h] : 0.f;
    if (!is_dn) for (int i = tid; i < 32 * 64; i += NTHR) { const int i2 = i >> 6, j = i & 63;
        ((bf16_t*)WUT)[j * LD32 + i2] = f2bf(p.rw_w_up()[((size_t)(layer * 2 + d) * 32 + i2) * 256 + h * 64 + j]); ((bf16_t*)AUT)[j * LD32 + i2] = f2bf(p.rw_a_up()[((size_t)(layer * 2 + d) * 32 + i2) * 256 + h * 64 + j]); }
    bf16_t* yout = p.YS() + (size_t)((is_dn ? 2 : 0) + d) * RT * 256;
    f32x4 Sacc[2]; Sacc[0] = (f32x4){0.f, 0.f, 0.f, 0.f}; Sacc[1] = Sacc[0];
    for (int i = tid; i < 2 * 9216 / 4; i += NTHR) ((unsigned*)(smem + O_S0))[i] = 0u;
    __syncthreads();
    constexpr int NCH = (L + LC) / CT;
    RawIn cur = load_raw_chunk<is_dn>(p, b, d, h, lq, lt, 0);
#pragma unroll 1
    for (int ch = 0; ch < NCH; ++ch) {
        if (!is_dn) {
            const float4 sv0 = rw_mix(cur.x[0], mu_lo[0], mu_hi[0]), rs4 = rw_mix(cur.x[1], mu_lo[1], mu_hi[1]), vs4 = rw_mix(cur.x[2], mu_lo[2], mu_hi[2]), ks4 = rw_mix(cur.x[3], mu_lo[3], mu_hi[3]);
            if (ch + 1 < NCH) cur = load_raw_chunk<is_dn>(p, b, d, h, lq, lt, ch + 1);
            { const float4 sv = sv0;
              if (lq < 8) st4bf(TWb, lt, LD32, lq * 4, fast_tanh(sv.x), fast_tanh(sv.y), fast_tanh(sv.z), fast_tanh(sv.w));
              else st4bf(TAb, lt, LD32, (lq - 8) * 4, sv.x, sv.y, sv.z, sv.w); }
            __syncthreads();
            { const int mt = wid & 1, nt = wid >> 1;
              const bf16x8 aw = lds_frag(TWb, mt * 16 + fr, LD32, fq * 8), aa = lds_frag(TAb, mt * 16 + fr, LD32, fq * 8);
              const bf16x8 bw = lds_frag(WUT, nt * 16 + fr, LD32, fq * 8), ba = lds_frag(AUT, nt * 16 + fr, LD32, fq * 8);
              f32x4 cw = (f32x4){0.f, 0.f, 0.f, 0.f}, ca = cw;
              cw = __builtin_amdgcn_mfma_f32_16x16x32_bf16(bw, aw, cw, 0, 0, 0); ca = __builtin_amdgcn_mfma_f32_16x16x32_bf16(ba, aa, ca, 0, 0, 0);
              *(float4*)(LWP + (mt * 16 + fr) * 64 + nt * 16 + 4 * fq) = make_float4(cw[0], cw[1], cw[2], cw[3]);
              *(float4*)(APP + (mt * 16 + fr) * 64 + nt * 16 + 4 * fq) = make_float4(ca[0], ca[1], ca[2], ca[3]); }
            __syncthreads();
            float4 lwv = *(const float4*)(LWP + lt * 64 + lq * 4), apv = *(const float4*)(APP + lt * 64 + lq * 4);
            lwv.x += inv_w0.x; lwv.y += inv_w0.y; lwv.z += inv_w0.z; lwv.w += inv_w0.w; apv.x += inv_a0.x; apv.y += inv_a0.y; apv.z += inv_a0.z; apv.w += inv_a0.w;
            const float4 av = make_float4(sigm(apv.x), sigm(apv.y), sigm(apv.z), sigm(apv.w));
            *(float4*)(FLW + lt * 64 + lq * 4) = make_float4(-0.6065306597f * sigm(lwv.x), -0.6065306597f * sigm(lwv.y), -0.6065306597f * sigm(lwv.z), -0.6065306597f * sigm(lwv.w));
            *(float4*)(FR + lt * 64 + lq * 4) = rs4;
            *(float4*)(FV + lt * 64 + lq * 4) = vs4;
            const float4 ks = ks4;
            float4 kk = make_float4(ks.x * inv_kk.x, ks.y * inv_kk.y, ks.z * inv_kk.z, ks.w * inv_kk.w);
            float ssq = (kk.x * kk.x + kk.y * kk.y) + (kk.z * kk.z + kk.w * kk.w);
            ssq += __shfl_xor(ssq, 1); ssq += __shfl_xor(ssq, 2); ssq += __shfl_xor(ssq, 4); ssq += __shfl_xor(ssq, 8);
            const float rn = rsqrtf(ssq + 1e-6f);
            kk.x *= rn; kk.y *= rn; kk.z *= rn; kk.w *= rn;
            *(float4*)(FKK + lt * 64 + lq * 4) = kk;
            *(float4*)(FB + lt * 64 + lq * 4) = make_float4(kk.x * av.x, kk.y * av.y, kk.z * av.z, kk.w * av.w);
            *(float4*)(FKW + lt * 64 + lq * 4) = make_float4(ks.x * (1.f + (av.x - 1.f) * inv_ka.x), ks.y * (1.f + (av.y - 1.f) * inv_ka.y), ks.z * (1.f + (av.z - 1.f) * inv_ka.z), ks.w * (1.f + (av.w - 1.f) * inv_ka.w));
        } else {
            float u[3][4]; float sq = 0.f, sk = 0.f;
            const float al_raw = cur.al, be_raw = cur.be;
#pragma unroll
            for (int s3 = 0; s3 < 3; ++s3) { float a0 = 0.f, a1 = 0.f, a2 = 0.f, a3 = 0.f;
#pragma unroll
                for (int tap = 0; tap < 5; ++tap) { const float4 cw = *(const float4*)(CWL + (s3 * 5 + tap) * 64 + lq * 4); const uint2 x = cur.xv[s3][tap];
                    a0 += cw.x * lo2f(x.x); a1 += cw.y * hi2f(x.x); a2 += cw.z * lo2f(x.y); a3 += cw.w * hi2f(x.y); }
                u[s3][0] = a0; u[s3][1] = a1; u[s3][2] = a2; u[s3][3] = a3; }
            asm volatile("" : "+v"(u[0][0]), "+v"(u[0][1]), "+v"(u[0][2]), "+v"(u[0][3]), "+v"(u[1][0]), "+v"(u[1][1]), "+v"(u[1][2]), "+v"(u[1][3]), "+v"(u[2][0]), "+v"(u[2][1]), "+v"(u[2][2]), "+v"(u[2][3]));
            if (ch + 1 < NCH) cur = load_raw_chunk<is_dn>(p, b, d, h, lq, lt, ch + 1);
#pragma unroll
            for (int s3 = 0; s3 < 3; ++s3)
#pragma unroll
                for (int i = 0; i < 4; ++i) u[s3][i] = silu_(u[s3][i]);
#pragma unroll
            for (int i = 0; i < 4; ++i) { sq += u[0][i] * u[0][i]; sk += u[1][i] * u[1][i]; }
            sq += __shfl_xor(sq, 1); sq += __shfl_xor(sq, 2); sq += __shfl_xor(sq, 4); sq += __shfl_xor(sq, 8);
            sk += __shfl_xor(sk, 1); sk += __shfl_xor(sk, 2); sk += __shfl_xor(sk, 4); sk += __shfl_xor(sk, 8);
            const float qn = rsqrtf(sq + 1e-6f) * 0.125f, kn = rsqrtf(sk + 1e-6f);
            const float la = -dn_A * softplus_(al_raw + dn_dtb), a = __expf(la), beta = sigm(be_raw);
#pragma unroll
            for (int i = 0; i < 4; ++i) { const int j = lq * 4 + i; const float k = u[1][i] * kn;
                FLW[lt * 64 + j] = la; FKK[lt * 64 + j] = k; FB[lt * 64 + j] = a * beta * k; FKW[lt * 64 + j] = beta * k; FV[lt * 64 + j] = u[2][i]; FR[lt * 64 + j] = u[0][i] * qn; }
        }
        __syncthreads();
        const int k = tid & 63, tg = tid >> 6, t0 = tg * 4;
        float c0 = FLW[(t0 + 0) * 64 + k], c1 = c0 + FLW[(t0 + 1) * 64 + k], c2 = c1 + FLW[(t0 + 2) * 64 + k], c3 = c2 + FLW[(t0 + 3) * 64 + k];
        CS[tg * 64 + k] = c3;
        __syncthreads();
        {
            float off = 0.f, tot = 0.f;
#pragma unroll
            for (int g2 = 0; g2 < 8; ++g2) { const float s = CS[g2 * 64 + k]; tot += s; if (g2 < tg) off += s; }
            const float cum[4] = {off + c0, off + c1, off + c2, off + c3}; const float cumm[4] = {off, off + c0, off + c1, off + c2};
            float qk[4], bt[4], kt[4], vv[4];
#pragma unroll
            for (int j = 0; j < 4; ++j) { const int t = t0 + j; const float kkv = FKK[t * 64 + k], bv = FB[t * 64 + k], kwv = FKW[t * 64 + k], rv = FR[t * 64 + k];
                const float em = __expf(cumm[j]), ec = __expf(cum[j]), ee = __expf(tot - cum[j]);
                vv[j] = FV[t * 64 + k]; qk[j] = kkv * em; bt[j] = bv * ee; kt[j] = kwv * ee;
                RQS[t * 64 + k] = rv * ec;
                if (!is_dn) { const float ei = __expf(-cum[j]);
                    ((bf16_t*)(smem + O_QK))[t * LD64 + k] = f2bf(kkv * em); ((bf16_t*)(smem + O_RQ))[t * LD64 + k] = f2bf(rv * ec);
                    ((bf16_t*)(smem + O_BH))[t * LD64 + k] = f2bf(bv * ei); ((bf16_t*)(smem + O_KH))[t * LD64 + k] = f2bf(kwv * ei);
                } else {
                    ((bf16_t*)(smem + O_QK))[t * LD64 + k] = f2bf(kkv); ((bf16_t*)(smem + O_RQ))[t * LD64 + k] = f2bf(rv);
                    ((bf16_t*)(smem + O_BH))[t * LD64 + k] = f2bf(bv); ((bf16_t*)(smem + O_KH))[t * LD64 + k] = f2bf(kwv);
                    if (k == 0) { GM[t] = cumm[j]; GG[t] = cum[j]; }
                } }
            st4bf(smem + O_QKT, k, LD32, t0, qk[0], qk[1], qk[2], qk[3]); st4bf(smem + O_BT, k, LD32, t0, bt[0], bt[1], bt[2], bt[3]);
            st4bf(smem + O_KT, k, LD32, t0, kt[0], kt[1], kt[2], kt[3]); st4bf(smem + O_VT, k, LD32, t0, vv[0], vv[1], vv[2], vv[3]);
            if (tg == 0) PT[k] = __expf(tot);
        }
        __syncthreads();
        {
            const int mi = wid >> 1, hf = wid & 1;
            const unsigned char* Ab = smem + (mi < 2 ? O_QK : O_RQ); const unsigned char* Bb = smem + ((mi & 1) ? O_KH : O_BH);
            f32x4 acc[2]; acc[0] = (f32x4){0.f, 0.f, 0.f, 0.f}; acc[1] = acc[0];
#pragma unroll
            for (int ks = 0; ks < 2; ++ks) { const bf16x8 af = lds_frag(Ab, hf * 16 + fr, LD64, ks * 32 + fq * 8);
#pragma unroll
                for (int nt = 0; nt < 2; ++nt) { const bf16x8 bfv = lds_frag(Bb, nt * 16 + fr, LD64, ks * 32 + fq * 8); acc[nt] = __builtin_amdgcn_mfma_f32_16x16x32_bf16(bfv, af, acc[nt], 0, 0, 0); } }
            const int t = hf * 16 + fr; const float gt = is_dn ? (mi < 2 ? GM[t] : GG[t]) : 0.f;
#pragma unroll
            for (int nt = 0; nt < 2; ++nt) { float o[4];
#pragma unroll
                for (int j = 0; j < 4; ++j) { const int i = nt * 16 + 4 * fq + j; const bool keep = mi < 2 ? (i < t) : (i <= t); float val = keep ? acc[nt][j] : 0.f;
                    if (is_dn && keep) val *= __expf(gt - GG[i]); o[j] = val; }
                const int i0 = nt * 16 + 4 * fq;
                if (mi == 0) *(float4*)(AAB + t * 36 + i0) = make_float4(o[0], o[1], o[2], o[3]);
                else st4bf(smem + (mi == 1 ? O_AAK : (mi == 2 ? O_ARB : O_ARK)), t, LD32, i0, o[0], o[1], o[2], o[3]); }
        }
        __syncthreads();
        if (wid == 0) {
            bf16_t* TINV = (bf16_t*)(smem + O_TINV); bf16_t* TINVT = (bf16_t*)(smem + O_TINVT); bf16_t* M1T = (bf16_t*)(smem + O_M1T);
            if (lane < 32) { const int blk = lane >> 4, j = lane & 15; float x[16];
#pragma unroll
                for (int t = 0; t < 16; ++t) { float s = (t == j) ? 1.f : 0.f, s2 = 0.f; const float* rowp = AAB + (blk * 16 + t) * 36 + blk * 16;
                    float rv[16];
#pragma unroll
                    for (int i4 = 0; i4 < 16; i4 += 4) if (i4 < t) { const float4 q4 = *(const float4*)(rowp + i4); rv[i4] = q4.x; rv[i4 + 1] = q4.y; rv[i4 + 2] = q4.z; rv[i4 + 3] = q4.w; }
#pragma unroll
                    for (int i = 0; i < t; ++i) { if (i & 1) s2 -= rv[i] * x[i]; else s -= rv[i] * x[i]; }
                    x[t] = s + s2; }
#pragma unroll
                for (int t = 0; t < 16; ++t) TINV[(blk * 16 + t) * LD32 + blk * 16 + j] = f2bf(x[t]);
                if (blk == 0) {
#pragma unroll
                    for (int t = 0; t < 16; t += 4) st4bf(smem + O_TINVT, j, LD32, t, x[t], x[t + 1], x[t + 2], x[t + 3]); }
            } else { const int r = lane - 32;
#pragma unroll
                for (int t = 0; t < 16; t += 4) if (r < 16) st4bf(smem + O_TINV, r, LD32, 16 + t, 0.f, 0.f, 0.f, 0.f); }
            asm volatile("s_waitcnt lgkmcnt(0)" ::: "memory");
            bf16x8 af, bfv; const bf16x8 zf = {0, 0, 0, 0, 0, 0, 0, 0};
            if (fq < 2) { const float* lp = AAB + (16 + fr) * 36 + fq * 8; uint4 w; w.x = pack2(lp[0], lp[1]); w.y = pack2(lp[2], lp[3]); w.z = pack2(lp[4], lp[5]); w.w = pack2(lp[6], lp[7]); af = __builtin_bit_cast(bf16x8, w);
                bfv = lds_frag(smem + O_TINVT, fr, LD32, fq * 8); } else { af = zf; bfv = zf; }
            f32x4 m1 = (f32x4){0.f, 0.f, 0.f, 0.f};
            m1 = __builtin_amdgcn_mfma_f32_16x16x32_bf16(bfv, af, m1, 0, 0, 0);
#pragma unroll
            for (int j = 0; j < 4; ++j) M1T[(4 * fq + j) * LD32 + fr] = f2bf(m1[j]);
            asm volatile("s_waitcnt lgkmcnt(0)" ::: "memory");
            if (fq < 2) { af = lds_frag(smem + O_TINV, 16 + fr, LD32, 16 + fq * 8); bfv = lds_frag(smem + O_M1T, fr, LD32, fq * 8); } else { af = zf; bfv = zf; }
            f32x4 x21 = (f32x4){0.f, 0.f, 0.f, 0.f};
            x21 = __builtin_amdgcn_mfma_f32_16x16x32_bf16(bfv, af, x21, 0, 0, 0);
            st4bf(smem + O_TINV, 16 + fr, LD32, 4 * fq, -x21[0], -x21[1], -x21[2], -x21[3]);
        }
        __syncthreads();
        {
            const int mt = wid & 3, nt = wid >> 2;
            { const bf16x8 af = lds_frag(smem + O_QKT, mt * 16 + fr, LD32, fq * 8), bfv = lds_frag(smem + O_TINV, nt * 16 + fr, LD32, fq * 8);
              f32x4 acc = (f32x4){0.f, 0.f, 0.f, 0.f}; acc = __builtin_amdgcn_mfma_f32_16x16x32_bf16(bfv, af, acc, 0, 0, 0);
              st4bf(smem + O_WT, mt * 16 + fr, LD32, nt * 16 + 4 * fq, acc[0], acc[1], acc[2], acc[3]); }
            { const bf16x8 af = lds_frag(smem + O_VT, mt * 16 + fr, LD32, fq * 8), bfv = lds_frag(smem + O_AAK, nt * 16 + fr, LD32, fq * 8);
              f32x4 acc = (f32x4){0.f, 0.f, 0.f, 0.f}; acc = __builtin_amdgcn_mfma_f32_16x16x32_bf16(bfv, af, acc, 0, 0, 0);
              st4bf(smem + O_AVT, mt * 16 + fr, LD32, nt * 16 + 4 * fq, acc[0], acc[1], acc[2], acc[3]); }
        }
        __syncthreads();
        {
            { const int mt = wid & 3, nt = wid >> 2;
              const bf16x8 af = lds_frag(smem + O_AVT, mt * 16 + fr, LD32, fq * 8), bfv = lds_frag(smem + O_TINV, nt * 16 + fr, LD32, fq * 8);
              f32x4 acc = (f32x4){0.f, 0.f, 0.f, 0.f}; acc = __builtin_amdgcn_mfma_f32_16x16x32_bf16(bfv, af, acc, 0, 0, 0);
              st4bf(smem + O_U0T, mt * 16 + fr, LD32, nt * 16 + 4 * fq, -acc[0], -acc[1], -acc[2], -acc[3]); }
            { const int mt = wid & 1, nt = wid >> 1;
              const bf16x8 af = lds_frag(smem + O_ARB, mt * 16 + fr, LD32, fq * 8), bfv = lds_frag(smem + O_WT, nt * 16 + fr, LD32, fq * 8);
              f32x4 acc = (f32x4){0.f, 0.f, 0.f, 0.f}; acc = __builtin_amdgcn_mfma_f32_16x16x32_bf16(bfv, af, acc, 0, 0, 0);
              const int t = mt * 16 + fr, k0 = nt * 16 + 4 * fq; const float4 rq = *(const float4*)(RQS + t * 64 + k0);
              st4bf(smem + O_REFF, t, LD64, k0, rq.x - acc[0], rq.y - acc[1], rq.z - acc[2], rq.w - acc[3]); }
#pragma unroll
            for (int j2 = 0; j2 < 2; ++j2) { const int mt = wid & 3, nt = (wid >> 2) * 2 + j2;
              const bf16x8 af = lds_frag(smem + O_BT, mt * 16 + fr, LD32, fq * 8), bfv = lds_frag(smem + O_WT, nt * 16 + fr, LD32, fq * 8);
              f32x4 acc = (f32x4){0.f, 0.f, 0.f, 0.f}; acc = __builtin_amdgcn_mfma_f32_16x16x32_bf16(bfv, af, acc, 0, 0, 0);
              st4bf(smem + O_MC, mt * 16 + fr, LD64, nt * 16 + 4 * fq, -acc[0], -acc[1], -acc[2], -acc[3]); }
        }
        __syncthreads();
        {
            const unsigned char* S0c = smem + O_S0 + (ch & 1) * 9216; unsigned char* S0n = smem + O_S0 + ((ch + 1) & 1) * 9216;
            { const int mt = wid & 1, nt = wid >> 1;
              f32x4 acc = (f32x4){0.f, 0.f, 0.f, 0.f};
#pragma unroll
              for (int ks = 0; ks < 2; ++ks) acc = __builtin_amdgcn_mfma_f32_16x16x32_bf16(lds_frag(S0c, nt * 16 + fr, LD64, ks * 32 + fq * 8), lds_frag(smem + O_REFF, mt * 16 + fr, LD64, ks * 32 + fq * 8), acc, 0, 0, 0);
              acc = __builtin_amdgcn_mfma_f32_16x16x32_bf16(lds_frag(smem + O_U0T, nt * 16 + fr, LD32, fq * 8), lds_frag(smem + O_ARB, mt * 16 + fr, LD32, fq * 8), acc, 0, 0, 0);
              acc = __builtin_amdgcn_mfma_f32_16x16x32_bf16(lds_frag(smem + O_VT, nt * 16 + fr, LD32, fq * 8), lds_frag(smem + O_ARK, mt * 16 + fr, LD32, fq * 8), acc, 0, 0, 0);
              int yb, yl, ylen; scan_pos(b, d, ch * CT + mt * 16 + fr, yb, yl, ylen);
              uint2 o; o.x = pack2(acc[0], acc[1]); o.y = pack2(acc[2], acc[3]);
              *(uint2*)(yout + (size_t)(yb + yl) * 256 + h * 64 + nt * 16 + 4 * fq) = o; }
#pragma unroll
            for (int j2 = 0; j2 < 2; ++j2) { const int mt = wid & 3, nt = (wid >> 2) * 2 + j2;
              const float4 pt = *(const float4*)(PT + nt * 16 + 4 * fq);
              f32x4 acc = Sacc[j2]; acc[0] *= pt.x; acc[1] *= pt.y; acc[2] *= pt.z; acc[3] *= pt.w;
#pragma unroll
              for (int ks = 0; ks < 2; ++ks) acc = __builtin_amdgcn_mfma_f32_16x16x32_bf16(lds_frag(smem + O_MC, nt * 16 + fr, LD64, ks * 32 + fq * 8), lds_frag(S0c, mt * 16 + fr, LD64, ks * 32 + fq * 8), acc, 0, 0, 0);
              acc = __builtin_amdgcn_mfma_f32_16x16x32_bf16(lds_frag(smem + O_BT, nt * 16 + fr, LD32, fq * 8), lds_frag(smem + O_U0T, mt * 16 + fr, LD32, fq * 8), acc, 0, 0, 0);
              acc = __builtin_amdgcn_mfma_f32_16x16x32_bf16(lds_frag(smem + O_KT, nt * 16 + fr, LD32, fq * 8), lds_frag(smem + O_VT, mt * 16 + fr, LD32, fq * 8), acc, 0, 0, 0);
              Sacc[j2] = acc;
              st4bf(S0n, mt * 16 + fr, LD64, nt * 16 + 4 * fq, acc[0], acc[1], acc[2], acc[3]); }
        }
        __syncthreads();
    }
}

constexpr int K_QK = 0, K_RQ = 4608, K_BH = 9216, K_KH = 13824, K_QKT = 18432, K_BT = 23552, K_KT = 28672, K_VT = 33792;
constexpr int K_RQS = 38912;
constexpr int K_PT = 43008, K_GM = 43264, K_GG = 43392;
constexpr int PKG_BYTES = 45056;
constexpr int RING_R = 8;
constexpr int P_PK = 51712;
constexpr int P_TW = 98304, P_TA = 100864, P_LWP = 103424, P_APP = 111616, P_WUT = 119808, P_AUT = 124928, P_CWL = 119808;
constexpr int C_PKG = 46592, C_S0 = C_PKG + 2 * PKG_BYTES;
static_assert(P_PK + PKG_BYTES <= P_TW && P_AUT + 5120 <= LDS_BYTES - 16, "producer LDS");
static_assert(C_S0 + 2 * 9216 <= LDS_BYTES - 16, "consumer LDS");
static_assert((size_t)128 * RING_R * PKG_BYTES <= (size_t)RL * D * 2, "ring stays below the context rows of Y");
static_assert(PKG_BYTES % (NTHR * 8) == 0, "copy-out rounds");
constexpr int CW_RING = 8192;
static_assert((CW_RING + 2 * 128 * 32) * 4 <= (int)CTL_BYTES, "ring flags");
__device__ __forceinline__ void ring_wait(unsigned* flag, unsigned need, unsigned& seen, unsigned* bar) {
    if (seen >= need) return;
    unsigned sp = 0u;
    for (;;) {
        seen = __builtin_amdgcn_readfirstlane(xb_ld(flag));
        if (seen >= need) break;
        __builtin_amdgcn_s_sleep(1);
        if ((++sp & 255u) == 0u) { if (xb_ld(&bar[XB_TMO])) break; if (sp > XB_SPIN_CAP) { atomicAdd(&bar[XB_TMO], 1u); break; } }
    }
}
template <bool is_dn>
__device__ __forceinline__ void scan_producer(const P& p, int layer, int chain, unsigned char* smem) {
    const int d = chain & 1, h = (chain >> 1) & 3, b = chain >> 3;
    const int tid = p.tid(), lane = tid & 63, wid = tid >> 6, fr = lane & 15, fq = lane >> 4;
    float* FLW = (float*)(smem + O_FLW); float* FKK = (float*)(smem + O_FKK); float* FB = (float*)(smem + O_FB); float* FKW = (float*)(smem + O_FKW); float* FV = (float*)(smem + O_FV); float* FR = (float*)(smem + O_FR);
    float* CS = (float*)(smem + O_CS); unsigned char* pk = smem + P_PK; float* PT = (float*)(pk + K_PT); float* GM = (float*)(pk + K_GM); float* GG = (float*)(pk + K_GG); bf16_t* RQSb = (bf16_t*)(pk + K_RQS);
    unsigned char* TWb = smem + P_TW; unsigned char* TAb = smem + P_TA;
    unsigned char* WUT = smem + P_WUT; unsigned char* AUT = smem + P_AUT;
    float* LWP = (float*)(smem + P_LWP); float* APP = (float*)(smem + P_APP);
    const int lq = tid & 15, lt = tid >> 4;
    const float* mu = p.rw_mu() + (size_t)layer * 2 * 896;
    float4 mu_lo[4], mu_hi[4], inv_w0 = make_float4(0.f, 0.f, 0.f, 0.f), inv_a0 = inv_w0, inv_kk = inv_w0, inv_ka = inv_w0;
    float* CWL = (float*)(smem + P_CWL);
#pragma unroll
    for (int i = 0; i < 4; ++i) { mu_lo[i] = inv_w0; mu_hi[i] = inv_w0; }
    if (!is_dn) { const int c4 = h * 64 + lq * 4; const int cols[4] = {768 + lq * 4, c4, 512 + c4, 256 + c4};
#pragma unroll
        for (int i = 0; i < 4; ++i) { mu_lo[i] = *(const float4*)(mu + cols[i]); mu_hi[i] = *(const float4*)(mu + 896 + cols[i]); }
        inv_w0 = *(const float4*)(p.rw_w0() + (layer * 2 + d) * 256 + c4); inv_a0 = *(const float4*)(p.rw_a0() + (layer * 2 + d) * 256 + c4);
        inv_kk = *(const float4*)(p.rw_k_k() + layer * 256 + c4); inv_ka = *(const float4*)(p.rw_k_a() + layer * 256 + c4);
    } else {
        for (int i = tid; i < 15 * 64; i += NTHR) { const int st = i >> 6, j = i & 63, s3 = st / 5, tap = st % 5; CWL[i] = p.dn_conv()[((size_t)layer * 5 + tap) * 768 + s3 * 256 + h * 64 + j]; }
    }
    const float dn_A = is_dn ? expf(p.dn_a_log()[(layer * 2 + d) * 4 + h]) : 0.f;
    const float dn_dtb = is_dn ? p.dn_dt_bias()[(layer * 2 + d) * 4 + h] : 0.f;
    if (!is_dn) for (int i = tid; i < 32 * 64; i += NTHR) { const int i2 = i >> 6, j = i & 63;
        ((bf16_t*)WUT)[j * LD32 + i2] = f2bf(p.rw_w_up()[((size_t)(layer * 2 + d) * 32 + i2) * 256 + h * 64 + j]); ((bf16_t*)AUT)[j * LD32 + i2] = f2bf(p.rw_a_up()[((size_t)(layer * 2 + d) * 32 + i2) * 256 + h * 64 + j]); }
    const int cg = (is_dn ? 64 : 0) + chain;
    unsigned* fl = p.ctl() + CW_RING + (layer * 128 + cg) * 32;
    unsigned char* ring = (unsigned char*)p.Y() + (size_t)cg * RING_R * PKG_BYTES;
    const __amdgpu_buffer_rsrc_t ring_rs = __builtin_amdgcn_make_buffer_rsrc((void*)ring, 0, RING_R * PKG_BYTES, 0x00020000);
    unsigned cons_seen = 0u;
    __syncthreads();
    constexpr int NCH = (L + LC) / CT;
    RawP cur = load_rawp<is_dn>(p, b, d, h, lq, lt, 0);
#pragma unroll 1
    for (int ch = 0; ch < NCH; ++ch) {
        if (ch == 0 || ch == 7 || ch == 8 || ch == NCH - 1) rawp_fix<is_dn>(cur, b, d, lt, ch);
        if (!is_dn) {
            const float4 sv0 = rw_mix(cur.x[0], mu_lo[0], mu_hi[0]), rs4 = rw_mix(cur.x[1], mu_lo[1], mu_hi[1]), vs4 = rw_mix(cur.x[2], mu_lo[2], mu_hi[2]), ks4 = rw_mix(cur.x[3], mu_lo[3], mu_hi[3]);
            cur = load_rawp<is_dn>(p, b, d, h, lq, lt, ch + 1 < NCH ? ch + 1 : ch);
            { const float4 sv = sv0;
              if (lq < 8) st4bf(TWb, lt, LD32, lq * 4, fast_tanh(sv.x), fast_tanh(sv.y), fast_tanh(sv.z), fast_tanh(sv.w));
              else st4bf(TAb, lt, LD32, (lq - 8) * 4, sv.x, sv.y, sv.z, sv.w); }
            __syncthreads();
            { const int mt = wid & 1, nt = wid >> 1;
              const bf16x8 aw = lds_frag(TWb, mt * 16 + fr, LD32, fq * 8), aa = lds_frag(TAb, mt * 16 + fr, LD32, fq * 8);
              const bf16x8 bw = lds_frag(WUT, nt * 16 + fr, LD32, fq * 8), ba = lds_frag(AUT, nt * 16 + fr, LD32, fq * 8);
              f32x4 cw = (f32x4){0.f, 0.f, 0.f, 0.f}, ca = cw;
              cw = __builtin_amdgcn_mfma_f32_16x16x32_bf16(bw, aw, cw, 0, 0, 0); ca = __builtin_amdgcn_mfma_f32_16x16x32_bf16(ba, aa, ca, 0, 0, 0);
              *(float4*)(LWP + (mt * 16 + fr) * 64 + nt * 16 + 4 * fq) = make_float4(cw[0], cw[1], cw[2], cw[3]);
              *(float4*)(APP + (mt * 16 + fr) * 64 + nt * 16 + 4 * fq) = make_float4(ca[0], ca[1], ca[2], ca[3]); }
            __syncthreads();
            float4 lwv = *(const float4*)(LWP + lt * 64 + lq * 4), apv = *(const float4*)(APP + lt * 64 + lq * 4);
            lwv.x += inv_w0.x; lwv.y += inv_w0.y; lwv.z += inv_w0.z; lwv.w += inv_w0.w; apv.x += inv_a0.x; apv.y += inv_a0.y; apv.z += inv_a0.z; apv.w += inv_a0.w;
            const float4 av = make_float4(sigm(apv.x), sigm(apv.y), sigm(apv.z), sigm(apv.w));
            *(float4*)(FLW + lt * 64 + lq * 4) = make_float4(-0.6065306597f * sigm(lwv.x), -0.6065306597f * sigm(lwv.y), -0.6065306597f * sigm(lwv.z), -0.6065306597f * sigm(lwv.w));
            *(float4*)(FR + lt * 64 + lq * 4) = rs4;
            *(float4*)(FV + lt * 64 + lq * 4) = vs4;
            const float4 ks = ks4;
            float4 kk = make_float4(ks.x * inv_kk.x, ks.y * inv_kk.y, ks.z * inv_kk.z, ks.w * inv_kk.w);
            float ssq = (kk.x * kk.x + kk.y * kk.y) + (kk.z * kk.z + kk.w * kk.w);
            ssq += __shfl_xor(ssq, 1); ssq += __shfl_xor(ssq, 2); ssq += __shfl_xor(ssq, 4); ssq += __shfl_xor(ssq, 8);
            const float rn = rsqrtf(ssq + 1e-6f);
            kk.x *= rn; kk.y *= rn; kk.z *= rn; kk.w *= rn;
            *(float4*)(FKK + lt * 64 + lq * 4) = kk;
            *(float4*)(FB + lt * 64 + lq * 4) = make_float4(kk.x * av.x, kk.y * av.y, kk.z * av.z, kk.w * av.w);
            *(float4*)(FKW + lt * 64 + lq * 4) = make_float4(ks.x * (1.f + (av.x - 1.f) * inv_ka.x), ks.y * (1.f + (av.y - 1.f) * inv_ka.y), ks.z * (1.f + (av.z - 1.f) * inv_ka.z), ks.w * (1.f + (av.w - 1.f) * inv_ka.w));
        } else {
            float u[3][4]; float sq = 0.f, sk = 0.f;
            const float al_raw = bf2f(cur.alr), be_raw = bf2f(cur.ber);
#pragma unroll
            for (int s3 = 0; s3 < 3; ++s3) { float a0 = 0.f, a1 = 0.f, a2 = 0.f, a3 = 0.f;
#pragma unroll
                for (int tap = 0; tap < 5; ++tap) { const float4 cw = *(const float4*)(CWL + (s3 * 5 + tap) * 64 + lq * 4); const uint2 x = cur.xv[s3][tap];
                    a0 += cw.x * lo2f(x.x); a1 += cw.y * hi2f(x.x); a2 += cw.z * lo2f(x.y); a3 += cw.w * hi2f(x.y); }
                u[s3][0] = a0; u[s3][1] = a1; u[s3][2] = a2; u[s3][3] = a3; }
            asm volatile("" : "+v"(u[0][0]), "+v"(u[0][1]), "+v"(u[0][2]), "+v"(u[0][3]), "+v"(u[1][0]), "+v"(u[1][1]), "+v"(u[1][2]), "+v"(u[1][3]), "+v"(u[2][0]), "+v"(u[2][1]), "+v"(u[2][2]), "+v"(u[2][3]));
            cur = load_rawp<is_dn>(p, b, d, h, lq, lt, ch + 1 < NCH ? ch + 1 : ch);
#pragma unroll
            for (int s3 = 0; s3 < 3; ++s3)
#pragma unroll
                for (int i = 0; i < 4; ++i) u[s3][i] = silu_(u[s3][i]);
#pragma unroll
            for (int i = 0; i < 4; ++i) { sq += u[0][i] * u[0][i]; sk += u[1][i] * u[1][i]; }
            sq += __shfl_xor(sq, 1); sq += __shfl_xor(sq, 2); sq += __shfl_xor(sq, 4); sq += __shfl_xor(sq, 8);
            sk += __shfl_xor(sk, 1); sk += __shfl_xor(sk, 2); sk += __shfl_xor(sk, 4); sk += __shfl_xor(sk, 8);
            const float qn = rsqrtf(sq + 1e-6f) * 0.125f, kn = rsqrtf(sk + 1e-6f);
            const float la = -dn_A * softplus_(al_raw + dn_dtb), a = __expf(la), beta = sigm(be_raw);
#pragma unroll
            for (int i = 0; i < 4; ++i) { const int j = lq * 4 + i; const float k = u[1][i] * kn;
                FLW[lt * 64 + j] = la; FKK[lt * 64 + j] = k; FB[lt * 64 + j] = a * beta * k; FKW[lt * 64 + j] = beta * k; FV[lt * 64 + j] = u[2][i]; FR[lt * 64 + j] = u[0][i] * qn; }
        }
        __syncthreads();
        const int k = tid & 63, tg = tid >> 6, t0 = tg * 4;
        float c0 = FLW[(t0 + 0) * 64 + k], c1 = c0 + FLW[(t0 + 1) * 64 + k], c2 = c1 + FLW[(t0 + 2) * 64 + k], c3 = c2 + FLW[(t0 + 3) * 64 + k];
        CS[tg * 64 + k] = c3;
        __syncthreads();
        {
            float off = 0.f, tot = 0.f;
#pragma unroll
            for (int g2 = 0; g2 < 8; ++g2) { const float s = CS[g2 * 64 + k]; tot += s; if (g2 < tg) off += s; }
            const float cum[4] = {off + c0, off + c1, off + c2, off + c3}; const float cumm[4] = {off, off + c0, off + c1, off + c2};
            float qk[4], bt[4], kt[4], vv[4];
#pragma unroll
            for (int j = 0; j < 4; ++j) { const int t = t0 + j; const float kkv = FKK[t * 64 + k], bv = FB[t * 64 + k], kwv = FKW[t * 64 + k], rv = FR[t * 64 + k];
                const float em = __expf(cumm[j]), ec = __expf(cum[j]), ee = __expf(tot - cum[j]);
                vv[j] = FV[t * 64 + k]; qk[j] = kkv * em; bt[j] = bv * ee; kt[j] = kwv * ee;
                RQSb[t * 64 + k] = f2bf(rv * ec);
                if (!is_dn) { const float ei = __expf(-cum[j]);
                    ((bf16_t*)(pk + K_QK))[t * LD64 + k] = f2bf(kkv * em); ((bf16_t*)(pk + K_RQ))[t * LD64 + k] = f2bf(rv * ec);
                    ((bf16_t*)(pk + K_BH))[t * LD64 + k] = f2bf(bv * ei); ((bf16_t*)(pk + K_KH))[t * LD64 + k] = f2bf(kwv * ei);
                } else {
                    ((bf16_t*)(pk + K_QK))[t * LD64 + k] = f2bf(kkv); ((bf16_t*)(pk + K_RQ))[t * LD64 + k] = f2bf(rv);
                    ((bf16_t*)(pk + K_BH))[t * LD64 + k] = f2bf(bv); ((bf16_t*)(pk + K_KH))[t * LD64 + k] = f2bf(kwv);
                    if (k == 0) { GM[t] = cumm[j]; GG[t] = cum[j]; }
                } }
            st4bf(pk + K_QKT, k, LD32, t0, qk[0], qk[1], qk[2], qk[3]); st4bf(pk + K_BT, k, LD32, t0, bt[0], bt[1], bt[2], bt[3]);
            st4bf(pk + K_KT, k, LD32, t0, kt[0], kt[1], kt[2], kt[3]); st4bf(pk + K_VT, k, LD32, t0, vv[0], vv[1], vv[2], vv[3]);
            if (tg == 0) PT[k] = __expf(tot);
        }
        asm volatile("s_waitcnt vmcnt(0)" ::: "memory");
        __syncthreads();
        if (tid == 0 && ch > 0) __hip_atomic_store(fl, (unsigned)ch, __ATOMIC_RELAXED, __HIP_MEMORY_SCOPE_AGENT);
        if (ch >= RING_R) ring_wait(fl + 16, (unsigned)(ch - RING_R + 1), cons_seen, p.ctl() + CW_BAR);
        { const unsigned so = (unsigned)(ch & (RING_R - 1)) * (unsigned)PKG_BYTES;
#pragma unroll
          for (int r = 0; r < 6; ++r) { const int o = (r * NTHR + tid) * 16;
              if (r < 5 || tid < 256) { const pg8::u32x4 v = *(const pg8::u32x4*)(pk + o); __builtin_amdgcn_raw_buffer_store_b128(v, ring_rs, so + (unsigned)o, 0, 16); } } }
    }
    asm volatile("s_waitcnt vmcnt(0)" ::: "memory");
    __syncthreads();
    if (tid == 0) __hip_atomic_store(fl, (unsigned)NCH, __ATOMIC_RELAXED, __HIP_MEMORY_SCOPE_AGENT);
}

template <bool is_dn>
__device__ __forceinline__ void scan_consumer(const P& p, int layer, int chain, unsigned char* smem) {
    const int d = chain & 1, h = (chain >> 1) & 3, b = chain >> 3;
    const int tid = p.tid(), lane = tid & 63, wid = tid >> 6, fr = lane & 15, fq = lane >> 4;
    float* AAB = (float*)(smem + O_AAB);
    const int cg = (is_dn ? 64 : 0) + chain;
    unsigned* fl = p.ctl() + CW_RING + (layer * 128 + cg) * 32;
    const unsigned char* ring = (const unsigned char*)p.Y() + (size_t)cg * RING_R * PKG_BYTES;
    PG8_LAS unsigned char* sl = (PG8_LAS unsigned char*)smem;
    bf16_t* yout = p.YS() + (size_t)((is_dn ? 2 : 0) + d) * RT * 256;
    f32x4 Sacc[2]; Sacc[0] = (f32x4){0.f, 0.f, 0.f, 0.f}; Sacc[1] = Sacc[0];
    for (int i = tid; i < 2 * 9216 / 4; i += NTHR) ((unsigned*)(smem + C_S0))[i] = 0u;
    constexpr int NCH = (L + LC) / CT;
    unsigned prod_seen = 0u;
#define RING_DMA(c) do { ring_wait(fl, (unsigned)((c) + 1), prod_seen, p.ctl() + CW_BAR); \
        const unsigned char* src_ = ring + (size_t)((c) & (RING_R - 1)) * PKG_BYTES + wid * 1024 + lane * 16; const int dst_ = C_PKG + ((c) & 1) * PKG_BYTES + wid * 1024; \
        _Pragma("unroll") for (int r_ = 0; r_ < 5; ++r_) __builtin_amdgcn_global_load_lds((const unsigned*)(src_ + r_ * 8192), (PG8_LAS unsigned*)(sl + dst_ + r_ * 8192), 16, 0, 16); \
        if (wid < 4) __builtin_amdgcn_global_load_lds((const unsigned*)(src_ + 5 * 8192), (PG8_LAS unsigned*)(sl + dst_ + 5 * 8192), 16, 0, 16); } while (0)
    RING_DMA(0);
    asm volatile("s_waitcnt vmcnt(0)" ::: "memory");
    __syncthreads();
    if (tid == 0) __hip_atomic_store(fl + 16, 1u, __ATOMIC_RELAXED, __HIP_MEMORY_SCOPE_AGENT);
#pragma unroll 1
    for (int ch = 0; ch < NCH; ++ch) {
        const unsigned char* pk = smem + C_PKG + (ch & 1) * PKG_BYTES;
        if (ch + 1 < NCH) RING_DMA(ch + 1);
        {
            const int mi = wid >> 1, hf = wid & 1;
            const unsigned char* Ab = pk + (mi < 2 ? K_QK : K_RQ); const unsigned char* Bb = pk + ((mi & 1) ? K_KH : K_BH);
            f32x4 acc[2]; acc[0] = (f32x4){0.f, 0.f, 0.f, 0.f}; acc[1] = acc[0];
#pragma unroll
            for (int ks = 0; ks < 2; ++ks) { const bf16x8 af = lds_frag(Ab, hf * 16 + fr, LD64, ks * 32 + fq * 8);
#pragma unroll
                for (int nt = 0; nt < 2; ++nt) { const bf16x8 bfv = lds_frag(Bb, nt * 16 + fr, LD64, ks * 32 + fq * 8); acc[nt] = __builtin_amdgcn_mfma_f32_16x16x32_bf16(bfv, af, acc[nt], 0, 0, 0); } }
            const int t = hf * 16 + fr; const float* GM = (const float*)(pk + K_GM); const float* GG = (const float*)(pk + K_GG); const float gt = is_dn ? (mi < 2 ? GM[t] : GG[t]) : 0.f;
#pragma unroll
            for (int nt = 0; nt < 2; ++nt) { float o[4];
#pragma unroll
                for (int j = 0; j < 4; ++j) { const int i = nt * 16 + 4 * fq + j; const bool keep = mi < 2 ? (i < t) : (i <= t); float val = keep ? acc[nt][j] : 0.f;
                    if (is_dn && keep) val *= __expf(gt - GG[i]); o[j] = val; }
                const int i0 = nt * 16 + 4 * fq;
                if (mi == 0) *(float4*)(AAB + t * 36 + i0) = make_float4(o[0], o[1], o[2], o[3]);
                else st4bf(smem + (mi == 1 ? O_AAK : (mi == 2 ? O_ARB : O_ARK)), t, LD32, i0, o[0], o[1], o[2], o[3]); }
        }
        __syncthreads();
        if (wid == 0) {
            bf16_t* TINV = (bf16_t*)(smem + O_TINV); bf16_t* TINVT = (bf16_t*)(smem + O_TINVT); bf16_t* M1T = (bf16_t*)(smem + O_M1T);
            if (lane < 32) { const int blk = lane >> 4, j = lane & 15; float x[16];
#pragma unroll
                for (int t = 0; t < 16; ++t) { float s = (t == j) ? 1.f : 0.f, s2 = 0.f; const float* rowp = AAB + (blk * 16 + t) * 36 + blk * 16;
                    float rv[16];
#pragma unroll
                    for (int i4 = 0; i4 < 16; i4 += 4) if (i4 < t) { const float4 q4 = *(const float4*)(rowp + i4); rv[i4] = q4.x; rv[i4 + 1] = q4.y; rv[i4 + 2] = q4.z; rv[i4 + 3] = q4.w; }
#pragma unroll
                    for (int i = 0; i < t; ++i) { if (i & 1) s2 -= rv[i] * x[i]; else s -= rv[i] * x[i]; }
                    x[t] = s + s2; }
#pragma unroll
                for (int t = 0; t < 16; ++t) TINV[(blk * 16 + t) * LD32 + blk * 16 + j] = f2bf(x[t]);
                if (blk == 0) {
#pragma unroll
                    for (int t = 0; t < 16; t += 4) st4bf(smem + O_TINVT, j, LD32, t, x[t], x[t + 1], x[t + 2], x[t + 3]); }
            } else { const int r = lane - 32;
#pragma unroll
                for (int t = 0; t < 16; t += 4) if (r < 16) st4bf(smem + O_TINV, r, LD32, 16 + t, 0.f, 0.f, 0.f, 0.f); }
            asm volatile("s_waitcnt lgkmcnt(0)" ::: "memory");
            bf16x8 af, bfv; const bf16x8 zf = {0, 0, 0, 0, 0, 0, 0, 0};
            if (fq < 2) { const float* lp = AAB + (16 + fr) * 36 + fq * 8; uint4 w; w.x = pack2(lp[0], lp[1]); w.y = pack2(lp[2], lp[3]); w.z = pack2(lp[4], lp[5]); w.w = pack2(lp[6], lp[7]); af = __builtin_bit_cast(bf16x8, w);
                bfv = lds_frag(smem + O_TINVT, fr, LD32, fq * 8); } else { af = zf; bfv = zf; }
            f32x4 m1 = (f32x4){0.f, 0.f, 0.f, 0.f};
            m1 = __builtin_amdgcn_mfma_f32_16x16x32_bf16(bfv, af, m1, 0, 0, 0);
#pragma unroll
            for (int j = 0; j < 4; ++j) M1T[(4 * fq + j) * LD32 + fr] = f2bf(m1[j]);
            asm volatile("s_waitcnt lgkmcnt(0)" ::: "memory");
            if (fq < 2) { af = lds_frag(smem + O_TINV, 16 + fr, LD32, 16 + fq * 8); bfv = lds_frag(smem + O_M1T, fr, LD32, fq * 8); } else { af = zf; bfv = zf; }
            f32x4 x21 = (f32x4){0.f, 0.f, 0.f, 0.f};
            x21 = __builtin_amdgcn_mfma_f32_16x16x32_bf16(bfv, af, x21, 0, 0, 0);
            st4bf(smem + O_TINV, 16 + fr, LD32, 4 * fq, -x21[0], -x21[1], -x21[2], -x21[3]);
        }
        __syncthreads();
        {
            const int mt = wid & 3, nt = wid >> 2;
            { const bf16x8 af = lds_frag(pk + K_QKT, mt * 16 + fr, LD32, fq * 8), bfv = lds_frag(smem + O_TINV, nt * 16 + fr, LD32, fq * 8);
              f32x4 acc = (f32x4){0.f, 0.f, 0.f, 0.f}; acc = __builtin_amdgcn_mfma_f32_16x16x32_bf16(bfv, af, acc, 0, 0, 0);
              st4bf(smem + O_WT, mt * 16 + fr, LD32, nt * 16 + 4 * fq, acc[0], acc[1], acc[2], acc[3]); }
            { const bf16x8 af = lds_frag(pk + K_VT, mt * 16 + fr, LD32, fq * 8), bfv = lds_frag(smem + O_AAK, nt * 16 + fr, LD32, fq * 8);
              f32x4 acc = (f32x4){0.f, 0.f, 0.f, 0.f}; acc = __builtin_amdgcn_mfma_f32_16x16x32_bf16(bfv, af, acc, 0, 0, 0);
              st4bf(smem + O_AVT, mt * 16 + fr, LD32, nt * 16 + 4 * fq, acc[0], acc[1], acc[2], acc[3]); }
        }
        __syncthreads();
        {
            { const int mt = wid & 3, nt = wid >> 2;
              const bf16x8 af = lds_frag(smem + O_AVT, mt * 16 + fr, LD32, fq * 8), bfv = lds_frag(smem + O_TINV, nt * 16 + fr, LD32, fq * 8);
              f32x4 acc = (f32x4){0.f, 0.f, 0.f, 0.f}; acc = __builtin_amdgcn_mfma_f32_16x16x32_bf16(bfv, af, acc, 0, 0, 0);
              st4bf(smem + O_U0T, mt * 16 + fr, LD32, nt * 16 + 4 * fq, -acc[0], -acc[1], -acc[2], -acc[3]); }
            { const int mt = wid & 1, nt = wid >> 1;
              const bf16x8 af = lds_frag(smem + O_ARB, mt * 16 + fr, LD32, fq * 8), bfv = lds_frag(smem + O_WT, nt * 16 + fr, LD32, fq * 8);
              f32x4 acc = (f32x4){0.f, 0.f, 0.f, 0.f}; acc = __builtin_amdgcn_mfma_f32_16x16x32_bf16(bfv, af, acc, 0, 0, 0);
              const int t = mt * 16 + fr, k0 = nt * 16 + 4 * fq; const uint2 rq2 = *(const uint2*)(pk + K_RQS + (t * 64 + k0) * 2); const float4 rq = make_float4(lo2f(rq2.x), hi2f(rq2.x), lo2f(rq2.y), hi2f(rq2.y));
              st4bf(smem + O_REFF, t, LD64, k0, rq.x - acc[0], rq.y - acc[1], rq.z - acc[2], rq.w - acc[3]); }
#pragma unroll
            for (int j2 = 0; j2 < 2; ++j2) { const int mt = wid & 3, nt = (wid >> 2) * 2 + j2;
              const bf16x8 af = lds_frag(pk + K_BT, mt * 16 + fr, LD32, fq * 8), bfv = lds_frag(smem + O_WT, nt * 16 + fr, LD32, fq * 8);
              f32x4 acc = (f32x4){0.f, 0.f, 0.f, 0.f}; acc = __builtin_amdgcn_mfma_f32_16x16x32_bf16(bfv, af, acc, 0, 0, 0);
              st4bf(smem + O_MC, mt * 16 + fr, LD64, nt * 16 + 4 * fq, -acc[0], -acc[1], -acc[2], -acc[3]); }
        }
        asm volatile("s_waitcnt vmcnt(0)" ::: "memory");
        __syncthreads();
        if (tid == 0 && ch + 1 < NCH) __hip_atomic_store(fl + 16, (unsigned)(ch + 2), __ATOMIC_RELAXED, __HIP_MEMORY_SCOPE_AGENT);
        {
            const unsigned char* S0c = smem + C_S0 + (ch & 1) * 9216; unsigned char* S0n = smem + C_S0 + ((ch + 1) & 1) * 9216;
            { const int mt = wid & 1, nt = wid >> 1;
              f32x4 acc = (f32x4){0.f, 0.f, 0.f, 0.f};
#pragma unroll
              for (int ks = 0; ks < 2; ++ks) acc = __builtin_amdgcn_mfma_f32_16x16x32_bf16(lds_frag(S0c, nt * 16 + fr, LD64, ks * 32 + fq * 8), lds_frag(smem + O_REFF, mt * 16 + fr, LD64, ks * 32 + fq * 8), acc, 0, 0, 0);
              acc = __builtin_amdgcn_mfma_f32_16x16x32_bf16(lds_frag(smem + O_U0T, nt * 16 + fr, LD32, fq * 8), lds_frag(smem + O_ARB, mt * 16 + fr, LD32, fq * 8), acc, 0, 0, 0);
              acc = __builtin_amdgcn_mfma_f32_16x16x32_bf16(lds_frag(pk + K_VT, nt * 16 + fr, LD32, fq * 8), lds_frag(smem + O_ARK, mt * 16 + fr, LD32, fq * 8), acc, 0, 0, 0);
              int yb, yl, ylen; scan_pos(b, d, ch * CT + mt * 16 + fr, yb, yl, ylen);
              uint2 o; o.x = pack2(acc[0], acc[1]); o.y = pack2(acc[2], acc[3]);
              *(uint2*)(yout + (size_t)(yb + yl) * 256 + h * 64 + nt * 16 + 4 * fq) = o; }
#pragma unroll
            for (int j2 = 0; j2 < 2; ++j2) { const int mt = wid & 3, nt = (wid >> 2) * 2 + j2;
              const float4 pt = *(const float4*)(pk + K_PT + (nt * 16 + 4 * fq) * 4);
              f32x4 acc = Sacc[j2]; acc[0] *= pt.x; acc[1] *= pt.y; acc[2] *= pt.z; acc[3] *= pt.w;
#pragma unroll
              for (int ks = 0; ks < 2; ++ks) acc = __builtin_amdgcn_mfma_f32_16x16x32_bf16(lds_frag(smem + O_MC, nt * 16 + fr, LD64, ks * 32 + fq * 8), lds_frag(S0c, mt * 16 + fr, LD64, ks * 32 + fq * 8), acc, 0, 0, 0);
              acc = __builtin_amdgcn_mfma_f32_16x16x32_bf16(lds_frag(pk + K_BT, nt * 16 + fr, LD32, fq * 8), lds_frag(smem + O_U0T, mt * 16 + fr, LD32, fq * 8), acc, 0, 0, 0);
              acc = __builtin_amdgcn_mfma_f32_16x16x32_bf16(lds_frag(pk + K_KT, nt * 16 + fr, LD32, fq * 8), lds_frag(pk + K_VT, mt * 16 + fr, LD32, fq * 8), acc, 0, 0, 0);
              Sacc[j2] = acc;
              st4bf(S0n, mt * 16 + fr, LD64, nt * 16 + 4 * fq, acc[0], acc[1], acc[2], acc[3]); }
        }
        __syncthreads();
    }
}
#undef RING_DMA

__device__ __forceinline__ void s5_state_scan(const P& p, int layer) {
    if (p.bid() >= 32) return;
    const int pr = p.bid() * 4 + (p.wid() >> 1), b = pr >> 4, g = pr & 15, d = p.wid() & 1, pp = p.lane();
    float2 lam = p.LAMB()[((size_t)(layer * 2 + d) * 16 + g) * 64 + pp];
#pragma unroll
    for (int k = 0; k < 4; ++k) lam = make_float2(lam.x * lam.x - lam.y * lam.y, 2.f * lam.x * lam.y);
    float sr = 0.f, si = 0.f;
    const size_t rb = (size_t)g * S5ROWS + (size_t)b * 272;
    bf16_t* ac = p.AC() + 256 + 2 * (d * 64 + pp); const bf16_t* vv = p.V() + 2 * (d * 64 + pp);
#pragma unroll 1
    for (int bt = 0; bt < 4; ++bt) {
        unsigned vreg[68];
#pragma unroll
        for (int i = 0; i < 68; ++i) { const int st = bt * 68 + i; const int cf = d == 0 ? st : (st < 16 ? 15 - st : 287 - st);
            vreg[i] = *(const unsigned*)(vv + (rb + cf) * 256); }
        asm volatile("" ::: "memory");
#pragma unroll
        for (int i = 0; i < 68; ++i) { const int st = bt * 68 + i; const int cf = d == 0 ? st : (st < 16 ? 15 - st : 287 - st);
            __hip_atomic_store((unsigned*)(ac + (rb + cf) * 512), pack2(sr, si), __ATOMIC_RELAXED, __HIP_MEMORY_SCOPE_AGENT);
            const unsigned v = vreg[i];
            const float nr = lam.x * sr - lam.y * si + lo2f(v), ni = lam.x * si + lam.y * sr + hi2f(v);
            sr = nr; si = ni; }
    }
}

__device__ __forceinline__ void fourier_a_init(const P& p, unsigned char* smem) {
    bf16_t* DA = (bf16_t*)smem;
    for (int i = p.tid(); i < 64 * 64; i += NTHR) { const int q2 = i >> 6, pp = i & 63; float s, c; sincospif(2.f * (float)((q2 * pp) & 63) / 64.f, &s, &c);
        *(unsigned*)(DA + q2 * 136 + 2 * pp) = pack2(c, -s); *(unsigned*)(DA + (64 + q2) * 136 + 2 * pp) = pack2(-s, -c); }
    __syncthreads();
}
__device__ __forceinline__ void fourier_a(const P& p, int item, unsigned char* smem) {
    unsigned char* DAb = smem; unsigned char* DTb = smem + 34816; bf16_t* DT = (bf16_t*)DTb;
    const int chb = item & 3, q = (item >> 2) & 63, b = item >> 8;
    const int lane = p.lane(), wid = p.wid(), fr = lane & 15, fq = lane >> 4;
    { const int pp = p.tid() >> 3, c8 = (p.tid() & 7) * 8; const size_t row = (size_t)b * L + 64 * pp + q;
      const uint4 a = *(const uint4*)(p.PM() + row * NP + PC_FC + chb * 64 + c8), s = *(const uint4*)(p.PM() + row * NP + PC_FS + chb * 64 + c8);
      const unsigned av[4] = {a.x, a.y, a.z, a.w}, sv[4] = {s.x, s.y, s.z, s.w};
#pragma unroll
      for (int j = 0; j < 4; ++j) {
          *(unsigned*)(DT + (c8 + 2 * j) * 136 + 2 * pp) = (av[j] & 0xFFFFu) | (sv[j] << 16);
          *(unsigned*)(DT + (c8 + 2 * j + 1) * 136 + 2 * pp) = (av[j] >> 16) | (sv[j] & 0xFFFF0000u); } }
    __syncthreads();
    const int mt = wid & 3, q2 = mt * 16 + fr;
    float sn, cs; sincospif(2.f * (float)(q * q2) / 4096.f, &sn, &cs);
#pragma unroll
    for (int j2 = 0; j2 < 2; ++j2) { const int nt = (wid >> 2) * 2 + j2;
        f32x4 ar = (f32x4){0.f, 0.f, 0.f, 0.f}, ai = ar;
#pragma unroll
        for (int ks = 0; ks < 4; ++ks) { const bf16x8 bfv = lds_frag(DTb, nt * 16 + fr, 136, ks * 32 + fq * 8);
            ar = __builtin_amdgcn_mfma_f32_16x16x32_bf16(bfv, lds_frag(DAb, mt * 16 + fr, 136, ks * 32 + fq * 8), ar, 0, 0, 0);
            ai = __builtin_amdgcn_mfma_f32_16x16x32_bf16(bfv, lds_frag(DAb, 64 + mt * 16 + fr, 136, ks * 32 + fq * 8), ai, 0, 0, 0); }
        const size_t row = (size_t)b * L + 64 * q2 + q; const int c0 = chb * 64 + nt * 16 + 4 * fq;
        uint2 o; o.x = pack2(ar[0] * cs + ai[0] * sn, ar[1] * cs + ai[1] * sn); o.y = pack2(ar[2] * cs + ai[2] * sn, ar[3] * cs + ai[3] * sn);
        *(uint2*)(p.PM() + row * NP + PC_FC + c0) = o;
        o.x = pack2(ai[0] * cs - ar[0] * sn, ai[1] * cs - ar[1] * sn); o.y = pack2(ai[2] * cs - ar[2] * sn, ai[3] * cs - ar[3] * sn);
        *(uint2*)(p.PM() + row * NP + PC_FS + c0) = o; }
    __syncthreads();
}
__device__ __forceinline__ void fourier_b_init(const P& p, unsigned char* smem) {
    bf16_t* DM = (bf16_t*)smem;
    for (int i = p.tid(); i < 64 * 64; i += NTHR) { const int p2 = i >> 6, q = i & 63; float s, c; sincospif(2.f * (float)((p2 * q) & 63) / 64.f, &s, &c);
        *(unsigned*)(DM + p2 * 136 + 2 * q) = pack2(c, s); }
    __syncthreads();
}
__device__ __forceinline__ void fourier_b(const P& p, int item, unsigned char* smem) {
    unsigned char* DMb = smem; unsigned char* DTb = smem + 17408; bf16_t* DT = (bf16_t*)DTb;
    const int chb = item & 3, q2 = (item >> 2) & 63, b = item >> 8;
    const int lane = p.lane(), wid = p.wid(), fr = lane & 15, fq = lane >> 4;
    { const int q = p.tid() >> 3, c8 = (p.tid() & 7) * 8; const size_t row = (size_t)b * L + 64 * q2 + q;
      const uint4 a = *(const uint4*)(p.PM() + row * NP + PC_FC + chb * 64 + c8), s = *(const uint4*)(p.PM() + row * NP + PC_FS + chb * 64 + c8);
      const unsigned av[4] = {a.x, a.y, a.z, a.w}, sv[4] = {s.x, s.y, s.z, s.w};
#pragma unroll
      for (int j = 0; j < 4; ++j) {
          *(unsigned*)(DT + (c8 + 2 * j) * 136 + 2 * q) = (av[j] & 0xFFFFu) | (sv[j] << 16);
          *(unsigned*)(DT + (c8 + 2 * j + 1) * 136 + 2 * q) = (av[j] >> 16) | (sv[j] & 0xFFFF0000u); } }
    __syncthreads();
#pragma unroll
    for (int j2 = 0; j2 < 2; ++j2) { const int mt = wid & 3, nt = (wid >> 2) * 2 + j2;
        f32x4 acc = (f32x4){0.f, 0.f, 0.f, 0.f};
#pragma unroll
        for (int ks = 0; ks < 4; ++ks) acc = __builtin_amdgcn_mfma_f32_16x16x32_bf16(lds_frag(DTb, nt * 16 + fr, 136, ks * 32 + fq * 8), lds_frag(DMb, mt * 16 + fr, 136, ks * 32 + fq * 8), acc, 0, 0, 0);
        const size_t row = (size_t)b * L + 64 * (mt * 16 + fr) + q2; const float sc = 1.f / 512.f;
        uint2 o; o.x = pack2(acc[0] * sc, acc[1] * sc); o.y = pack2(acc[2] * sc, acc[3] * sc);
        *(uint2*)(p.Y() + row * D + chb * 64 + nt * 16 + 4 * fq) = o; }
    __syncthreads();
}
__device__ __forceinline__ void fourier_ctx(const P& p, int item, unsigned char* smem) {
    unsigned* twb = (unsigned*)smem;
    unsigned char* ZTb = smem + 1024; bf16_t* ZT = (bf16_t*)ZTb;
    constexpr int LDZ = 520;
    const int chb = item & 7, b = item >> 3;
    const int lane = p.lane(), wid = p.wid(), fr = lane & 15, fq = lane >> 4;
    if (p.tid() < 256) { float s, c; sincospif(2.f * p.tid() / 256.f, &s, &c); twb[p.tid()] = pack2(c, s); }
    for (int i = p.tid(); i < 256 * 4; i += NTHR) { const int l = i >> 2, c8 = (i & 3) * 8; const size_t row = (size_t)RL + b * LC + l;
        const uint4 a = *(const uint4*)(p.PM() + row * NP + PC_FC + chb * 32 + c8), s = *(const uint4*)(p.PM() + row * NP + PC_FS + chb * 32 + c8);
        const unsigned av[4] = {a.x, a.y, a.z, a.w}, sv[4] = {s.x ^ 0x80008000u, s.y ^ 0x80008000u, s.z ^ 0x80008000u, s.w ^ 0x80008000u};
#pragma unroll
        for (int j = 0; j < 4; ++j) { ZT[(c8 + 2 * j) * LDZ + l] = (bf16_t)(av[j] & 0xFFFFu); ZT[(c8 + 2 * j + 1) * LDZ + l] = (bf16_t)(av[j] >> 16);
            ZT[(c8 + 2 * j) * LDZ + 256 + l] = (bf16_t)(sv[j] & 0xFFFFu); ZT[(c8 + 2 * j + 1) * LDZ + 256 + l] = (bf16_t)(sv[j] >> 16); } }
    __syncthreads();
    f32x4 acc[2][2];
#pragma unroll
    for (int mi = 0; mi < 2; ++mi)
#pragma unroll
        for (int nt = 0; nt < 2; ++nt) acc[mi][nt] = (f32x4){0.f, 0.f, 0.f, 0.f};
#pragma unroll 2
    for (int ks = 0; ks < 16; ++ks) {
        const bf16x8 b0 = lds_frag(ZTb, fr, LDZ, ks * 32 + fq * 8), b1 = lds_frag(ZTb, 16 + fr, LDZ, ks * 32 + fq * 8);
        const int kb = (ks & 7) * 32 + fq * 8; const bool sn = ks >= 8;
#pragma unroll
        for (int mi = 0; mi < 2; ++mi) { const int l2 = (wid * 2 + mi) * 16 + fr;
            unsigned w[4];
#pragma unroll
            for (int j2 = 0; j2 < 4; ++j2) { const unsigned t0 = twb[((kb + 2 * j2) * l2) & 255], t1 = twb[((kb + 2 * j2 + 1) * l2) & 255];
                w[j2] = sn ? ((t0 >> 16) | (t1 & 0xFFFF0000u)) : ((t0 & 0xFFFFu) | (t1 << 16)); }
            uint4 wv; wv.x = w[0]; wv.y = w[1]; wv.z = w[2]; wv.w = w[3];
            const bf16x8 af = __builtin_bit_cast(bf16x8, wv);
            acc[mi][0] = __builtin_amdgcn_mfma_f32_16x16x32_bf16(b0, af, acc[mi][0], 0, 0, 0);
            acc[mi][1] = __builtin_amdgcn_mfma_f32_16x16x32_bf16(b1, af, acc[mi][1], 0, 0, 0); }
    }
#pragma unroll
    for (int mi = 0; mi < 2; ++mi)
#pragma unroll
        for (int nt = 0; nt < 2; ++nt) { const size_t row = (size_t)RL + b * LC + (wid * 2 + mi) * 16 + fr; const float sc = 1.f / 128.f;
            uint2 o; o.x = pack2(acc[mi][nt][0] * sc, acc[mi][nt][1] * sc); o.y = pack2(acc[mi][nt][2] * sc, acc[mi][nt][3] * sc);
            *(uint2*)(p.Y() + row * D + chb * 32 + nt * 16 + 4 * fq) = o; }
    __syncthreads();
}

__device__ __forceinline__ void phase_mixA(const P& p, int layer, unsigned char* smem) {
    if (p.bid() < 64) scan_consumer<false>(p, layer, p.bid(), smem);
    else if (p.bid() < 128) scan_consumer<true>(p, layer, p.bid() - 64, smem);
    else if (p.bid() < 192) scan_producer<false>(p, layer, p.bid() - 128, smem);
    else scan_producer<true>(p, layer, p.bid() - 192, smem);
    __syncthreads();
    {
        const int hb = (p.bid() + 128) & 255, nh = p.nblk();
        { pg8::Gemm g{p.AC(), p.S5GG() + (size_t)layer * 16 * 256 * 256, 512, 256, 256}; pg8::S5Order S; S.init(nh, hb, (size_t)256 * 256 * 2);
          EpiStoreBf16 E{p.V(), 256, 0, (size_t)S5ROWS * 256, nullptr};
          pg8::gemm_phase<EpiStoreBf16, pg8::S5Order>((PG8_LAS unsigned char*)smem, g, S, E); }
        __syncthreads();
        fourier_a_init(p, smem);
        for (int it = hb; it < 2048; it += nh) fourier_a(p, it, smem);
        if (layer == 0) for (int it = hb; it < 64; it += nh) fourier_ctx(p, it, smem);
    }
}

__device__ __forceinline__ void phase_mixB(const P& p, int layer, unsigned char* smem) {
    const int nrows = layer == 0 ? RT : RL;
    unsigned* s5f = p.ctl() + CW_S5F + layer * 64;
    if (p.bid() < 32) {
        s5_state_scan(p, layer);
        asm volatile("s_waitcnt vmcnt(0)" ::: "memory");
        __syncthreads();
        if (p.tid() == 0) (void)xb_add(s5f, 1u);
    }
    __syncthreads();
    fourier_b_init(p, smem);
    for (int it = p.bid(); it < 2048; it += p.nblk()) fourier_b(p, it, smem);
    { pg8::Gemm g{p.AC(), p.S5TT() + (size_t)layer * 16 * 256 * 512, 512, 512, 512}; pg8::S5FlowOrder S; S.init(p.nblk(), p.bid(), (size_t)256 * 512 * 2); S.flag = s5f; S.bar = p.ctl() + CW_BAR;
      EpiS5Y E{p.PM(), p.s5_d() + layer * 256, layer == 0 ? 1 : 0};
      pg8::gemm_phase<EpiS5Y, pg8::S5FlowOrder>((PG8_LAS unsigned char*)smem, g, S, E); }
    __syncthreads();
    float* GU = (float*)smem;
    float* SG = GU + 64 * 256;
    for (int i = p.tid(); i < 64 * 256; i += NTHR) GU[i] = p.rw_g_up()[(size_t)layer * 64 * 256 + i];
    __syncthreads();
    int r_lo, r_hi;
    {
      const int N1 = 32, NA = 144, D1 = 22, EX = 83, c = p.bid(), G = p.nblk(); const int a = (nrows + N1 * D1 - (G - NA) * EX) / G, rem = nrows - (G * a - N1 * D1 + (G - NA) * EX);
      r_lo = c * a + (c < rem ? c : rem) - D1 * (c < N1 ? c : N1) + EX * (c > NA ? c - NA : 0);
      const int c1 = c + 1;
      r_hi = c1 * a + (c1 < rem ? c1 : rem) - D1 * (c1 < N1 ? c1 : N1) + EX * (c1 > NA ? c1 - NA : 0); }
    const float* mu = p.rw_mu() + (size_t)layer * 2 * 896;
    const bf16_t* Y0 = p.YS(); const bf16_t* Y1 = p.YS() + (size_t)RT * 256;
    const bf16_t* D0 = p.YS() + (size_t)2 * RT * 256; const bf16_t* D1 = p.YS() + (size_t)3 * RT * 256;
#pragma unroll 2
    for (int r = r_lo + p.wid(); r < r_hi; r += 8) {
        int base, l, len;
        if (r < RL) { base = (r >> 12) << 12; l = r & 4095; len = L; } else { const int rr = r - RL; base = RL + ((rr >> 8) << 8); l = rr & 255; len = LC; }
        const int c0 = p.lane() * 4, hh = p.lane() >> 4;
        { SG[p.wid() * 64 + p.lane()] = sigm(rw_shift(p, mu, base, l, len, 832 + p.lane()));
          const uint2 a = *(const uint2*)(Y0 + (size_t)r * 256 + c0), bq = *(const uint2*)(Y1 + (size_t)r * 256 + c0);
          float y[4] = {lo2f(a.x) + lo2f(bq.x), hi2f(a.x) + hi2f(bq.x), lo2f(a.y) + lo2f(bq.y), hi2f(a.y) + hi2f(bq.y)};
          float sm = (y[0] + y[1]) + (y[2] + y[3]);
          sm += __shfl_xor(sm, 1); sm += __shfl_xor(sm, 2); sm += __shfl_xor(sm, 4); sm += __shfl_xor(sm, 8);
          const float mean = sm * (1.f / 64.f);
          float vq = 0.f;
#pragma unroll
          for (int i = 0; i < 4; ++i) { const float dd = y[i] - mean; vq += dd * dd; }
          vq += __shfl_xor(vq, 1); vq += __shfl_xor(vq, 2); vq += __shfl_xor(vq, 4); vq += __shfl_xor(vq, 8);
          const float rstd = rsqrtf(vq * (1.f / 64.f) + 64e-5f);
          float rs[4], ks[4], vs[4], bsum = 0.f;
          { const Raw3 xr_ = rw_raw3(p, base, l, len, c0); const float4 r4 = rw_mix(xr_, *(const float4*)(mu + c0), *(const float4*)(mu + 896 + c0));
            asm volatile("" ::: "memory");
            const Raw3 xk_ = rw_raw3(p, base, l, len, 256 + c0); const float4 k4 = rw_mix(xk_, *(const float4*)(mu + 256 + c0), *(const float4*)(mu + 896 + 256 + c0));
            asm volatile("" ::: "memory");
            const Raw3 xv_ = rw_raw3(p, base, l, len, 512 + c0); const float4 v4 = rw_mix(xv_, *(const float4*)(mu + 512 + c0), *(const float4*)(mu + 896 + 512 + c0));
            const float4 rk4 = *(const float4*)(p.rw_r_k() + layer * 256 + c0);
            rs[0] = r4.x; rs[1] = r4.y; rs[2] = r4.z; rs[3] = r4.w; ks[0] = k4.x; ks[1] = k4.y; ks[2] = k4.z; ks[3] = k4.w; vs[0] = v4.x; vs[1] = v4.y; vs[2] = v4.z; vs[3] = v4.w;
            bsum = (rs[0] * ks[0] * rk4.x + rs[1] * ks[1] * rk4.y) + (rs[2] * ks[2] * rk4.z + rs[3] * ks[3] * rk4.w); }
          bsum += __shfl_xor(bsum, 1); bsum += __shfl_xor(bsum, 2); bsum += __shfl_xor(bsum, 4); bsum += __shfl_xor(bsum, 8);
          float g[4] = {0.f, 0.f, 0.f, 0.f};
          for (int i2 = 0; i2 < 64; ++i2) { const float sg = SG[p.wid() * 64 + i2]; const float4 gu = *(const float4*)(GU + i2 * 256 + c0);
              g[0] += sg * gu.x; g[1] += sg * gu.y; g[2] += sg * gu.z; g[3] += sg * gu.w; }
          float o[4];
#pragma unroll
          for (int i = 0; i < 4; ++i) { const int c = c0 + i; const float yn = (y[i] - mean) * rstd * p.rw_ln_g()[layer * 256 + c] + p.rw_ln_b()[layer * 256 + c];
              o[i] = (yn + bsum * vs[i]) * g[i]; }
          uint2 w; w.x = pack2(o[0], o[1]); w.y = pack2(o[2], o[3]);
          *(uint2*)(p.Y() + (size_t)r * D + 256 + c0) = w; }
        { const uint2 a = *(const uint2*)(D0 + (size_t)r * 256 + c0), bq = *(const uint2*)(D1 + (size_t)r * 256 + c0);
          float y[4] = {lo2f(a.x) + lo2f(bq.x), hi2f(a.x) + hi2f(bq.x), lo2f(a.y) + lo2f(bq.y), hi2f(a.y) + hi2f(bq.y)};
          float sq = (y[0] * y[0] + y[1] * y[1]) + (y[2] * y[2] + y[3] * y[3]);
          sq += __shfl_xor(sq, 1); sq += __shfl_xor(sq, 2); sq += __shfl_xor(sq, 4); sq += __shfl_xor(sq, 8);
          const float rstd = rsqrtf(sq * (1.f / 64.f) + 1e-6f);
          const uint2 gt = *(const uint2*)(p.PM() + (size_t)r * NP + PC_DG + c0);
          const float gv[4] = {lo2f(gt.x), hi2f(gt.x), lo2f(gt.y), hi2f(gt.y)};
          float o[4];
#pragma unroll
          for (int i = 0; i < 4; ++i) o[i] = y[i] * rstd * p.dn_norm_g()[layer * 64 + ((c0 + i) & 63)] * silu_(gv[i]);
          uint2 w; w.x = pack2(o[0], o[1]); w.y = pack2(o[2], o[3]);
          *(uint2*)(p.Y() + (size_t)r * D + 512 + c0) = w; }
        (void)hh;
    }
}

__device__ __forceinline__ void phase_mixB1(const P& p, int layer, unsigned char* smem) {
    { pg8::Gemm g{p.AC(), p.S5TT() + (size_t)layer * 16 * 256 * 512, 512, 512, 512}; pg8::S5Order S; S.init(p.nblk(), p.bid(), (size_t)256 * 512 * 2);
      EpiS5Y E{p.PM(), p.s5_d() + layer * 256, layer == 0 ? 1 : 0};
      pg8::gemm_phase<EpiS5Y, pg8::S5Order>((PG8_LAS unsigned char*)smem, g, S, E); }
}

__device__ __forceinline__ void phase_glu(const P& p, int layer, unsigned char* smem) {
    const int rows = layer == 0 ? RT : RL;
    pg8::Gemm g{p.PM() + PC_S5, p.WGLUT(), NP, 256, 256}; pg8::GridOrder S; S.init(rows, 256, p.nblk(), p.bid(), NP, 256);
    EpiGlu E{p.PM(), p.Y(), p.s5_b_glu() + layer * 256};
    pg8::gemm_phase<EpiGlu, pg8::GridOrder>((PG8_LAS unsigned char*)smem, g, S, E);
}
__device__ __forceinline__ void phase_gates(const P& p, int layer, unsigned char* smem) {
    const int rows = layer == 0 ? RT : RL;
    pg8::Gemm g{p.H(), p.WGT(), 1024, 1024, 1024}; pg8::GridOrder S; S.init(rows, 4096, p.nblk(), p.bid(), 1024, 1024);
    EpiStoreBf16 E{p.GB(), 4096, 1, 0, nullptr};
    pg8::gemm_phase<EpiStoreBf16, pg8::GridOrder>((PG8_LAS unsigned char*)smem, g, S, E);
}
constexpr size_t GM_SCRP = 0, GM_SCRS = (size_t)32 << 20, GM_TL = (size_t)64 << 20, GM_MM = (size_t)96 << 20;
static_assert(GM_MM + (size_t)RT * 1024 * 2 <= (size_t)RT * NP * 2, "gate/merge scratch fits in PM");
static_assert(GM_TL + (size_t)32 * 4 * 65536 * 2 <= GM_MM && (size_t)256 * 131072 <= GM_SCRS, "gate/merge scratch layout");
__device__ __forceinline__ bf16_t* gm_mm(const P& p) { return (bf16_t*)((unsigned char*)p.PM() + GM_MM); }
__device__ __forceinline__ void phase_gatemerge(const P& p, int layer, unsigned char* smem) {
    const int rows = layer == 0 ? RT : RL;
    pg8::Gemm g{p.H(), p.WGT(), 1024, 1024, 1024};
    pg8::GateMergeOrder S; S.init(rows, 1024, p.nblk(), p.bid(), 1024, 1024);
    S.dA = (size_t)((const char*)p.Y() - (const char*)p.H()); S.dB = (size_t)((const char*)p.WBT() - (const char*)p.WGT());
    unsigned char* pm = (unsigned char*)p.PM();
    EpiGateMerge E{pm + GM_SCRP, pm + GM_SCRS, (bf16_t*)(pm + GM_TL), gm_mm(p)};
    pg8::gemm_phase_gm<EpiGateMerge, pg8::GateMergeOrder>((PG8_LAS unsigned char*)smem, g, S, E);
}
__device__ __forceinline__ void phase_gm_tail(const P& p, int layer) {
    const int rows = layer == 0 ? RT : RL;
    pg8::GateMergeOrder S; S.init(rows, 1024, p.nblk(), p.bid(), 1024, 1024);
    const int ft = S.full_tiles(), nt = S.nwg - ft;
    const bf16_t* TL = (const bf16_t*)((unsigned char*)p.PM() + GM_TL); bf16_t* M = gm_mm(p);
    for (int i = p.bid() * NTHR + p.tid(); i < nt * 8192; i += p.nblk() * NTHR) {
        const int lt = i >> 13, lr = (i >> 5) & 255, lc = (i & 31) * 8;
        int pm, pn; S.tile((long)ft + lt, pm, pn);
        const bf16_t* tp = TL + ((size_t)lt * 4 * 65536 + lr * 256 + lc);
        const uint4 a = *(const uint4*)tp, b = *(const uint4*)(tp + 65536), cc = *(const uint4*)(tp + 2 * 65536), d = *(const uint4*)(tp + 3 * 65536);
        uint4 o;
        o.x = pack2((lo2f(a.x) + lo2f(b.x)) + (lo2f(cc.x) + lo2f(d.x)), (hi2f(a.x) + hi2f(b.x)) + (hi2f(cc.x) + hi2f(d.x)));
        o.y = pack2((lo2f(a.y) + lo2f(b.y)) + (lo2f(cc.y) + lo2f(d.y)), (hi2f(a.y) + hi2f(b.y)) + (hi2f(cc.y) + hi2f(d.y)));
        o.z = pack2((lo2f(a.z) + lo2f(b.z)) + (lo2f(cc.z) + lo2f(d.z)), (hi2f(a.z) + hi2f(b.z)) + (hi2f(cc.z) + hi2f(d.z)));
        o.w = pack2((lo2f(a.w) + lo2f(b.w)) + (lo2f(cc.w) + lo2f(d.w)), (hi2f(a.w) + hi2f(b.w)) + (hi2f(cc.w) + hi2f(d.w)));
        *(uint4*)(M + ((size_t)pm * 256 + lr) * 1024 + pn * 256 + lc) = o;
    }
}
__device__ __forceinline__ void phase_merge(const P& p, int layer, unsigned char* smem) {
    const int rows = layer == 0 ? RT : RL;
    pg8::Gemm g{p.Y(), p.WBT(), 1024, 256, 256}; pg8::MergeOrder S; S.init(rows, 1024, p.nblk(), p.bid(), 1024, 256);
    EpiMergeY E{p.GB(), p.MM()};
    pg8::gemm_phase<EpiMergeY, pg8::MergeOrder>((PG8_LAS unsigned char*)smem, g, S, E);
}
__device__ __forceinline__ void phase_msum(const P& p, int layer) {
    const int rows = layer == 0 ? RT : RL;
    const size_t n8 = (size_t)rows * 128;
    for (size_t i = (size_t)p.bid() * NTHR + p.tid(); i < n8; i += (size_t)p.nblk() * NTHR) {
        const size_t r = i >> 7; const int c = (int)(i & 127) * 8;
        const bf16_t* tp = p.GB() + r * 4096 + c;
        const uint4 a = *(const uint4*)tp, b = *(const uint4*)(tp + 1024), cc = *(const uint4*)(tp + 2048), d = *(const uint4*)(tp + 3072);
        uint4 o;
        o.x = pack2((lo2f(a.x) + lo2f(b.x)) + (lo2f(cc.x) + lo2f(d.x)), (hi2f(a.x) + hi2f(b.x)) + (hi2f(cc.x) + hi2f(d.x)));
        o.y = pack2((lo2f(a.y) + lo2f(b.y)) + (lo2f(cc.y) + lo2f(d.y)), (hi2f(a.y) + hi2f(b.y)) + (hi2f(cc.y) + hi2f(d.y)));
        o.z = pack2((lo2f(a.z) + lo2f(b.z)) + (lo2f(cc.z) + lo2f(d.z)), (hi2f(a.z) + hi2f(b.z)) + (hi2f(cc.z) + hi2f(d.z)));
        o.w = pack2((lo2f(a.w) + lo2f(b.w)) + (lo2f(cc.w) + lo2f(d.w)), (hi2f(a.w) + hi2f(b.w)) + (hi2f(cc.w) + hi2f(d.w)));
        *(uint4*)(p.MM() + r * 1024 + c) = o;
    }
}
__device__ __forceinline__ void phase_msum_tail(const P& p, int layer) {
    const int rows = layer == 0 ? RT : RL;
    pg8::MergeOrder S; S.init(rows, 1024, p.nblk(), p.bid(), 1024, 256);
    const int ft = S.full_tiles(), nt = S.nwg - ft;
    for (int i = p.bid() * NTHR + p.tid(); i < nt * 8192; i += p.nblk() * NTHR) {
        int pm, pn; S.tile((long)ft + (i >> 13), pm, pn);
        const size_t r = (size_t)pm * 256 + ((i >> 5) & 255); const int c = pn * 256 + (i & 31) * 8;
        const bf16_t* tp = p.GB() + r * 4096 + c;
        const uint4 a = *(const uint4*)tp, b = *(const uint4*)(tp + 1024), cc = *(const uint4*)(tp + 2048), d = *(const uint4*)(tp + 3072);
        uint4 o;
        o.x = pack2((lo2f(a.x) + lo2f(b.x)) + (lo2f(cc.x) + lo2f(d.x)), (hi2f(a.x) + hi2f(b.x)) + (hi2f(cc.x) + hi2f(d.x)));
        o.y = pack2((lo2f(a.y) + lo2f(b.y)) + (lo2f(cc.y) + lo2f(d.y)), (hi2f(a.y) + hi2f(b.y)) + (hi2f(cc.y) + hi2f(d.y)));
        o.z = pack2((lo2f(a.z) + lo2f(b.z)) + (lo2f(cc.z) + lo2f(d.z)), (hi2f(a.z) + hi2f(b.z)) + (hi2f(cc.z) + hi2f(d.z)));
        o.w = pack2((lo2f(a.w) + lo2f(b.w)) + (lo2f(cc.w) + lo2f(d.w)), (hi2f(a.w) + hi2f(b.w)) + (hi2f(cc.w) + hi2f(d.w)));
        *(uint4*)(p.MM() + r * 1024 + c) = o;
    }
}
__device__ __forceinline__ void phase_outproj(const P& p, int layer, unsigned char* smem) {
    const int rows = layer == 0 ? RT : RL;
    pg8::Gemm g{gm_mm(p), p.WOT(), 1024, 1024, 1024}; pg8::GridOrder S; S.init(rows, 1024, p.nblk(), p.bid(), 1024, 1024);
    EpiOut E{p.out(), p.XC(), p.MOD() + (size_t)layer * 9 * 6144 + 2 * 1024};
    pg8::gemm_phase<EpiOut, pg8::GridOrder>((PG8_LAS unsigned char*)smem, g, S, E);
    if (layer == 0 && p.bid() >= 32) wprep_items(p, 1, p.bid() - 32, p.nblk() - 32, smem, 1);
}

__device__ __forceinline__ void phase_norm2_router(const P& p, int layer, unsigned char* smem) {
    float* RW = (float*)smem;
    unsigned* lcnt = (unsigned*)(RW + 1024 * 20);
    int t_ = (int)threadIdx.x; asm volatile("" : "+v"(t_));
    for (int i = t_; i < 1024 * 16; i += NTHR) { const int k = i >> 4, e = i & 15; RW[(((k >> 8) * 4 + (k & 3)) * 64 + ((k >> 2) & 63)) * 20 + e] = p.router_w()[i]; }
    if (t_ < 16) lcnt[t_] = 0u;
    __syncthreads();
    const int nrows = layer == 0 ? RT : RL;
    const int gw = p.bid() * 8 + p.wid(), nw = p.nblk() * 8;
    float rb[16];
#pragma unroll
    for (int e = 0; e < 16; ++e) rb[e] = p.router_b()[e];
    const int ln4 = p.lane() * 4, last = nrows - 1;
    float4 xn[4];
#pragma unroll
    for (int j = 0; j < 4; ++j) xn[j] = *(const float4*)(xrow(p, gw) + j * 256 + ln4);
#pragma unroll 1
    for (int r = gw; r < nrows; r += nw) {
        const float* md = p.MOD() + (size_t)(layer * 9 + modrow(r)) * 6144;
        float v[16]; float ss = 0.f;
#pragma unroll
        for (int j = 0; j < 4; ++j) { v[j * 4] = xn[j].x; v[j * 4 + 1] = xn[j].y; v[j * 4 + 2] = xn[j].z; v[j * 4 + 3] = xn[j].w; }
        { const float* xq = xrow(p, min(r + nw, last));
#pragma unroll
          for (int j = 0; j < 4; ++j) xn[j] = *(const float4*)(xq + j * 256 + ln4); }
#pragma unroll
        for (int j = 0; j < 16; ++j) ss += v[j] * v[j];
#pragma unroll
        for (int o = 32; o >= 1; o >>= 1) ss += __shfl_xor(ss, o);
        const float rstd = rsqrtf(ss * (1.f / 1024.f) + 1e-6f);
        float lg[16];
#pragma unroll
        for (int e = 0; e < 16; ++e) lg[e] = 0.f;
#pragma unroll
        for (int j = 0; j < 4; ++j) { const int k = j * 256 + ln4;
            const float4 g = *(const float4*)(p.norm2_g() + layer * 1024 + k), sc = *(const float4*)(md + 4 * 1024 + k), sh = *(const float4*)(md + 3 * 1024 + k);
            float h2[4];
            h2[0] = v[j * 4] * rstd * g.x * (1.f + sc.x) + sh.x; h2[1] = v[j * 4 + 1] * rstd * g.y * (1.f + sc.y) + sh.y;
            h2[2] = v[j * 4 + 2] * rstd * g.z * (1.f + sc.z) + sh.z; h2[3] = v[j * 4 + 3] * rstd * g.w * (1.f + sc.w) + sh.w;
            uint2 o; o.x = pack2(h2[0], h2[1]); o.y = pack2(h2[2], h2[3]);
            *(uint2*)(p.H() + (size_t)r * D + k) = o;
#pragma unroll
            for (int q = 0; q < 4; ++q) { const float4* rw4 = (const float4*)(RW + ((j * 4 + q) * 64 + p.lane()) * 20);
#pragma unroll
                for (int e4 = 0; e4 < 4; ++e4) { const float4 w = rw4[e4]; lg[e4 * 4] += h2[q] * w.x; lg[e4 * 4 + 1] += h2[q] * w.y; lg[e4 * 4 + 2] += h2[q] * w.z; lg[e4 * 4 + 3] += h2[q] * w.w; } }
            asm volatile("" ::: "memory"); }
        const int ln = p.lane();
#pragma unroll
        for (int i = 0; i < 8; ++i) { const bool up = (ln & 32) != 0; const float send = up ? lg[i] : lg[i + 8], keep = up ? lg[i + 8] : lg[i]; lg[i] = keep + __shfl_xor(send, 32); }
#pragma unroll
        for (int i = 0; i < 4; ++i) { const bool up = (ln & 16) != 0; const float send = up ? lg[i] : lg[i + 4], keep = up ? lg[i + 4] : lg[i]; lg[i] = keep + __shfl_xor(send, 16); }
#pragma unroll
        for (int i = 0; i < 2; ++i) { const bool up = (ln & 8) != 0; const float send = up ? lg[i] : lg[i + 2], keep = up ? lg[i + 2] : lg[i]; lg[i] = keep + __shfl_xor(send, 8); }
        { const bool up = (ln & 4) != 0; const float send = up ? lg[0] : lg[1], keep = up ? lg[1] : lg[0]; lg[0] = keep + __shfl_xor(send, 4); }
        lg[0] += __shfl_xor(lg[0], 2); lg[0] += __shfl_xor(lg[0], 1);
        float sc[16], sel[16];
#pragma unroll
        for (int e = 0; e < 16; ++e) { sc[e] = sigm(__shfl(lg[0], 4 * e)); sel[e] = sc[e] + rb[e]; }
        int best = 0; float bestv = -1e30f;
#pragma unroll
        for (int g = 0; g < 4; ++g) { float m1 = -1e30f, m2 = -1e30f;
#pragma unroll
            for (int i = 0; i < 4; ++i) { const float s = sel[g * 4 + i]; if (s > m1) { m2 = m1; m1 = s; } else if (s > m2) m2 = s; }
            const float gs = m1 + m2; if (gs > bestv) { bestv = gs; best = g; } }
        int i1 = 0, i2 = 0; float s1 = -1e30f, s2 = -1e30f;
#pragma unroll
        for (int g = 0; g < 4; ++g)
#pragma unroll
            for (int i = 0; i < 4; ++i) if (g == best) { const float s = sel[g * 4 + i]; const int e = g * 4 + i;
                if (s > s1) { s2 = s1; i2 = i1; s1 = s; i1 = e; } else if (s > s2) { s2 = s; i2 = e; } }
        float w1 = 0.f, w2 = 0.f;
#pragma unroll
        for (int e = 0; e < 16; ++e) { if (e == i1) w1 = sc[e]; if (e == i2) w2 = sc[e]; }
        const float inv = 1.f / (w1 + w2);
        if (p.lane() == 0) { p.TOK()[r] = make_int4(i1, i2, __float_as_int(w1 * inv), __float_as_int(w2 * inv)); atomicAdd(&lcnt[i1], 1u); atomicAdd(&lcnt[i2], 1u); }
    }
    __syncthreads();
    if (p.tid() < 16 && lcnt[p.tid()]) atomicAdd(p.ctl() + CW_CNT + layer * 64 + p.tid(), lcnt[p.tid()]);
}

__device__ __forceinline__ void load_segments(const P& p, int layer, int* seg  , int* cnt  ) {
    if (p.tid() == 0) { int s = 0; for (int e = 0; e < 16; ++e) { const int c = (int)__hip_atomic_load(p.ctl() + CW_CNT + layer * 64 + e, __ATOMIC_RELAXED, __HIP_MEMORY_SCOPE_AGENT); cnt[e] = c; seg[e] = s; s += (c + 255) & ~255; } seg[16] = s; }
    __syncthreads();
}

__device__ __forceinline__ void phase_scatter(const P& p, int layer, unsigned char* smem) {
    int* seg = (int*)(smem + LDS_RING); int* cnt = seg + 32;
    load_segments(p, layer, seg, cnt);
    int* lc = (int*)smem; int* lbase = lc + 16; int* rowpos = lc + 64;
    const int nrows = layer == 0 ? RT : RL;
    const int rpw = nrows / p.nblk(), r0 = p.bid() * rpw;
    if (p.tid() < 16) lc[p.tid()] = 0;
    __syncthreads();
    for (int i = p.wid(); i < rpw; i += 8) {
        if (p.lane() == 0) { const int4 tk = p.TOK()[r0 + i]; rowpos[i * 2] = atomicAdd(&lc[tk.x], 1); rowpos[i * 2 + 1] = atomicAdd(&lc[tk.y], 1); }
    }
    __syncthreads();
    if (p.tid() < 16) lbase[p.tid()] = lc[p.tid()] ? (int)atomicAdd(p.ctl() + CW_CNT + layer * 64 + 32 + p.tid(), (unsigned)lc[p.tid()]) : 0;
    __syncthreads();
    for (int i = p.wid(); i < rpw; i += 8) {
        const int r = r0 + i; const int4 tk = p.TOK()[r];
        const int s0 = seg[tk.x] + lbase[tk.x] + rowpos[i * 2], s1 = seg[tk.y] + lbase[tk.y] + rowpos[i * 2 + 1];
        if (p.lane() == 0) p.SLOT()[r] = make_int2(s0, s1);
        const uint4* src = (const uint4*)(p.H() + (size_t)r * D);
        const uint4 a = src[p.lane()], b2 = src[64 + p.lane()];
        uint4* d0 = (uint4*)(p.XS() + (size_t)s0 * D); uint4* d1 = (uint4*)(p.XS() + (size_t)s1 * D);
        d0[p.lane()] = a; d0[64 + p.lane()] = b2; d1[p.lane()] = a; d1[64 + p.lane()] = b2;
    }
}

__device__ __forceinline__ void phase_moe1(const P& p, int layer, unsigned char* smem) {
    int* seg = (int*)(smem + LDS_RING); int* cnt = seg + 32;
    load_segments(p, layer, seg, cnt);
    pg8::Gemm g{p.XS(), p.W13T(), 1024, 1024, 1024}; pg8::Moe1Order S; S.init(seg, 2, 512, p.nblk(), p.bid(), 1024, 1024); S.flags = p.ctl() + CW_MOEF + layer * 512;
    EpiMoe1 E{p.ACT()};
    pg8::gemm_phase<EpiMoe1, pg8::Moe1Order>((PG8_LAS unsigned char*)smem, g, S, E);
}
__device__ __forceinline__ void phase_moe2(const P& p, int layer, unsigned char* smem) {
    int* seg = (int*)(smem + LDS_RING); int* cnt = seg + 32;
    load_segments(p, layer, seg, cnt);
    pg8::Gemm g{p.ACT(), p.W2T(), 256, 256, 256}; pg8::Moe2Order S; S.init(seg, 4, 1024, p.nblk(), p.bid(), 256, 256); S.flags = p.ctl() + CW_MOEF + layer * 512; S.bar = p.ctl() + CW_BAR;
    { const int u1 = (seg[16] >> 8) * 2 - 2 * p.nblk(); S.r1 = u1 < 0 ? 0 : (u1 > p.nblk() ? p.nblk() : u1); }
    EpiStoreBf16 E{p.YE(), 1024, 0, 0, nullptr};
    pg8::gemm_phase<EpiStoreBf16, pg8::Moe2Order>((PG8_LAS unsigned char*)smem, g, S, E);
}

constexpr int NPH_LAYER = 13;
constexpr int NPHASE = 1 + 2 * NPH_LAYER + 1;

__global__ void __launch_bounds__(NTHR, 2) fwd(Args a) {
    extern __shared__ __attribute__((aligned(16))) unsigned char smem[];
    P p(a);

    volatile LAS unsigned* xbw = (volatile LAS unsigned*)(smem + LDS_BYTES - 16);
    const bool multi = (a.ph_hi - a.ph_lo) > 1;
    XcdBarrier bar; bar.bar = p.ctl() + CW_BAR; bar.x = 0; bar.st = xbw;
    if (multi) {
        if (threadIdx.x == 0) { xbw[0] = 0u; xbw[1] = 0u; xbw[2] = 0u; xbw[3] = 0u; }
        __syncthreads();
        bar = xcd_barrier_post(p.ctl() + CW_BAR, xbw);
    }
#define IN(k) (a.ph_lo <= (k) && (k) < a.ph_hi)
#define SEAM(k) do { if (IN((k) + 1)) xcd_barrier(bar); } while (0)

    if (IN(0)) { phase_prologue(p, smem); SEAM(0); }
    {
        if (IN(1)) { phase_wprep(p, 0, smem); phase_norm1(p, 0); SEAM(1); }
        if (IN(2)) { phase_gemm1(p, smem); SEAM(2); }
        if (IN(3)) { phase_mixA(p, 0, smem); SEAM(3); }
        if (IN(4)) { phase_mixB(p, 0, smem); SEAM(4); }
        if (IN(5)) { if (!MK_SINGLE) SEAM(5); }
        if (IN(6)) { phase_glu(p, 0, smem); SEAM(6); }
        if (IN(7)) { phase_gatemerge(p, 0, smem); SEAM(7); }
        if (IN(8)) { phase_gm_tail(p, 0); SEAM(8); }
        if (IN(9)) { phase_outproj(p, 0, smem); SEAM(9); }
        if (IN(10)) { phase_norm2_router(p, 0, smem); SEAM(10); }
        if (IN(11)) { phase_scatter(p, 0, smem); SEAM(11); }
        if (IN(12)) { phase_moe1(p, 0, smem); if (!MK_SINGLE) SEAM(12); }
        if (IN(13)) { phase_moe2(p, 0, smem); SEAM(13); }
    }
    {
        if (IN(14)) { phase_wprep(p, 1, smem); phase_norm1(p, 1); SEAM(14); }
        if (IN(15)) { phase_gemm1(p, smem); SEAM(15); }
        if (IN(16)) { phase_mixA(p, 1, smem); SEAM(16); }
        if (IN(17)) { phase_mixB(p, 1, smem); SEAM(17); }
        if (IN(18)) { if (!MK_SINGLE) SEAM(18); }
        if (IN(19)) { phase_glu(p, 1, smem); SEAM(19); }
        if (IN(20)) { phase_gatemerge(p, 1, smem); SEAM(20); }
        if (IN(21)) { if (!MK_SINGLE) SEAM(21); }
        if (IN(22)) { phase_outproj(p, 1, smem); SEAM(22); }
        if (IN(23)) { phase_norm2_router(p, 1, smem); SEAM(23); }
        if (IN(24)) { phase_scatter(p, 1, smem); SEAM(24); }
        if (IN(25)) { phase_moe1(p, 1, smem); if (!MK_SINGLE) SEAM(25); }
        if (IN(26)) { phase_moe2(p, 1, smem); SEAM(26); }
    }
    if (IN(NPHASE - 1)) { phase_norm1(p, 2); }
#undef IN
#undef SEAM
}

}

extern "C" void kernel_launch(void* const* d_in, const int* in_sizes, int n_in, void* d_out, int out_size, void* d_ws, size_t ws_size, hipStream_t stream) {
    static int ready = 0;
    if (ready == 0) {
        if (n_in != 42 || out_size != RL * D || ws_size < WS_END) { fprintf(stderr, "kernel_launch: unexpected shapes n_in=%d out=%d ws=%zu need=%zu\n", n_in, out_size, ws_size, (size_t)WS_END); ready = -1; return; }
        if (hipFuncSetAttribute((const void*)fwd, hipFuncAttributeMaxDynamicSharedMemorySize, LDS_BYTES) != hipSuccess) { fprintf(stderr, "kernel_launch: hipFuncSetAttribute failed\n"); ready = -1; return; }
        int per_cu = 0; (void)hipOccupancyMaxActiveBlocksPerMultiprocessor(&per_cu, (const void*)fwd, NTHR, LDS_BYTES); (void)hipGetLastError();
        if (per_cu < 1) fprintf(stderr, "kernel_launch: occupancy query says %d blocks/CU\n", per_cu);
        ready = 1;
    }
    if (ready < 0) return;
    (void)in_sizes;
    (void)hipMemsetAsync((char*)d_ws + WS_CTL, 0, CTL_BYTES, stream);
    Args a{};
    for (int i = 0; i < 42; ++i) a.in[i] = (const float*)d_in[i];
    a.out = (float*)d_out; a.ws = (unsigned char*)d_ws;
    const int grid = 256;
#if MK_SINGLE
    a.ph_lo = 0; a.ph_hi = NPHASE;
    hipLaunchKernelGGL(fwd, dim3(grid), dim3(NTHR), LDS_BYTES, stream, a);
#else
    for (int ph = 0; ph < NPHASE; ++ph) { a.ph_lo = ph; a.ph_hi = ph + 1; hipLaunchKernelGGL(fwd, dim3(grid), dim3(NTHR), LDS_BYTES, stream, a); }
#endif
}
```

```cpp
#include <hip/hip_runtime.h>
#include <stdio.h>
#include <stdint.h>

#ifndef MK_SINGLE
#define MK_SINGLE 1
#endif

namespace {

typedef unsigned short bf16_t;
typedef short bf16x8 __attribute__((ext_vector_type(8)));
typedef float f32x4 __attribute__((ext_vector_type(4)));

constexpr int D = 1024, NB = 8, L = 4096, LC = 256;
constexpr int RL = NB * L, RC = NB * LC, RT = RL + RC;
constexpr int NP = 2816;
constexpr int NIN = 6544;
constexpr int NTHR = 512;
constexpr int NSLOT = 73728;
constexpr int LDS_RING = 131072;
constexpr int LDS_BYTES = 159744;
constexpr int PC_FC = 0, PC_FS = 256, PC_RW = 512, PC_DQKV = 1408, PC_DG = 2176, PC_DAL = 2432, PC_DBE = 2440, PC_S5 = 2448;

constexpr size_t al256(size_t x) { return (x + 255) & ~(size_t)255; }
constexpr size_t WS_CTL = 0;
constexpr size_t CTL_BYTES = 65536;
constexpr size_t WS_MOD = WS_CTL + CTL_BYTES;
constexpr size_t WS_LAMB = al256(WS_MOD + 2 * 9 * 6144 * 4);
constexpr size_t WS_BBAR = al256(WS_LAMB + 2 * 2 * 16 * 64 * 8);
constexpr size_t WS_TOK = al256(WS_BBAR + 2 * 2 * 16 * 64 * 16 * 8);
constexpr size_t WS_SLOT = al256(WS_TOK + (size_t)RT * 16);
constexpr size_t WS_XC = al256(WS_SLOT + (size_t)RT * 8);
constexpr size_t WS_WINT = al256(WS_XC + (size_t)RC * D * 4);
constexpr size_t WS_WGT = al256(WS_WINT + (size_t)NP * 1024 * 2);
constexpr size_t WS_WBT = al256(WS_WGT + (size_t)4096 * 1024 * 2);
constexpr size_t WS_WOT = al256(WS_WBT + (size_t)4 * 1024 * 256 * 2);
constexpr size_t WS_W13T = al256(WS_WOT + (size_t)1024 * 1024 * 2);
constexpr size_t WS_W2T = al256(WS_W13T + (size_t)16 * 512 * 1024 * 2);
constexpr size_t WS_WGLUT = al256(WS_W2T + (size_t)16 * 1024 * 256 * 2);
constexpr size_t WS_S5TT = al256(WS_WGLUT + (size_t)256 * 256 * 2);
constexpr size_t WS_S5GG = al256(WS_S5TT + (size_t)2 * 16 * 256 * 512 * 2);
constexpr size_t WS_H = al256(WS_S5GG + (size_t)2 * 16 * 256 * 256 * 2);
constexpr size_t WS_PM = al256(WS_H + (size_t)RT * D * 2);
constexpr size_t WS_YS = al256(WS_PM + (size_t)RT * NP * 2);
constexpr int S5ROWS = 2304;
constexpr size_t WS_AC = al256(WS_YS + (size_t)4 * RT * 256 * 2);
constexpr size_t WS_V = al256(WS_AC + (size_t)16 * S5ROWS * 512 * 2);
constexpr size_t WS_Y = al256(WS_V + (size_t)16 * S5ROWS * 256 * 2);
constexpr size_t WS_END = al256(WS_Y + (size_t)RT * D * 2);
constexpr size_t WS_GB = WS_PM;
constexpr size_t WS_MM = WS_H;
constexpr size_t WS_XS = WS_PM;
constexpr size_t WS_ACT = WS_XS + (size_t)NSLOT * D * 2;
constexpr size_t WS_YE = WS_ACT + (size_t)NSLOT * 256 * 2;
static_assert(WS_GB + (size_t)RT * 4096 * 2 <= WS_Y, "gate alias");
static_assert(WS_YE + (size_t)NSLOT * D * 2 <= WS_END, "moe alias");

constexpr int CW_BAR = 0;
constexpr int CW_CNT = 4096;
constexpr int CW_S5F = 6144;
constexpr int CW_MOEF = 5120;

#define XB_TMO      128
#define XB_XCNT(j)  (256  + 64 * (j))
#define XB_XSUB(j)  (1280 + 64 * (j))
#define XB_XGEN(j)  (2304 + 64 * (j))
#define XB_TOP      3328
#define XB_TOPGEN   3392
#define XCD_BAR_WORDS 3456
#define XB_SPIN_CAP (1u << 18)
#define LAS __attribute__((address_space(3)))

__device__ __forceinline__ unsigned xb_ld(unsigned* p)              { return __hip_atomic_load(p, __ATOMIC_RELAXED, __HIP_MEMORY_SCOPE_AGENT); }
__device__ __forceinline__ unsigned xb_add(unsigned* p, unsigned v) { return __hip_atomic_fetch_add(p, v, __ATOMIC_RELAXED, __HIP_MEMORY_SCOPE_AGENT); }
__device__ __forceinline__ unsigned xb_xcc_id() { return (unsigned)__builtin_amdgcn_s_getreg((3 << 11) | 20) & 0xFu; }
#define XB_SPIN(cond, bar) do { unsigned _sp = 0; while (cond) { __builtin_amdgcn_s_sleep(1); \
    if ((++_sp & 255u) == 0u) { if (xb_ld(&(bar)[XB_TMO])) break; if (_sp > XB_SPIN_CAP) { atomicAdd(&(bar)[XB_TMO], 1u); break; } } } } while (0)

struct XcdBarrier { unsigned* bar; unsigned x; volatile LAS unsigned* st; };

__device__ __forceinline__ XcdBarrier xcd_barrier_post(unsigned* bar, volatile LAS unsigned* st) {
    XcdBarrier b; b.bar = bar; b.x = xb_xcc_id(); b.st = st;
    if (threadIdx.x == 0) (void)xb_add(&bar[XB_XCNT(b.x)], 1u);
    return b;
}
__device__ __forceinline__ void xcd_barrier_complete(unsigned* bar, unsigned x, unsigned& nloc, unsigned& nx) {
    const unsigned G = gridDim.x * gridDim.y * gridDim.z;
    unsigned sum, cnt, mine, sp = 0u;
    for (;;) {
        sum = 0u; cnt = 0u; mine = 0u;
#pragma unroll
        for (unsigned j = 0; j < 16; ++j) { const unsigned c = xb_ld(&bar[XB_XCNT(j)]); sum += c; cnt += (c > 0u) ? 1u : 0u; mine = (j == x) ? c : mine; }
        if (sum == G) break;
        __builtin_amdgcn_s_sleep(1);
        if ((++sp & 255u) == 0u) { if (xb_ld(&bar[XB_TMO])) break; if (sp > XB_SPIN_CAP) { atomicAdd(&bar[XB_TMO], 1u); break; } }
    }
    nloc = mine > 0u ? mine : 1u; nx = cnt > 0u ? cnt : 1u;
}
__device__ __forceinline__ void xcd_barrier(const XcdBarrier& b) {
    asm volatile("s_waitcnt vmcnt(0)" ::: "memory");
    __syncthreads();
    if (threadIdx.x == 0) {
        unsigned* bar = b.bar;
        __builtin_amdgcn_s_waitcnt(0);
        unsigned nloc = b.st[0], nx = b.st[1];
        if (nloc == 0u) { xcd_barrier_complete(bar, b.x, nloc, nx); b.st[0] = nloc; b.st[1] = nx; }
        const unsigned old = xb_add(&bar[XB_XSUB(b.x)], 1u);
        const unsigned gen = old / nloc;
        if (old + 1u == (gen + 1u) * nloc) {
            __builtin_amdgcn_fence(__ATOMIC_RELEASE, "agent");
            asm volatile("s_waitcnt vmcnt(0)" ::: "memory");
            const unsigned og = xb_add(&bar[XB_TOP], 1u);
            const unsigned tg = og / nx;
            if (og + 1u == (tg + 1u) * nx) xb_add(&bar[XB_TOPGEN], 1u);
            else XB_SPIN(xb_ld(&bar[XB_TOPGEN]) == tg, bar);
            __builtin_amdgcn_fence(__ATOMIC_ACQUIRE, "agent");
            xb_add(&bar[XB_XGEN(b.x)], 1u);
            asm volatile("s_waitcnt vmcnt(0)" ::: "memory");
        } else {
            XB_SPIN(xb_ld(&bar[XB_XGEN(b.x)]) == gen, bar);
            __builtin_amdgcn_fence(__ATOMIC_ACQUIRE, "agent");
            asm volatile("s_waitcnt vmcnt(0)" ::: "memory");
        }
    }
    __syncthreads();
}

__device__ __forceinline__ bf16_t f2bf(float f) { return __builtin_bit_cast(bf16_t, (__bf16)f); }
__device__ __forceinline__ float bf2f(bf16_t b) { return __uint_as_float(((unsigned)b) << 16); }
typedef __bf16 bf16v2g_t __attribute__((ext_vector_type(2)));
__device__ __forceinline__ unsigned pack2(float a, float b) { const bf16v2g_t v = {(__bf16)a, (__bf16)b}; return __builtin_bit_cast(unsigned, v); }
__device__ __forceinline__ float lo2f(unsigned u) { return __uint_as_float(u << 16); }
__device__ __forceinline__ float hi2f(unsigned u) { return __uint_as_float(u & 0xFFFF0000u); }
__device__ __forceinline__ float rsq_fast(float x) { return __builtin_amdgcn_rsqf(x); }
__device__ __forceinline__ float sigm(float x) { return __builtin_amdgcn_rcpf(1.f + __expf(-x)); }
__device__ __forceinline__ float fast_tanh(float x) { const float e = __expf(-2.f * fabsf(x)); const float t = (1.f - e) * __builtin_amdgcn_rcpf(1.f + e); return x < 0.f ? -t : t; }
__device__ __forceinline__ float silu_(float x) { return x * sigm(x); }
__device__ __forceinline__ float softplus_(float x) { return x > 20.f ? x : __logf(1.f + __expf(x)); }
__device__ __forceinline__ float gelu_tanh(float x) { const float u = 0.7978845608f * (x + 0.044715f * x * x * x); return 0.5f * x * (1.f + tanhf(u)); }

struct Args { const float* in[42]; float* out; unsigned char* ws; int ph_lo, ph_hi; };
struct P {
    const Args& a;
    __device__ __forceinline__ int bid() const { return (int)blockIdx.x; }
    __device__ __forceinline__ int nblk() const { return (int)gridDim.x; }
    __device__ __forceinline__ int tid() const { return (int)threadIdx.x; }
    __device__ __forceinline__ int lane() const { return (int)(threadIdx.x & 63); }
    __device__ __forceinline__ int wid() const { return (int)(threadIdx.x >> 6); }
    __device__ __forceinline__ P(const Args& a_) : a(a_) {}
    __device__ __forceinline__ const float* x() const { return a.in[0]; }
    __device__ __forceinline__ const float* c() const { return a.in[1]; }
    __device__ __forceinline__ const float* ctx() const { return a.in[2]; }
    __device__ __forceinline__ const float* c_ctx() const { return a.in[3]; }
    __device__ __forceinline__ const float* w_mod() const { return a.in[4]; }
    __device__ __forceinline__ const float* b_mod() const { return a.in[5]; }
    __device__ __forceinline__ const float* norm1_g() const { return a.in[6]; }
    __device__ __forceinline__ const float* norm2_g() const { return a.in[7]; }
    __device__ __forceinline__ const float* w_in() const { return a.in[8]; }
    __device__ __forceinline__ const float* rw_mu() const { return a.in[9]; }
    __device__ __forceinline__ const float* rw_w0() const { return a.in[10]; }
    __device__ __forceinline__ const float* rw_w_up() const { return a.in[11]; }
    __device__ __forceinline__ const float* rw_a0() const { return a.in[12]; }
    __device__ __forceinline__ const float* rw_a_up() const { return a.in[13]; }
    __device__ __forceinline__ const float* rw_k_k() const { return a.in[14]; }
    __device__ __forceinline__ const float* rw_k_a() const { return a.in[15]; }
    __device__ __forceinline__ const float* rw_r_k() const { return a.in[16]; }
    __device__ __forceinline__ const float* rw_g_up() const { return a.in[17]; }
    __device__ __forceinline__ const float* rw_ln_g() const { return a.in[18]; }
    __device__ __forceinline__ const float* rw_ln_b() const { return a.in[19]; }
    __device__ __forceinline__ const float* dn_conv() const { return a.in[20]; }
    __device__ __forceinline__ const float* dn_a_log() const { return a.in[21]; }
    __device__ __forceinline__ const float* dn_dt_bias() const { return a.in[22]; }
    __device__ __forceinline__ const float* dn_norm_g() const { return a.in[23]; }
    __device__ __forceinline__ const float* s5_lam_re() const { return a.in[24]; }
    __device__ __forceinline__ const float* s5_lam_im() const { return a.in[25]; }
    __device__ __forceinline__ const float* s5_log_step() const { return a.in[26]; }
    __device__ __forceinline__ const float* s5_b_re() const { return a.in[27]; }
    __device__ __forceinline__ const float* s5_b_im() const { return a.in[28]; }
    __device__ __forceinline__ const float* s5_c_re() const { return a.in[29]; }
    __device__ __forceinline__ const float* s5_c_im() const { return a.in[30]; }
    __device__ __forceinline__ const float* s5_d() const { return a.in[31]; }
    __device__ __forceinline__ const float* s5_w_glu() const { return a.in[32]; }
    __device__ __forceinline__ const float* s5_b_glu() const { return a.in[33]; }
    __device__ __forceinline__ const float* w_branch() const { return a.in[34]; }
    __device__ __forceinline__ const float* w_out() const { return a.in[35]; }
    __device__ __forceinline__ const float* router_w() const { return a.in[36]; }
    __device__ __forceinline__ const float* router_b() const { return a.in[37]; }
    __device__ __forceinline__ const float* moe_w1() const { return a.in[38]; }
    __device__ __forceinline__ const float* moe_w3() const { return a.in[39]; }
    __device__ __forceinline__ const float* moe_w2() const { return a.in[40]; }
    __device__ __forceinline__ const float* final_g() const { return a.in[41]; }
    __device__ __forceinline__ float* out() const { return a.out; }
    __device__ __forceinline__ unsigned* ctl() const { return (unsigned*)(a.ws + WS_CTL); }
    __device__ __forceinline__ float* MOD() const { return (float*)(a.ws + WS_MOD); }
    __device__ __forceinline__ float2* LAMB() const { return (float2*)(a.ws + WS_LAMB); }
    __device__ __forceinline__ float2* BBAR() const { return (float2*)(a.ws + WS_BBAR); }
    __device__ __forceinline__ int4* TOK() const { return (int4*)(a.ws + WS_TOK); }
    __device__ __forceinline__ int2* SLOT() const { return (int2*)(a.ws + WS_SLOT); }
    __device__ __forceinline__ float* XC() const { return (float*)(a.ws + WS_XC); }
    __device__ __forceinline__ bf16_t* WINT() const { return (bf16_t*)(a.ws + WS_WINT); }
    __device__ __forceinline__ bf16_t* WGT() const { return (bf16_t*)(a.ws + WS_WGT); }
    __device__ __forceinline__ bf16_t* WBT() const { return (bf16_t*)(a.ws + WS_WBT); }
    __device__ __forceinline__ bf16_t* WOT() const { return (bf16_t*)(a.ws + WS_WOT); }
    __device__ __forceinline__ bf16_t* W13T() const { return (bf16_t*)(a.ws + WS_W13T); }
    __device__ __forceinline__ bf16_t* W2T() const { return (bf16_t*)(a.ws + WS_W2T); }
    __device__ __forceinline__ bf16_t* WGLUT() const { return (bf16_t*)(a.ws + WS_WGLUT); }
    __device__ __forceinline__ bf16_t* H() const { return (bf16_t*)(a.ws + WS_H); }
    __device__ __forceinline__ bf16_t* PM() const { return (bf16_t*)(a.ws + WS_PM); }
    __device__ __forceinline__ bf16_t* Y() const { return (bf16_t*)(a.ws + WS_Y); }
    __device__ __forceinline__ bf16_t* YS() const { return (bf16_t*)(a.ws + WS_YS); }
    __device__ __forceinline__ bf16_t* S5TT() const { return (bf16_t*)(a.ws + WS_S5TT); }
    __device__ __forceinline__ bf16_t* S5GG() const { return (bf16_t*)(a.ws + WS_S5GG); }
    __device__ __forceinline__ bf16_t* AC() const { return (bf16_t*)(a.ws + WS_AC); }
    __device__ __forceinline__ bf16_t* V() const { return (bf16_t*)(a.ws + WS_V); }
    __device__ __forceinline__ bf16_t* GB() const { return (bf16_t*)(a.ws + WS_GB); }
    __device__ __forceinline__ bf16_t* MM() const { return (bf16_t*)(a.ws + WS_MM); }
    __device__ __forceinline__ bf16_t* XS() const { return (bf16_t*)(a.ws + WS_XS); }
    __device__ __forceinline__ bf16_t* ACT() const { return (bf16_t*)(a.ws + WS_ACT); }
    __device__ __forceinline__ bf16_t* YE() const { return (bf16_t*)(a.ws + WS_YE); }
};

__device__ __forceinline__ float* xrow(const P& p, int r) { return r < RL ? p.out() + (size_t)r * D : p.XC() + (size_t)(r - RL) * D; }
__device__ __forceinline__ int modrow(int r) { return r < RL ? (r >> 12) : 8; }

namespace pg8 {
#define PG8_LAS __attribute__((address_space(3)))
typedef unsigned u32x4 __attribute__((ext_vector_type(4)));
typedef unsigned u32x2 __attribute__((ext_vector_type(2)));
constexpr int BM = 256, BK = 64, HALF = 128, HTB = HALF * BK * 2, STAGE_BYTES = 8 * HTB, NXCD = 8, WGM = 8;
__host__ __device__ __forceinline__ int lds_byte(int r, int c) { const int st = (r >> 4) * 2 + (c >> 5), rr = r & 15, cc = c & 31, ob = rr * 64 + cc * 2; return st * 1024 + (ob ^ (((ob >> 9) & 1) << 5)); }
__host__ __device__ __forceinline__ void stage_rc(int b, int& R, int& C) { const int st = b / 1024, sb = b % 1024, swz = sb ^ (((sb >> 9) & 1) << 5); R = (st >> 1) * 16 + swz / 64; C = (st & 1) * 32 + (swz % 64) / 2; }
__host__ __device__ __forceinline__ int perm32(int rho) { const int n = rho >> 4, i = rho & 15; return 8 * (i >> 2) + 4 * n + (i & 3); }
struct Unit { int pm, pn, aux, pad; size_t a_off, b_off; };
struct Gemm { const bf16_t* A; const bf16_t* Bt; int lda, ldb, K; };

struct GridOrder {
    static constexpr int A_AUX = 0;
    int nM, nN, nwg, G, c; size_t astep, bstep;
    __device__ void init(int M, int N, int G_, int c_, int lda, int ldb) { nM = M / BM; nN = N / BM; nwg = nM * nN; G = G_; c = c_; astep = (size_t)BM * lda * 2; bstep = (size_t)BM * ldb * 2; }
    __device__ bool tile(long Lidx, int& pm, int& pn) const {
        if (Lidx >= nwg) return false;
        int wgid = (int)Lidx; { const int q = nwg / NXCD, r = nwg % NXCD, xcd = wgid % NXCD, off = wgid / NXCD; wgid = (xcd < r ? xcd * (q + 1) : r * (q + 1) + (xcd - r) * q) + off; }
        const int nig = WGM * nN, gid = wgid / nig, fm = gid * WGM, gsz = (nM - fm) < WGM ? (nM - fm) : WGM;
        pm = fm + ((wgid % nig) % gsz); pn = (wgid % nig) / gsz; return true;
    }
    __device__ bool next(int i, Unit& u) const { int pm, pn; if (!tile((long)i * G + c, pm, pn)) return false; u.pm = pm; u.pn = pn; u.aux = 0; u.pad = 0; u.a_off = pm * astep; u.b_off = pn * bstep; return true; }
    __device__ __forceinline__ void a_ready(const Unit&) const {}
    __device__ __forceinline__ void done(const Unit&) const {}
};
struct MergeOrder : GridOrder {
    __device__ int full_tiles() const { return (nwg / G) * G; }
    __device__ bool next(int j, Unit& u) const { int pm, pn, i4, sp = 0; const int ft = full_tiles(), f4 = 4 * (ft / G);
        if (j < f4) { if (!tile((long)(j >> 2) * G + c, pm, pn)) return false; i4 = j & 3; }
        else { const long U = (long)(j - f4) * G + c; if (U >= (long)(nwg - ft) * 4) return false; if (!tile((long)ft + (U >> 2), pm, pn)) return false; i4 = (int)(U & 3); sp = 4; }
        u.pm = pm; u.pn = pn; u.aux = i4 | sp; u.pad = 0;
        u.a_off = pm * astep + (size_t)i4 * 256 * 2; u.b_off = ((size_t)i4 * 1024 + (size_t)pn * 256) * 256 * 2; return true; }
};
struct GateMergeOrder : GridOrder {
    size_t dA, dB;
    __device__ int full_tiles() const { return (nwg / G) * G; }
    __device__ bool next(int j, Unit& u) const { int pm, pn, i4, kind, sp = 0, lt = 0; const int ft = full_tiles(), f8 = 8 * (ft / G);
        if (j < f8) { if (!tile((long)(j >> 3) * G + c, pm, pn)) return false; i4 = (j >> 1) & 3; kind = j & 1; }
        else { const int jj = j - f8; const long U = (long)(jj >> 1) * G + c; if (U >= (long)(nwg - ft) * 4) return false; lt = (int)(U >> 2); if (!tile((long)ft + lt, pm, pn)) return false; i4 = (int)(U & 3); kind = jj & 1; sp = 4; }
        u.pm = pm; u.pn = pn; u.aux = i4 | sp | (kind << 3) | (lt << 4); u.pad = kind ? 16 : 4;
        if (kind) { u.a_off = pm * astep; u.b_off = ((size_t)i4 * 1024 + (size_t)pn * 256) * 1024 * 2; }
        else { u.a_off = dA + pm * astep + (size_t)i4 * 256 * 2; u.b_off = dB + ((size_t)i4 * 1024 + (size_t)pn * 256) * 256 * 2; }
        return true; }
};
struct MoeOrder {
    static constexpr int A_AUX = 0;
    const int* seg; int nN, brows, G, c; size_t astep, bstep_row;
    __device__ void init(const int* seg_, int nN_, int brows_, int G_, int c_, int lda, int ldb) { seg = seg_; nN = nN_; brows = brows_; G = G_; c = c_; astep = (size_t)BM * lda * 2; bstep_row = (size_t)ldb * 2; }
    __device__ bool next(int i, Unit& u) const {
        const long Lidx = (long)i * G + c; const int ntm = __builtin_amdgcn_readfirstlane(seg[16] >> 8);
        if (Lidx >= (long)ntm * nN) return false;
        const int pm = (int)(Lidx / nN), pn = (int)(Lidx % nN);
        int e = 0;
#pragma unroll
        for (int k = 1; k < 16; ++k) if ((seg[k] >> 8) <= pm) e = k;
        e = __builtin_amdgcn_readfirstlane(e);
        u.pm = pm; u.pn = pn; u.aux = e; u.pad = 0; u.a_off = pm * astep; u.b_off = ((size_t)e * brows + (size_t)pn * 256) * bstep_row; return true;
    }
    __device__ __forceinline__ void a_ready(const Unit&) const {}
    __device__ __forceinline__ void done(const Unit&) const {}
};
struct Moe1Order : MoeOrder {
    unsigned* flags;
    __device__ __forceinline__ void done(const Unit& u) const { asm volatile("s_waitcnt vmcnt(0)" ::: "memory"); if ((threadIdx.x & 63) == 0) (void)xb_add(flags + u.pm, 1u); }
};
struct Moe2Order : MoeOrder {
    static constexpr int A_AUX = 16;
    unsigned* flags; unsigned* bar;
    int r1;
    __device__ bool next(int i, Unit& u) const {
        const int Lg = G - r1; long U;
        if (c < r1) U = 2L * Lg + (long)i * G + c;
        else U = i < 2 ? (long)i * Lg + (c - r1) : 2L * Lg + (long)(i - 2) * G + c;
        const int ntm = __builtin_amdgcn_readfirstlane(seg[16] >> 8);
        if (U >= (long)ntm * nN) return false;
        const int pm = (int)(U / nN), pn = (int)(U % nN);
        int e = 0;
#pragma unroll
        for (int k = 1; k < 16; ++k) if ((seg[k] >> 8) <= pm) e = k;
        e = __builtin_amdgcn_readfirstlane(e);
        u.pm = pm; u.pn = pn; u.aux = e; u.pad = 0; u.a_off = pm * astep; u.b_off = ((size_t)e * brows + (size_t)pn * 256) * bstep_row; return true;
    }
    __device__ __forceinline__ void a_ready(const Unit& u) const {
        unsigned sp = 0u;
        for (;;) { const unsigned v = __builtin_amdgcn_readfirstlane(xb_ld(flags + u.pm)); if (v >= 16u) break; __builtin_amdgcn_s_sleep(1);
            if ((++sp & 255u) == 0u) { if (xb_ld(&bar[XB_TMO])) break; if (sp > XB_SPIN_CAP) { atomicAdd(&bar[XB_TMO], 1u); break; } } }
    }
};
typedef __bf16 bf16v2_t __attribute__((ext_vector_type(2)));
struct S5Order {
    static constexpr int A_AUX = 0;
    int G, c; size_t bgstride;
    __device__ void init(int G_, int c_, size_t bgstride_) { G = G_; c = c_; bgstride = bgstride_; }
    __device__ bool next(int i, Unit& u) const { const long Lidx = (long)i * G + c; if (Lidx >= 144) return false; const int g = (int)Lidx / 9, pm = (int)Lidx % 9;
        u.pm = pm; u.pn = 0; u.aux = g; u.pad = 0; u.a_off = ((size_t)g * 2304 + (size_t)pm * 256) * 512 * 2; u.b_off = (size_t)g * bgstride; return true; }
    __device__ __forceinline__ void a_ready(const Unit&) const {}
    __device__ __forceinline__ void done(const Unit&) const {}
};
struct S5FlowOrder : S5Order {
    static constexpr int A_AUX = 16;
    unsigned* flag; unsigned* bar;
    __device__ __forceinline__ void a_ready(const Unit&) const {
        unsigned sp = 0u;
        for (;;) { const unsigned v = __builtin_amdgcn_readfirstlane(xb_ld(flag)); if (v >= 32u) break; __builtin_amdgcn_s_sleep(1);
            if ((++sp & 255u) == 0u) { if (xb_ld(&bar[XB_TMO])) break; if (sp > XB_SPIN_CAP) { atomicAdd(&bar[XB_TMO], 1u); break; } } }
    }
};
__device__ __forceinline__ unsigned cvt_pk_bf16(float lo, float hi) { const bf16v2_t v = {(__bf16)lo, (__bf16)hi}; return __builtin_bit_cast(unsigned, v); }
template <class Epi, class Sched>
__device__ __forceinline__ void gemm_phase(PG8_LAS unsigned char* lds, const Gemm g, const Sched& S, const Epi& E) {
    const int tid = threadIdx.x, wid = __builtin_amdgcn_readfirstlane(tid >> 6), lane = tid & 63, wr = wid >> 2, wc = wid & 3, fr = lane & 15, fq = lane >> 4;
    int K_ = g.K; asm volatile("" : "+s"(K_));
    const int K = K_, nt = K / BK;
    unsigned voffA[2], voffB[2];
#pragma unroll
    for (int i = 0; i < 2; ++i) { int R, C; stage_rc(tid * 16 + i * 8192, R, C); const int Rb = Epi::PERM ? ((R & ~31) + perm32(R & 31)) : R;
        voffA[i] = (unsigned)(R * g.lda + C) * 2u; voffB[i] = (unsigned)(Rb * g.ldb + C) * 2u; }
    const size_t kstep = (size_t)(BK * 2);
    const size_t hstepA = (size_t)HALF * g.lda * 2, hstepB = (size_t)HALF * g.ldb * 2;
    const unsigned ldsw = (unsigned)wid * 1024u;
    const int aoff = lds_byte(wr * 64 + fr, fq * 8), boff = lds_byte(wc * 32 + fr, fq * 8);
#define PG8_SA(b, h) (((b) * 2 + (h)) * HTB)
#define PG8_SB(b, h) ((4 + (b) * 2 + (h)) * HTB)
#define PG8_STAGE(bufoff, gbase, voff) do { _Pragma("unroll") for (int _i = 0; _i < 2; ++_i) \
        __builtin_amdgcn_global_load_lds((const unsigned*)((const char*)(gbase) + (voff)[_i]), (PG8_LAS unsigned*)(lds + (bufoff) + ldsw + _i * 8192), 16, 0, 0); } while (0)
#define PG8_STAGE_A(bufoff, gbase, voff) do { _Pragma("unroll") for (int _i = 0; _i < 2; ++_i) \
        __builtin_amdgcn_global_load_lds((const unsigned*)((const char*)(gbase) + (voff)[_i]), (PG8_LAS unsigned*)(lds + (bufoff) + ldsw + _i * 8192), 16, 0, Sched::A_AUX); } while (0)
#define PG8_LDA(dst, b, h) do { _Pragma("unroll") for (int m = 0; m < 4; ++m) _Pragma("unroll") for (int k = 0; k < 2; ++k) dst[m][k] = *(const PG8_LAS bf16x8*)(lds + PG8_SA(b, h) + aoff + m * 2048 + k * 1024); } while (0)
#define PG8_LDB(dst, b, h) do { _Pragma("unroll") for (int n = 0; n < 2; ++n) _Pragma("unroll") for (int k = 0; k < 2; ++k) dst[n][k] = *(const PG8_LAS bf16x8*)(lds + PG8_SB(b, h) + boff + n * 2048 + k * 1024); } while (0)
#define PG8_MMA(ai, bj, At, Bt) do { __builtin_amdgcn_s_setprio(1); _Pragma("unroll") for (int m = 0; m < 4; ++m) _Pragma("unroll") for (int n = 0; n < 2; ++n) _Pragma("unroll") for (int k = 0; k < 2; ++k) \
        acc[ai][bj][m][n] = __builtin_amdgcn_mfma_f32_16x16x32_bf16(Bt[n][k], At[m][k], acc[ai][bj][m][n], 0, 0, 0); __builtin_amdgcn_s_setprio(0); } while (0)
#define PG8_WAIT_V(n) asm volatile("s_waitcnt vmcnt(" #n ")" ::: "memory")
#define PG8_WAIT_L(n) asm volatile("s_waitcnt lgkmcnt(" #n ")" ::: "memory")
#define PG8_BAR __builtin_amdgcn_s_barrier()
#define PG8_SCHED __builtin_amdgcn_sched_barrier(0)
    Unit cur, nxt; int ui = 0;
    if (!S.next(0, cur)) return;
    f32x4 acc[2][2][4][2];
#pragma unroll
    for (int a = 0; a < 2; ++a)
#pragma unroll
        for (int b = 0; b < 2; ++b)
#pragma unroll
            for (int m = 0; m < 4; ++m)
#pragma unroll
                for (int n = 0; n < 2; ++n) acc[a][b][m][n] = (f32x4){0.f, 0.f, 0.f, 0.f};
    bf16x8 At[4][2], B0[2][2], B1[2][2];
    const char* cA = (const char*)g.A + cur.a_off; const char* cB = (const char*)g.Bt + cur.b_off;
    S.a_ready(cur);
    PG8_STAGE(PG8_SB(0, 0), cB, voffB); PG8_STAGE_A(PG8_SA(0, 0), cA, voffA); PG8_STAGE(PG8_SB(0, 1), cB + hstepB, voffB); PG8_STAGE_A(PG8_SA(0, 1), cA + hstepA, voffA);
    if (wr == 1) PG8_BAR;
    PG8_WAIT_V(4); PG8_BAR;
    PG8_STAGE(PG8_SB(1, 0), cB + kstep, voffB); PG8_STAGE_A(PG8_SA(1, 0), cA + kstep, voffA); PG8_STAGE(PG8_SB(1, 1), cB + hstepB + kstep, voffB);
    PG8_WAIT_V(6); PG8_BAR;
    for (;;) {
        const bool has_next = S.next(ui + 1, nxt);
        const char* nA = has_next ? (const char*)g.A + nxt.a_off : cA; const char* nB = has_next ? (const char*)g.Bt + nxt.b_off : cB;
        for (int t = 0; t < nt; t += 2) {
            const bool last = (t == nt - 2);
            const char* a1 = cA + (size_t)(t + 1) * kstep;
            const char* a2 = last ? nA : cA + (size_t)(t + 2) * kstep; const char* b2 = last ? nB : cB + (size_t)(t + 2) * kstep;
            const char* a3 = a2 + kstep; const char* b3 = b2 + kstep;
            if (last && has_next) S.a_ready(nxt);
            PG8_LDB(B0, 0, 0); PG8_SCHED; PG8_LDA(At, 0, 0); PG8_STAGE_A(PG8_SA(1, 1), a1 + hstepA, voffA);
            PG8_WAIT_L(8); PG8_BAR; PG8_WAIT_L(0); PG8_MMA(0, 0, At, B0); PG8_BAR; PG8_SCHED;
            PG8_LDB(B1, 0, 1); PG8_STAGE(PG8_SB(0, 0), b2, voffB);
            PG8_BAR; PG8_WAIT_L(0); PG8_MMA(0, 1, At, B1); PG8_BAR;
            PG8_LDA(At, 0, 1); PG8_STAGE_A(PG8_SA(0, 0), a2, voffA);
            PG8_BAR; PG8_WAIT_L(0); PG8_MMA(1, 0, At, B0); PG8_BAR; PG8_SCHED;
            PG8_STAGE(PG8_SB(0, 1), b2 + hstepB, voffB);
            PG8_WAIT_V(6); PG8_BAR; PG8_MMA(1, 1, At, B1); PG8_BAR;
            PG8_LDB(B0, 1, 0); PG8_SCHED; PG8_LDA(At, 1, 0); PG8_STAGE_A(PG8_SA(0, 1), a2 + hstepA, voffA);
            PG8_WAIT_L(8); PG8_BAR; PG8_WAIT_L(0); PG8_MMA(0, 0, At, B0); PG8_BAR; PG8_SCHED;
            PG8_LDB(B1, 1, 1); PG8_STAGE(PG8_SB(1, 0), b3, voffB);
            PG8_BAR; PG8_WAIT_L(0); PG8_MMA(0, 1, At, B1); PG8_BAR;
            PG8_LDA(At, 1, 1); PG8_STAGE_A(PG8_SA(1, 0), a3, voffA);
            PG8_BAR; PG8_WAIT_L(0); PG8_MMA(1, 0, At, B0); PG8_BAR; PG8_SCHED;
            PG8_STAGE(PG8_SB(1, 1), b3 + hstepB, voffB);
            PG8_WAIT_V(6); PG8_BAR; PG8_MMA(1, 1, At, B1); PG8_BAR;
        }
        if constexpr (!Epi::AFTER_DRAIN) { E(acc, cur, wr, wc, fr, fq); S.done(cur); }
        if (!has_next) break;
#pragma unroll
        for (int a = 0; a < 2; ++a)
#pragma unroll
            for (int b = 0; b < 2; ++b)
#pragma unroll
                for (int m = 0; m < 4; ++m)
#pragma unroll
                    for (int n = 0; n < 2; ++n) acc[a][b][m][n] = (f32x4){0.f, 0.f, 0.f, 0.f};
        cur = nxt; cA = nA; cB = nB; ++ui;
    }
    PG8_WAIT_V(0);
    if (wr == 0) PG8_BAR;
    PG8_BAR;
    if constexpr (Epi::AFTER_DRAIN) { E.fused(acc, cur, wr, wc, fr, fq, lds, wid, lane); S.done(cur); }
#undef PG8_SA
#undef PG8_SB
#undef PG8_STAGE
#undef PG8_STAGE_A
#undef PG8_LDA
#undef PG8_LDB
#undef PG8_MMA
#undef PG8_WAIT_V
#undef PG8_WAIT_L
#undef PG8_BAR
#undef PG8_SCHED
}

template <class Epi, class Sched>
__device__ __forceinline__ void gemm_phase_gm(PG8_LAS unsigned char* lds, const Gemm g, const Sched& S, const Epi& E) {
    const int tid = threadIdx.x, wid = __builtin_amdgcn_readfirstlane(tid >> 6), lane = tid & 63, wr = wid >> 2, wc = wid & 3, fr = lane & 15, fq = lane >> 4;
    (void)g.K;
    unsigned voffA[2], voffBP[2], voffBG[2];
#pragma unroll
    for (int i = 0; i < 2; ++i) { int R, C; stage_rc(tid * 16 + i * 8192, R, C); const int Rb = Epi::PERM ? ((R & ~31) + perm32(R & 31)) : R;
        voffA[i] = (unsigned)(R * g.lda + C) * 2u; voffBP[i] = (unsigned)(Rb * 256 + C) * 2u; voffBG[i] = (unsigned)(Rb * 1024 + C) * 2u; }
    const size_t kstep = (size_t)(BK * 2);
    const size_t hstepA = (size_t)HALF * g.lda * 2, hstepBP = (size_t)HALF * 256 * 2, hstepBG = (size_t)HALF * 1024 * 2;
    const unsigned ldsw = (unsigned)wid * 1024u;
    const int aoff = lds_byte(wr * 64 + fr, fq * 8), boff = lds_byte(wc * 32 + fr, fq * 8);
#define PG8_SA(b, h) (((b) * 2 + (h)) * HTB)
#define PG8_SB(b, h) ((4 + (b) * 2 + (h)) * HTB)
#define PG8_STAGE(bufoff, gbase, voff) do { _Pragma("unroll") for (int _i = 0; _i < 2; ++_i) \
        __builtin_amdgcn_global_load_lds((const unsigned*)((const char*)(gbase) + (voff)[_i]), (PG8_LAS unsigned*)(lds + (bufoff) + ldsw + _i * 8192), 16, 0, 0); } while (0)
#define PG8_STAGE_A(bufoff, gbase, voff) do { _Pragma("unroll") for (int _i = 0; _i < 2; ++_i) \
        __builtin_amdgcn_global_load_lds((const unsigned*)((const char*)(gbase) + (voff)[_i]), (PG8_LAS unsigned*)(lds + (bufoff) + ldsw + _i * 8192), 16, 0, Sched::A_AUX); } while (0)
#define PG8_LDA(dst, b, h) do { _Pragma("unroll") for (int m = 0; m < 4; ++m) _Pragma("unroll") for (int k = 0; k < 2; ++k) dst[m][k] = *(const PG8_LAS bf16x8*)(lds + PG8_SA(b, h) + aoff + m * 2048 + k * 1024); } while (0)
#define PG8_LDB(dst, b, h) do { _Pragma("unroll") for (int n = 0; n < 2; ++n) _Pragma("unroll") for (int k = 0; k < 2; ++k) dst[n][k] = *(const PG8_LAS bf16x8*)(lds + PG8_SB(b, h) + boff + n * 2048 + k * 1024); } while (0)
#define PG8_MMA(ai, bj, At, Bt) do { __builtin_amdgcn_s_setprio(1); _Pragma("unroll") for (int m = 0; m < 4; ++m) _Pragma("unroll") for (int n = 0; n < 2; ++n) _Pragma("unroll") for (int k = 0; k < 2; ++k) \
        acc[ai][bj][m][n] = __builtin_amdgcn_mfma_f32_16x16x32_bf16(Bt[n][k], At[m][k], acc[ai][bj][m][n], 0, 0, 0); __builtin_amdgcn_s_setprio(0); } while (0)
#define PG8_WAIT_V(n) asm volatile("s_waitcnt vmcnt(" #n ")" ::: "memory")
#define PG8_WAIT_L(n) asm volatile("s_waitcnt lgkmcnt(" #n ")" ::: "memory")
#define PG8_BAR __builtin_amdgcn_s_barrier()
#define PG8_SCHED __builtin_amdgcn_sched_barrier(0)
    Unit cur, nxt; int ui = 0;
    if (!S.next(0, cur)) return;
    f32x4 acc[2][2][4][2];
#pragma unroll
    for (int a = 0; a < 2; ++a)
#pragma unroll
        for (int b = 0; b < 2; ++b)
#pragma unroll
            for (int m = 0; m < 4; ++m)
#pragma unroll
                for (int n = 0; n < 2; ++n) acc[a][b][m][n] = (f32x4){0.f, 0.f, 0.f, 0.f};
    bf16x8 At[4][2], B0[2][2], B1[2][2];
    const char* cA = (const char*)g.A + cur.a_off; const char* cB = (const char*)g.Bt + cur.b_off;
    S.a_ready(cur);
    unsigned voffB[2]; size_t hstepB;
    { const bool kg = (cur.aux & 8) != 0; voffB[0] = kg ? voffBG[0] : voffBP[0]; voffB[1] = kg ? voffBG[1] : voffBP[1]; hstepB = kg ? hstepBG : hstepBP; }
    PG8_STAGE(PG8_SB(0, 0), cB, voffB); PG8_STAGE_A(PG8_SA(0, 0), cA, voffA); PG8_STAGE(PG8_SB(0, 1), cB + hstepB, voffB); PG8_STAGE_A(PG8_SA(0, 1), cA + hstepA, voffA);
    if (wr == 1) PG8_BAR;
    PG8_WAIT_V(4); PG8_BAR;
    PG8_STAGE(PG8_SB(1, 0), cB + kstep, voffB); PG8_STAGE_A(PG8_SA(1, 0), cA + kstep, voffA); PG8_STAGE(PG8_SB(1, 1), cB + hstepB + kstep, voffB);
    PG8_WAIT_V(6); PG8_BAR;
    for (;;) {
        const bool has_next = S.next(ui + 1, nxt);
        const char* nA = has_next ? (const char*)g.A + nxt.a_off : cA; const char* nB = has_next ? (const char*)g.Bt + nxt.b_off : cB;
        int nt_ = cur.pad; asm volatile("" : "+s"(nt_)); const int nt = nt_;
        const bool ckg = (cur.aux & 8) != 0, nkg = has_next ? ((nxt.aux & 8) != 0) : ckg;
        for (int t = 0; t < nt; t += 2) {
            const bool last = (t == nt - 2);
            { const bool kg = last ? nkg : ckg;
              voffB[0] = kg ? voffBG[0] : voffBP[0]; voffB[1] = kg ? voffBG[1] : voffBP[1]; hstepB = kg ? hstepBG : hstepBP; }
            const char* a1 = cA + (size_t)(t + 1) * kstep;
            const char* a2 = last ? nA : cA + (size_t)(t + 2) * kstep; const char* b2 = last ? nB : cB + (size_t)(t + 2) * kstep;
            const char* a3 = a2 + kstep; const char* b3 = b2 + kstep;
            if (last && has_next) S.a_ready(nxt);
            PG8_LDB(B0, 0, 0); PG8_SCHED; PG8_LDA(At, 0, 0); PG8_STAGE_A(PG8_SA(1, 1), a1 + hstepA, voffA);
            PG8_WAIT_L(8); PG8_BAR; PG8_WAIT_L(0); PG8_MMA(0, 0, At, B0); PG8_BAR; PG8_SCHED;
            PG8_LDB(B1, 0, 1); PG8_STAGE(PG8_SB(0, 0), b2, voffB);
            PG8_BAR; PG8_WAIT_L(0); PG8_MMA(0, 1, At, B1); PG8_BAR;
            PG8_LDA(At, 0, 1); PG8_STAGE_A(PG8_SA(0, 0), a2, voffA);
            PG8_BAR; PG8_WAIT_L(0); PG8_MMA(1, 0, At, B0); PG8_BAR; PG8_SCHED;
            PG8_STAGE(PG8_SB(0, 1), b2 + hstepB, voffB);
            PG8_WAIT_V(6); PG8_BAR; PG8_MMA(1, 1, At, B1); PG8_BAR;
            PG8_LDB(B0, 1, 0); PG8_SCHED; PG8_LDA(At, 1, 0); PG8_STAGE_A(PG8_SA(0, 1), a2 + hstepA, voffA);
            PG8_WAIT_L(8); PG8_BAR; PG8_WAIT_L(0); PG8_MMA(0, 0, At, B0); PG8_BAR; PG8_SCHED;
            PG8_LDB(B1, 1, 1); PG8_STAGE(PG8_SB(1, 0), b3, voffB);
            PG8_BAR; PG8_WAIT_L(0); PG8_MMA(0, 1, At, B1); PG8_BAR;
            PG8_LDA(At, 1, 1); PG8_STAGE_A(PG8_SA(1, 0), a3, voffA);
            PG8_BAR; PG8_WAIT_L(0); PG8_MMA(1, 0, At, B0); PG8_BAR; PG8_SCHED;
            PG8_STAGE(PG8_SB(1, 1), b3 + hstepB, voffB);
            PG8_WAIT_V(6); PG8_BAR; PG8_MMA(1, 1, At, B1); PG8_BAR;
        }
        if constexpr (!Epi::AFTER_DRAIN) { E(acc, cur, wr, wc, fr, fq); S.done(cur); }
        if (!has_next) break;
#pragma unroll
        for (int a = 0; a < 2; ++a)
#pragma unroll
            for (int b = 0; b < 2; ++b)
#pragma unroll
                for (int m = 0; m < 4; ++m)
#pragma unroll
                    for (int n = 0; n < 2; ++n) acc[a][b][m][n] = (f32x4){0.f, 0.f, 0.f, 0.f};
        cur = nxt; cA = nA; cB = nB; ++ui;
    }
    PG8_WAIT_V(0);
    if (wr == 0) PG8_BAR;
    PG8_BAR;
    if constexpr (Epi::AFTER_DRAIN) { E.fused(acc, cur, wr, wc, fr, fq, lds, wid, lane); S.done(cur); }
#undef PG8_SA
#undef PG8_SB
#undef PG8_STAGE
#undef PG8_STAGE_A
#undef PG8_LDA
#undef PG8_LDB
#undef PG8_MMA
#undef PG8_WAIT_V
#undef PG8_WAIT_L
#undef PG8_BAR
#undef PG8_SCHED
}
}

struct EpiStoreBf16 {
    static constexpr bool PERM = true, AFTER_DRAIN = false;
    bf16_t* O; int ldc; int act; size_t aux_stride; bf16_t* ac;
    __device__ __forceinline__ void operator()(const f32x4 (&acc)[2][2][4][2], const pg8::Unit& u, int wr_, int wc_, int fr_, int fq_) const {
        int t_ = threadIdx.x; asm volatile("" : "+v"(t_)); const int fr = t_ & 15, fq = (t_ >> 4) & 3, wc = (t_ >> 6) & 3, wr = t_ >> 8; (void)wr_; (void)wc_; (void)fr_; (void)fq_;
        const int row0 = u.pm * 256 + wr * 64 + fr, col0 = u.pn * 256 + wc * 32 + 8 * fq;
#pragma unroll
        for (int ai = 0; ai < 2; ++ai)
#pragma unroll
            for (int m = 0; m < 4; ++m) { const int r = row0 + ai * 128 + m * 16; bf16_t* rowp = O + (size_t)u.aux * aux_stride + (size_t)r * ldc + col0;
#pragma unroll
                for (int bj = 0; bj < 2; ++bj) { f32x4 v0 = acc[ai][bj][m][0], v1 = acc[ai][bj][m][1];
                    if (act == 1) {
#pragma unroll
                        for (int j = 0; j < 4; ++j) { v0[j] = sigm(v0[j]); v1[j] = sigm(v1[j]); } }
                    pg8::u32x4 w; w.x = pg8::cvt_pk_bf16(v0[0], v0[1]); w.y = pg8::cvt_pk_bf16(v0[2], v0[3]); w.z = pg8::cvt_pk_bf16(v1[0], v1[1]); w.w = pg8::cvt_pk_bf16(v1[2], v1[3]);
                    *(pg8::u32x4*)(rowp + bj * 128) = w;
                    if (ac) { const int c = col0 + bj * 128;
                        if (c >= PC_S5 && c < PC_S5 + 256) { const int g = (c - PC_S5) >> 4, h0 = (c - PC_S5) & 15; int b, s;
                            if (r < RL) { b = r >> 12; const int l = r & 4095; s = LC + (l & 63) * 64 + (l >> 6); } else { const int rr = r - RL; b = rr >> 8; s = rr & 255; }
                            *(pg8::u32x4*)(ac + ((size_t)g * S5ROWS + b * 272 + (s >> 4)) * 512 + (s & 15) * 16 + h0) = w; } } } }
    }
};
struct EpiMergeY {
    static constexpr bool PERM = true, AFTER_DRAIN = false;
    bf16_t* GB; bf16_t* M;
    template <bool LAST>
    __device__ __forceinline__ void run(const f32x4 (&acc)[2][2][4][2], const pg8::Unit& u, int row0, int col0) const {
        uint4 g[2][4][2];
        const unsigned e0 = (unsigned)row0 * 4096u + (unsigned)((u.aux & 3) * 1024 + col0), em = (unsigned)row0 * 1024u + (unsigned)col0;
#pragma unroll
        for (int ai = 0; ai < 2; ++ai)
#pragma unroll
            for (int m = 0; m < 4; ++m)
#pragma unroll
                for (int bj = 0; bj < 2; ++bj) g[ai][m][bj] = *(const uint4*)(GB + (size_t)(e0 + (unsigned)((ai * 128 + m * 16) * 4096 + bj * 128)));
        asm volatile("" ::: "memory");
        if (!LAST) {
#pragma unroll
            for (int ai = 0; ai < 2; ++ai)
#pragma unroll
                for (int m = 0; m < 4; ++m)
#pragma unroll
                    for (int bj = 0; bj < 2; ++bj) { const uint4 q = g[ai][m][bj]; const f32x4 v0 = acc[ai][bj][m][0], v1 = acc[ai][bj][m][1];
                        pg8::u32x4 w; w.x = pg8::cvt_pk_bf16(lo2f(q.x) * v0[0], hi2f(q.x) * v0[1]); w.y = pg8::cvt_pk_bf16(lo2f(q.y) * v0[2], hi2f(q.y) * v0[3]);
                        w.z = pg8::cvt_pk_bf16(lo2f(q.z) * v1[0], hi2f(q.z) * v1[1]); w.w = pg8::cvt_pk_bf16(lo2f(q.w) * v1[2], hi2f(q.w) * v1[3]);
                        *(pg8::u32x4*)(GB + (size_t)(e0 + (unsigned)((ai * 128 + m * 16) * 4096 + bj * 128))) = w; }
        } else {
            f32x4 o[2][4][2][2];
#pragma unroll
            for (int ai = 0; ai < 2; ++ai)
#pragma unroll
                for (int m = 0; m < 4; ++m)
#pragma unroll
                    for (int bj = 0; bj < 2; ++bj) { const uint4 q = g[ai][m][bj]; const f32x4 v0 = acc[ai][bj][m][0], v1 = acc[ai][bj][m][1];
                        o[ai][m][bj][0] = (f32x4){lo2f(q.x) * v0[0], hi2f(q.x) * v0[1], lo2f(q.y) * v0[2], hi2f(q.y) * v0[3]};
                        o[ai][m][bj][1] = (f32x4){lo2f(q.z) * v1[0], hi2f(q.z) * v1[1], lo2f(q.w) * v1[2], hi2f(q.w) * v1[3]}; }
#pragma unroll 1
            for (int t = 0; t < 3; ++t) {
                asm volatile("" ::: "memory");
                const unsigned et = (unsigned)row0 * 4096u + (unsigned)(t * 1024 + col0);
#pragma unroll
                for (int ai = 0; ai < 2; ++ai)
#pragma unroll
                    for (int m = 0; m < 4; ++m)
#pragma unroll
                        for (int bj = 0; bj < 2; ++bj) g[ai][m][bj] = *(const uint4*)(GB + (size_t)(et + (unsigned)((ai * 128 + m * 16) * 4096 + bj * 128)));
                asm volatile("" ::: "memory");
#pragma unroll
                for (int ai = 0; ai < 2; ++ai)
#pragma unroll
                    for (int m = 0; m < 4; ++m)
#pragma unroll
                        for (int bj = 0; bj < 2; ++bj) { const uint4 q = g[ai][m][bj];
                            o[ai][m][bj][0] += (f32x4){lo2f(q.x), hi2f(q.x), lo2f(q.y), hi2f(q.y)}; o[ai][m][bj][1] += (f32x4){lo2f(q.z), hi2f(q.z), lo2f(q.w), hi2f(q.w)}; }
            }
#pragma unroll
            for (int ai = 0; ai < 2; ++ai)
#pragma unroll
                for (int m = 0; m < 4; ++m)
#pragma unroll
                    for (int bj = 0; bj < 2; ++bj) { const f32x4 a0 = o[ai][m][bj][0], a1 = o[ai][m][bj][1];
                        pg8::u32x4 w; w.x = pg8::cvt_pk_bf16(a0[0], a0[1]); w.y = pg8::cvt_pk_bf16(a0[2], a0[3]); w.z = pg8::cvt_pk_bf16(a1[0], a1[1]); w.w = pg8::cvt_pk_bf16(a1[2], a1[3]);
                        *(pg8::u32x4*)(M + (size_t)(em + (unsigned)((ai * 128 + m * 16) * 1024 + bj * 128))) = w; }
        }
    }
    __device__ __forceinline__ void operator()(const f32x4 (&acc)[2][2][4][2], const pg8::Unit& u, int wr_, int wc_, int fr_, int fq_) const {
        int t_ = threadIdx.x; asm volatile("" : "+v"(t_)); const int fr = t_ & 15, fq = (t_ >> 4) & 3, wc = (t_ >> 6) & 3, wr = t_ >> 8; (void)wr_; (void)wc_; (void)fr_; (void)fq_;
        const int row0 = u.pm * 256 + wr * 64 + fr, col0 = u.pn * 256 + wc * 32 + 8 * fq;
        if (u.aux == 3) run<true>(acc, u, row0, col0); else run<false>(acc, u, row0, col0);
    }
};
struct EpiGateMerge {
    static constexpr bool PERM = true, AFTER_DRAIN = false;
    unsigned char* scrP; unsigned char* scrS; bf16_t* TL; bf16_t* M;
    __device__ __forceinline__ void operator()(const f32x4 (&acc)[2][2][4][2], const pg8::Unit& u, int wr_, int wc_, int fr_, int fq_) const {
        int t_ = threadIdx.x; asm volatile("" : "+v"(t_)); const int fr = t_ & 15, fq = (t_ >> 4) & 3, wc = (t_ >> 6) & 3, wr = t_ >> 8; (void)wr_; (void)wc_; (void)fr_; (void)fq_;
        const unsigned lo = (unsigned)blockIdx.x * 131072u + (unsigned)t_ * 16u;
        if (!(u.aux & 8)) {
#pragma unroll
            for (int ai = 0; ai < 2; ++ai)
#pragma unroll
                for (int m = 0; m < 4; ++m)
#pragma unroll
                    for (int bj = 0; bj < 2; ++bj) { const f32x4 v0 = acc[ai][bj][m][0], v1 = acc[ai][bj][m][1];
                        pg8::u32x4 w; w.x = pg8::cvt_pk_bf16(v0[0], v0[1]); w.y = pg8::cvt_pk_bf16(v0[2], v0[3]); w.z = pg8::cvt_pk_bf16(v1[0], v1[1]); w.w = pg8::cvt_pk_bf16(v1[2], v1[3]);
                        *(pg8::u32x4*)(scrP + (size_t)(lo + (unsigned)(((ai * 4 + m) * 2 + bj) * 8192))) = w; }
            return;
        }
        const int br = u.aux & 3; const bool spread = (u.aux & 4) != 0, addS = !spread && br != 0;
        const int lr0 = wr * 64 + fr, lc0 = wc * 32 + 8 * fq;
        unsigned char* dbase; unsigned dstep_m, dstep_ai, dstep_bj, d0;
        if (spread) { dbase = (unsigned char*)TL; d0 = ((unsigned)(((u.aux >> 4) * 4 + br) * 65536 + lr0 * 256 + lc0)) * 2u; dstep_m = 16 * 256 * 2; dstep_ai = 128 * 256 * 2; dstep_bj = 128 * 2; }
        else if (br == 3) { dbase = (unsigned char*)M; d0 = ((unsigned)(u.pm * 256 + lr0) * 1024u + (unsigned)(u.pn * 256 + lc0)) * 2u; dstep_m = 16 * 1024 * 2; dstep_ai = 128 * 1024 * 2; dstep_bj = 128 * 2; }
        else { dbase = scrS; d0 = lo; dstep_m = 2 * 8192; dstep_ai = 8 * 8192; dstep_bj = 8192; }
#pragma unroll
        for (int ai = 0; ai < 2; ++ai) {
            uint4 g[4][2], s[4][2];
#pragma unroll
            for (int m = 0; m < 4; ++m)
#pragma unroll
                for (int bj = 0; bj < 2; ++bj) { const unsigned so = lo + (unsigned)(((ai * 4 + m) * 2 + bj) * 8192);
                    g[m][bj] = *(const uint4*)(scrP + (size_t)so);
                    s[m][bj] = addS ? *(const uint4*)(scrS + (size_t)so) : make_uint4(0u, 0u, 0u, 0u); }
            asm volatile("" ::: "memory");
#pragma unroll
            for (int m = 0; m < 4; ++m)
#pragma unroll
                for (int bj = 0; bj < 2; ++bj) { const uint4 q = g[m][bj], r = s[m][bj]; const f32x4 v0 = acc[ai][bj][m][0], v1 = acc[ai][bj][m][1];
                    pg8::u32x4 w;
                    w.x = pg8::cvt_pk_bf16(sigm(v0[0]) * lo2f(q.x) + lo2f(r.x), sigm(v0[1]) * hi2f(q.x) + hi2f(r.x)); w.y = pg8::cvt_pk_bf16(sigm(v0[2]) * lo2f(q.y) + lo2f(r.y), sigm(v0[3]) * hi2f(q.y) + hi2f(r.y));
                    w.z = pg8::cvt_pk_bf16(sigm(v1[0]) * lo2f(q.z) + lo2f(r.z), sigm(v1[1]) * hi2f(q.z) + hi2f(r.z)); w.w = pg8::cvt_pk_bf16(sigm(v1[2]) * lo2f(q.w) + lo2f(r.w), sigm(v1[3]) * hi2f(q.w) + hi2f(r.w));
                    *(pg8::u32x4*)(dbase + (size_t)(d0 + (unsigned)ai * dstep_ai + (unsigned)m * dstep_m + (unsigned)bj * dstep_bj)) = w; }
            asm volatile("" ::: "memory");
        }
    }
};
struct EpiOut {
    static constexpr bool PERM = false, AFTER_DRAIN = false;
    float* xl; float* xc; const float* mod;
    __device__ __forceinline__ void operator()(const f32x4 (&acc)[2][2][4][2], const pg8::Unit& u, int wr_, int wc_, int fr_, int fq_) const {
        int t_ = threadIdx.x; asm volatile("" : "+v"(t_)); const int fr = t_ & 15, fq = (t_ >> 4) & 3, wc = (t_ >> 6) & 3, wr = t_ >> 8; (void)wr_; (void)wc_; (void)fr_; (void)fq_;
        const int tr = u.pm * 256, col0 = u.pn * 256 + wc * 32 + 4 * fq;
        float* xb = tr < RL ? xl : xc - (size_t)RL * D; const float* gr = mod + (size_t)modrow(tr) * 6144 + col0;
        const unsigned e0 = (unsigned)(tr + wr * 64 + fr) * (unsigned)D + (unsigned)col0;
        f32x4 g[2][2];
#pragma unroll
        for (int bj = 0; bj < 2; ++bj)
#pragma unroll
            for (int n = 0; n < 2; ++n) g[bj][n] = *(const f32x4*)(gr + bj * 128 + n * 16);
#pragma unroll
        for (int ai = 0; ai < 2; ++ai) {
            f32x4 x[4][2][2];
#pragma unroll
            for (int m = 0; m < 4; ++m)
#pragma unroll
                for (int bj = 0; bj < 2; ++bj)
#pragma unroll
                    for (int n = 0; n < 2; ++n) x[m][bj][n] = *(const f32x4*)(xb + (size_t)(e0 + (unsigned)((ai * 128 + m * 16) * D + bj * 128 + n * 16)));
            asm volatile("" ::: "memory");
#pragma unroll
            for (int m = 0; m < 4; ++m)
#pragma unroll
                for (int bj = 0; bj < 2; ++bj)
#pragma unroll
                    for (int n = 0; n < 2; ++n) *(f32x4*)(xb + (size_t)(e0 + (unsigned)((ai * 128 + m * 16) * D + bj * 128 + n * 16))) = x[m][bj][n] + g[bj][n] * acc[ai][bj][m][n];
            asm volatile("" ::: "memory"); }
    }
};
struct EpiMoe1 {
    static constexpr bool PERM = false, AFTER_DRAIN = false;
    bf16_t* ACT;
    __device__ __forceinline__ void operator()(const f32x4 (&acc)[2][2][4][2], const pg8::Unit& u, int wr_, int wc_, int fr_, int fq_) const {
        int t_ = threadIdx.x; asm volatile("" : "+v"(t_)); const int fr = t_ & 15, fq = (t_ >> 4) & 3, wc = (t_ >> 6) & 3, wr = t_ >> 8; (void)wr_; (void)wc_; (void)fr_; (void)fq_;
        const int row0 = u.pm * 256 + wr * 64 + fr;
#pragma unroll
        for (int ai = 0; ai < 2; ++ai)
#pragma unroll
            for (int m = 0; m < 4; ++m) { bf16_t* rowp = ACT + (size_t)(row0 + ai * 128 + m * 16) * 256;
#pragma unroll
                for (int bj = 0; bj < 2; ++bj) { const int j0 = (u.pn * 256 + bj * 128 + wc * 32) / 2 + 4 * fq; const f32x4 a = acc[ai][bj][m][0], b = acc[ai][bj][m][1];
                    pg8::u32x2 w; w.x = pg8::cvt_pk_bf16(silu_(a[0]) * b[0], silu_(a[1]) * b[1]); w.y = pg8::cvt_pk_bf16(silu_(a[2]) * b[2], silu_(a[3]) * b[3]);
                    __hip_atomic_store((unsigned long long*)(rowp + j0), (unsigned long long)w.x | ((unsigned long long)w.y << 32), __ATOMIC_RELAXED, __HIP_MEMORY_SCOPE_AGENT); } }
    }
};
struct EpiS5Y {
    static constexpr bool PERM = true, AFTER_DRAIN = false;
    bf16_t* PMz; const float* dskip; int ctxrows;
    static __device__ __forceinline__ float gelu_f(float x) { return x * sigm(1.5957691216f * x * (1.f + 0.044715f * x * x)); }
    __device__ __forceinline__ void operator()(const f32x4 (&acc)[2][2][4][2], const pg8::Unit& u, int wr_, int wc_, int fr_, int fq_) const {
        int t_ = threadIdx.x; asm volatile("" : "+v"(t_)); const int fr = t_ & 15, fq = (t_ >> 4) & 3, wc = (t_ >> 6) & 3, wr = t_ >> 8; (void)wr_; (void)wc_; (void)fr_; (void)fq_;
        const int row0 = u.pm * 256 + wr * 64 + fr, col0 = wc * 32 + 8 * fq, g = u.aux;
#pragma unroll
        for (int ai = 0; ai < 2; ++ai) {
        unsigned off[2][4][2];
#pragma unroll
            for (int m = 0; m < 4; ++m) { const int rowg = row0 + ai * 128 + m * 16; const bool rv = rowg < 2176; const int rg = rv ? rowg : 0; const int b = rg / 272, cf = rg - b * 272;
#pragma unroll
                for (int bj = 0; bj < 2; ++bj) { const int c = col0 + bj * 128, s = cf * 16 + (c >> 4), h0 = c & 15;
                    int row;
                    if (s < LC) row = RL + b * LC + s; else { const int i = s - LC; row = b * L + (i & 63) * 64 + (i >> 6); }
                    const bool ok = rv && (s >= LC || ctxrows);
                    const unsigned o = (unsigned)row * (unsigned)NP + (unsigned)(PC_S5 + g * 16 + h0);
                    off[ai][m][bj] = ok ? o : 0xffffffffu;
                    (void)o; } }
        asm volatile("" ::: "memory");
#pragma unroll
            for (int m = 0; m < 4; ++m)
#pragma unroll
                for (int bj = 0; bj < 2; ++bj) { const f32x4 v0 = acc[ai][bj][m][0], v1 = acc[ai][bj][m][1];
                    pg8::u32x4 w;
                    w.x = pg8::cvt_pk_bf16(gelu_f(v0[0]), gelu_f(v0[1])); w.y = pg8::cvt_pk_bf16(gelu_f(v0[2]), gelu_f(v0[3]));
                    w.z = pg8::cvt_pk_bf16(gelu_f(v1[0]), gelu_f(v1[1])); w.w = pg8::cvt_pk_bf16(gelu_f(v1[2]), gelu_f(v1[3]));
                    if (off[ai][m][bj] != 0xffffffffu) *(pg8::u32x4*)(PMz + (size_t)off[ai][m][bj]) = w; }
        asm volatile("" ::: "memory"); }
    }
};
struct EpiGlu {
    static constexpr bool PERM = true, AFTER_DRAIN = false;
    const bf16_t* PMz; bf16_t* Yo; const float* bglu;
    __device__ __forceinline__ void operator()(const f32x4 (&acc)[2][2][4][2], const pg8::Unit& u, int wr_, int wc_, int fr_, int fq_) const {
        int t_ = threadIdx.x; asm volatile("" : "+v"(t_)); const int fr = t_ & 15, fq = (t_ >> 4) & 3, wc = (t_ >> 6) & 3, wr = t_ >> 8; (void)wr_; (void)wc_; (void)fr_; (void)fq_;
        const int row0 = u.pm * 256 + wr * 64 + fr, col0 = wc * 32 + 8 * fq;
#pragma unroll
        for (int bj = 0; bj < 2; ++bj) { const int c = col0 + bj * 128;
            const f32x4 b0 = *(const f32x4*)(bglu + c), b1 = *(const f32x4*)(bglu + c + 4);
#pragma unroll
            for (int ai = 0; ai < 2; ++ai)
#pragma unroll
                for (int m = 0; m < 4; ++m) { const size_t r = (size_t)(row0 + ai * 128 + m * 16);
                    const uint4 z = *(const uint4*)(PMz + r * NP + PC_S5 + c);
                    const f32x4 v0 = acc[ai][bj][m][0] + b0, v1 = acc[ai][bj][m][1] + b1;
                    pg8::u32x4 w;
                    w.x = pg8::cvt_pk_bf16(lo2f(z.x) * sigm(v0[0]), hi2f(z.x) * sigm(v0[1])); w.y = pg8::cvt_pk_bf16(lo2f(z.y) * sigm(v0[2]), hi2f(z.y) * sigm(v0[3]));
                    w.z = pg8::cvt_pk_bf16(lo2f(z.z) * sigm(v1[0]), hi2f(z.z) * sigm(v1[1])); w.w = pg8::cvt_pk_bf16(lo2f(z.w) * sigm(v1[2]), hi2f(z.w) * sigm(v1[3]));
                    *(pg8::u32x4*)(Yo + r * D + 768 + c) = w;
                    asm volatile("" ::: "memory"); } }
    }
};

__device__ __forceinline__ void phase_prologue(const P& p, unsigned char* smem) {
    float* cs = (float*)smem;
    float* red = cs + 9 * 1024;
    for (int i = p.tid(); i < 9 * 1024; i += NTHR) { const int r = i >> 10, k = i & 1023; const float v = r < 8 ? p.c()[r * 1024 + k] : p.c_ctx()[k]; cs[i] = silu_(v); }
    __syncthreads();
    for (int item = p.bid(); item < 192; item += p.nblk()) {
        const int layer = item / 96, cc = (item % 96) * 64, cl = p.tid() & 63, kg = p.tid() >> 6;
        const float* w = p.w_mod() + (size_t)layer * 1024 * 6144 + cc + cl;
        float acc[9];
#pragma unroll
        for (int r = 0; r < 9; ++r) acc[r] = 0.f;
        for (int k = kg * 128; k < kg * 128 + 128; ++k) { const float wv = w[(size_t)k * 6144];
#pragma unroll
            for (int r = 0; r < 9; ++r) acc[r] += cs[r * 1024 + k] * wv; }
#pragma unroll
        for (int r = 0; r < 9; ++r) red[(kg * 9 + r) * 64 + cl] = acc[r];
        __syncthreads();
        for (int o = p.tid(); o < 576; o += NTHR) { const int r = o >> 6, c2 = o & 63; float s = p.b_mod()[layer * 6144 + cc + c2];
            for (int k2 = 0; k2 < 8; ++k2) s += red[(k2 * 9 + r) * 64 + c2];
            p.MOD()[(size_t)(layer * 9 + r) * 6144 + cc + c2] = s; }
        __syncthreads();
    }
    for (int i = p.bid() * NTHR + p.tid(); i < 4096; i += p.nblk() * NTHR) {
        const int g = (i >> 6) & 15, d = (i >> 10) & 1, layer = i >> 11;
        const float lr = p.s5_lam_re()[i], li = p.s5_lam_im()[i], st = expf(p.s5_log_step()[(layer * 2 + d) * 16 + g]);
        const float mag = expf(lr * st); float sn, cn; sincosf(li * st, &sn, &cn);
        const float lbr = mag * cn, lbi = mag * sn;
        p.LAMB()[i] = make_float2(lbr, lbi);
        const float nr = lbr - 1.f, ni = lbi, den = lr * lr + li * li;
        const float qr = (nr * lr + ni * li) / den, qi = (ni * lr - nr * li) / den;
        for (int h = 0; h < 16; ++h) { const float br = p.s5_b_re()[(size_t)i * 16 + h], bi = p.s5_b_im()[(size_t)i * 16 + h];
            p.BBAR()[(size_t)i * 16 + h] = make_float2(qr * br - qi * bi, qr * bi + qi * br); }
    }
}

template <int MAP>
__device__ __forceinline__ void tjob(const P& p, int vb, int nvb, const float* src, long ld, int K, int ncols, bf16_t* dst, float* tile) {
    const int ntn = (ncols + 63) >> 6, ntk = K >> 6;
    for (int it = vb; it < ntn * ntk; it += nvb) {
        const int tn = it % ntn, tk = it / ntn, n0 = tn * 64, k0 = tk * 64;
#pragma unroll
        for (int ps = 0; ps < 2; ++ps) { const int kk = ps * 32 + (p.tid() >> 4), n4 = (p.tid() & 15) * 4;
            float4 v = make_float4(0.f, 0.f, 0.f, 0.f);
            if (n0 + n4 < ncols) v = *(const float4*)(src + (size_t)(k0 + kk) * ld + n0 + n4);
            tile[kk * 65 + n4 + 0] = v.x; tile[kk * 65 + n4 + 1] = v.y; tile[kk * 65 + n4 + 2] = v.z; tile[kk * 65 + n4 + 3] = v.w; }
        __syncthreads();
        { const int n = p.tid() >> 3, k8 = (p.tid() & 7) * 8;
          if (n0 + n < ncols) {
              uint4 w; w.x = pack2(tile[(k8 + 0) * 65 + n], tile[(k8 + 1) * 65 + n]); w.y = pack2(tile[(k8 + 2) * 65 + n], tile[(k8 + 3) * 65 + n]);
              w.z = pack2(tile[(k8 + 4) * 65 + n], tile[(k8 + 5) * 65 + n]); w.w = pack2(tile[(k8 + 6) * 65 + n], tile[(k8 + 7) * 65 + n]);
              int row = n0 + n;
              if (MAP == 1) row = (row >> 4) * 32 + (row & 15);
              if (MAP == 2) row = (row >> 4) * 32 + 16 + (row & 15);
              *(uint4*)(dst + (size_t)row * K + k0 + k8) = w; } }
        __syncthreads();
    }
}

__device__ __forceinline__ void s5_build_mats(const P& p, unsigned char* smem) {
    float2* pw = (float2*)smem;
    float* Kd = (float*)(smem + 18432);
    float2* CL = (float2*)(smem + 18432 + 32768);
    float2* BL = (float2*)(smem + 18432 + 32768 + 16896);
    for (int lg = p.bid(); lg < 32; lg += p.nblk()) { const int layer = lg >> 4, g = lg & 15;
        if (p.tid() < 128) { const int d = p.tid() >> 6, pp = p.tid() & 63; const float2 lam = p.LAMB()[((size_t)(layer * 2 + d) * 16 + g) * 64 + pp]; float2 cur = make_float2(1.f, 0.f);
            for (int j = 0; j <= 16; ++j) { pw[(d * 17 + j) * 65 + pp] = cur; cur = make_float2(cur.x * lam.x - cur.y * lam.y, cur.x * lam.y + cur.y * lam.x); } }
        for (int i = p.tid(); i < 2 * 16 * 64; i += NTHR) { const int d = i >> 10, h = (i >> 6) & 15, pp = i & 63; const size_t ci_ = (((size_t)(layer * 2 + d) * 16 + g) * 16 + h) * 64 + pp;
            CL[(d * 16 + h) * 65 + pp] = make_float2(p.s5_c_re()[ci_], p.s5_c_im()[ci_]); }
        for (int i = p.tid(); i < 2 * 64 * 16; i += NTHR) { const int d = i >> 10; BL[i] = p.BBAR()[((size_t)(layer * 2 + d) * 16 + g) * 1024 + (i & 1023)]; }
        __syncthreads();
        {
            const int d = p.tid() >> 8, j = (p.tid() >> 4) & 15, h = p.tid() & 15; float acc[16];
#pragma unroll
            for (int i = 0; i < 16; ++i) acc[i] = 0.f;
#pragma unroll 2
            for (int pp = 0; pp < 64; ++pp) { const float2 c = CL[(d * 16 + h) * 65 + pp], w = pw[(d * 17 + j) * 65 + pp];
                const float zr = c.x * w.x - c.y * w.y, zi = c.x * w.y + c.y * w.x; const float4* b4 = (const float4*)(BL + (d * 64 + pp) * 16);
#pragma unroll
                for (int q = 0; q < 8; ++q) { const float4 bb = b4[q]; acc[2 * q] += zr * bb.x - zi * bb.y; acc[2 * q + 1] += zr * bb.z - zi * bb.w; } }
#pragma unroll
            for (int q = 0; q < 4; ++q) *(float4*)(Kd + ((d * 16 + j) * 16 + h) * 16 + 4 * q) = make_float4(acc[4 * q], acc[4 * q + 1], acc[4 * q + 2], acc[4 * q + 3]);
        }
        __syncthreads();
        for (int e = p.tid(); e < 256 * 256; e += NTHR) { const int n = e >> 8, k = (e & 255) * 2, t = n >> 4, h = n & 15; float v0 = 0.f, v1 = 0.f;
            if (k < 256) { const int i = k >> 4, h2 = k & 15;
                if (i <= t) { const float2 q = *(const float2*)(Kd + ((0 * 16 + (t - i)) * 16 + h) * 16 + h2); v0 += q.x; v1 += q.y; }
                if (i >= t) { const float2 q = *(const float2*)(Kd + ((1 * 16 + (i - t)) * 16 + h) * 16 + h2); v0 += q.x; v1 += q.y; }
                if (i == t) { const float dsk = p.s5_d()[layer * 256 + g * 16 + h]; if (h2 == h) v0 += dsk; if (h2 + 1 == h) v1 += dsk; } }
            else { const int kk = k - 256, d = kk >> 7, pp = (kk >> 1) & 63, ex = d == 0 ? t + 1 : 16 - t;
                const float2 c = CL[(d * 16 + h) * 65 + pp], w = pw[(d * 17 + ex) * 65 + pp];
                v0 = c.x * w.x - c.y * w.y; v1 = -(c.x * w.y + c.y * w.x); }
            *(unsigned*)(p.S5TT() + ((size_t)lg * 256 + n) * 512 + k) = pack2(v0, v1); }
        for (int e = p.tid(); e < 256 * 128; e += NTHR) { const int n = e >> 7, k = (e & 127) * 2, d = n >> 7, pp = (n >> 1) & 63, ri = n & 1, i = k >> 4, h2 = k & 15, ex = d == 0 ? 15 - i : i;
            const float4 bb = *(const float4*)(BL + (d * 64 + pp) * 16 + h2); const float2 w = pw[(d * 17 + ex) * 65 + pp];
            *(unsigned*)(p.S5GG() + ((size_t)lg * 256 + n) * 256 + k) = ri ? pack2(w.x * bb.y + w.y * bb.x, w.x * bb.w + w.y * bb.z) : pack2(w.x * bb.x - w.y * bb.y, w.x * bb.z - w.y * bb.w); }
        __syncthreads();
    }
}

__device__ __forceinline__ void wprep_items(const P& p, int layer, int vb, int nvb, unsigned char* smem, int parts) {
    float* tile = (float*)smem;
    float2* tw = (float2*)(smem + 20480);
    __syncthreads();
    if (p.tid() < 64) { float s, c; sincospif(2.f * p.tid() / 64.f, &s, &c); tw[p.tid()] = make_float2(c, s); }
    __syncthreads();
    const float* win = p.w_in() + (size_t)layer * 1024 * NIN;
    if (parts & 1) {
        tjob<0>(p, vb, nvb, win + 256, NIN, 1024, 2192, p.WINT() + (size_t)512 * 1024, tile);
        tjob<0>(p, vb, nvb, win + 2448, NIN, 1024, 4096, p.WGT(), tile);
        for (int i = 0; i < 4; ++i) tjob<0>(p, vb, nvb, p.w_branch() + ((size_t)layer * 4 + i) * 256 * 1024, 1024, 256, 1024, p.WBT() + (size_t)i * 1024 * 256, tile);
        tjob<0>(p, vb, nvb, p.s5_w_glu() + (size_t)layer * 65536, 256, 256, 256, p.WGLUT(), tile);
        for (int it = vb; it < 1024; it += nvb) {
            const int n = it >> 1, k = (it & 1) * 512 + p.tid(), s = n >> 8, g = (n >> 6) & 3, cp = n & 63;
            const float* src = win + (size_t)k * NIN + g * 64;
            float acc = 0.f;
            for (int c4 = 0; c4 < 64; c4 += 4) { const float4 v = *(const float4*)(src + c4);
                const float2 t0 = tw[((c4 + 0) * cp) & 63], t1 = tw[((c4 + 1) * cp) & 63], t2 = tw[((c4 + 2) * cp) & 63], t3 = tw[((c4 + 3) * cp) & 63];
                acc += s ? (v.x * t0.y + v.y * t1.y + v.z * t2.y + v.w * t3.y) : (v.x * t0.x + v.y * t1.x + v.z * t2.x + v.w * t3.x); }
            p.WINT()[(size_t)n * 1024 + k] = f2bf(acc);
        }
        for (int i = vb * NTHR + p.tid(); i < 112 * 1024; i += nvb * NTHR) p.WINT()[(size_t)2704 * 1024 + i] = 0;
    }
    if (parts & 2) {
        tjob<0>(p, vb, nvb, p.w_out() + (size_t)layer * 1024 * 1024, 1024, 1024, 1024, p.WOT(), tile);
        for (int e = 0; e < 16; ++e) {
            tjob<1>(p, vb, nvb, p.moe_w1() + ((size_t)layer * 16 + e) * 1024 * 256, 256, 1024, 256, p.W13T() + (size_t)e * 512 * 1024, tile);
            tjob<2>(p, vb, nvb, p.moe_w3() + ((size_t)layer * 16 + e) * 1024 * 256, 256, 1024, 256, p.W13T() + (size_t)e * 512 * 1024, tile);
            tjob<0>(p, vb, nvb, p.moe_w2() + ((size_t)layer * 16 + e) * 256 * 1024, 1024, 256, 1024, p.W2T() + (size_t)e * 1024 * 256, tile);
        }
    }
}
__device__ __forceinline__ void phase_wprep(const P& p, int layer, unsigned char* smem) {
    if (layer == 0 && p.bid() < 32) { s5_build_mats(p, smem); return; }
    if (layer == 0) wprep_items(p, 0, p.bid() - 32, p.nblk() - 32, smem, 3);
    else wprep_items(p, 1, p.bid(), p.nblk(), smem, 2);
}

struct N1Row { float4 x[4]; uint2 y0[4], y1[4]; };
__device__ __forceinline__ N1Row n1_load(const P& p, int mode, int r, int2 sl) {
    N1Row o; const int ln4 = p.lane() * 4;
    if (mode == 0) { const float* src = r < RL ? p.x() + (size_t)r * D : p.ctx() + (size_t)(r - RL) * D;
#pragma unroll
        for (int j = 0; j < 4; ++j) { o.x[j] = *(const float4*)(src + j * 256 + ln4); o.y0[j] = make_uint2(0u, 0u); o.y1[j] = o.y0[j]; }
    } else { const float* xr = xrow(p, r);
#pragma unroll
        for (int j = 0; j < 4; ++j) { const int k = j * 256 + ln4;
            typedef float f4nt __attribute__((ext_vector_type(4))); typedef unsigned u2nt __attribute__((ext_vector_type(2)));
            const f4nt xv = __builtin_nontemporal_load((const f4nt*)(xr + k)); o.x[j] = make_float4(xv.x, xv.y, xv.z, xv.w);
            const u2nt a0 = __builtin_nontemporal_load((const u2nt*)(p.YE() + (size_t)sl.x * D + k)), a1 = __builtin_nontemporal_load((const u2nt*)(p.YE() + (size_t)sl.y * D + k));
            o.y0[j] = make_uint2(a0.x, a0.y); o.y1[j] = make_uint2(a1.x, a1.y); }
    }
    return o;
}
__device__ __forceinline__ void phase_norm1(const P& p, int mode) {
    const int gw = p.bid() * 8 + p.wid(), nw = p.nblk() * 8;
    const int nrows = (mode == 2) ? RL : RT, last = nrows - 1;
    const int layer = (mode == 0) ? 0 : 1;
    int4 tk = make_int4(0, 0, 0, 0), tk1 = tk; int2 sl = make_int2(0, 0), sl1 = sl;
    if (mode != 0) { const int rb = min(gw + nw, last); tk = p.TOK()[gw]; sl = p.SLOT()[gw]; tk1 = p.TOK()[rb]; sl1 = p.SLOT()[rb]; }
    N1Row cur = n1_load(p, mode, gw, sl);
#pragma unroll 1
    for (int r = gw; r < nrows; r += nw) {
        const N1Row c = cur; const int4 tkc = tk;
        tk = tk1; sl = sl1;
        if (mode != 0) { const int rc = min(r + 2 * nw, last); tk1 = p.TOK()[rc]; sl1 = p.SLOT()[rc]; }
        cur = n1_load(p, mode, min(r + nw, last), sl);
        const int mr = modrow(r);
        float v[16];
        float* xr = xrow(p, r);
        if (mode == 0) {
#pragma unroll
            for (int j = 0; j < 4; ++j) { v[j * 4] = c.x[j].x; v[j * 4 + 1] = c.x[j].y; v[j * 4 + 2] = c.x[j].z; v[j * 4 + 3] = c.x[j].w; }
        } else {
            const int pl = mode - 1;
            const float* g2 = p.MOD() + (size_t)(pl * 9 + mr) * 6144 + 5 * 1024;
            const float w0 = __int_as_float(tkc.z), w1 = __int_as_float(tkc.w);
#pragma unroll
            for (int j = 0; j < 4; ++j) { const int k = j * 256 + p.lane() * 4; const float4 t = c.x[j]; const uint2 y0 = c.y0[j], y1 = c.y1[j];
                const float4 gg = *(const float4*)(g2 + k);
                v[j * 4] = t.x + gg.x * (w0 * lo2f(y0.x) + w1 * lo2f(y1.x)); v[j * 4 + 1] = t.y + gg.y * (w0 * hi2f(y0.x) + w1 * hi2f(y1.x));
                v[j * 4 + 2] = t.z + gg.z * (w0 * lo2f(y0.y) + w1 * lo2f(y1.y)); v[j * 4 + 3] = t.w + gg.w * (w0 * hi2f(y0.y) + w1 * hi2f(y1.y)); }
        }
        float ss = 0.f;
#pragma unroll
        for (int i = 0; i < 16; ++i) ss += v[i] * v[i];
#pragma unroll
        for (int o = 32; o >= 1; o >>= 1) ss += __shfl_xor(ss, o);
        const float rstd = rsq_fast(ss * (1.f / 1024.f) + 1e-6f);
        if (mode == 2) {
#pragma unroll
            for (int j = 0; j < 4; ++j) { const int k = j * 256 + p.lane() * 4; const float4 g = *(const float4*)(p.final_g() + k);
                typedef float f4nt __attribute__((ext_vector_type(4)));
                const f4nt ov = {v[j * 4] * rstd * g.x, v[j * 4 + 1] * rstd * g.y, v[j * 4 + 2] * rstd * g.z, v[j * 4 + 3] * rstd * g.w};
                __builtin_nontemporal_store(ov, (f4nt*)(p.out() + (size_t)r * D + k)); }
        } else {
            const float* md = p.MOD() + (size_t)(layer * 9 + mr) * 6144;
#pragma unroll
            for (int j = 0; j < 4; ++j) { const int k = j * 256 + p.lane() * 4;
                { typedef float f4nt __attribute__((ext_vector_type(4))); const f4nt xv = {v[j * 4], v[j * 4 + 1], v[j * 4 + 2], v[j * 4 + 3]}; __builtin_nontemporal_store(xv, (f4nt*)(xr + k)); }
                const float4 g = *(const float4*)(p.norm1_g() + layer * 1024 + k), sh = *(const float4*)(md + k), sc = *(const float4*)(md + 1024 + k);
                uint2 o; o.x = pack2(v[j * 4] * rstd * g.x * (1.f + sc.x) + sh.x, v[j * 4 + 1] * rstd * g.y * (1.f + sc.y) + sh.y);
                o.y = pack2(v[j * 4 + 2] * rstd * g.z * (1.f + sc.z) + sh.z, v[j * 4 + 3] * rstd * g.w * (1.f + sc.w) + sh.w);
                *(uint2*)(p.H() + (size_t)r * D + k) = o; }
        }
    }
}

__device__ __forceinline__ void phase_gemm1(const P& p, unsigned char* smem) {
    pg8::Gemm g{p.H(), p.WINT(), 1024, 1024, 1024}; pg8::GridOrder S; S.init(RT, NP, p.nblk(), p.bid(), 1024, 1024);
    EpiStoreBf16 E{p.PM(), NP, 0, 0, p.AC()};
    pg8::gemm_phase<EpiStoreBf16, pg8::GridOrder>((PG8_LAS unsigned char*)smem, g, S, E);
}

__device__ __forceinline__ bf16x8 lds_frag(const unsigned char* base, int row, int ld, int col) { return *(const bf16x8*)(base + ((size_t)row * ld + col) * 2); }
__device__ __forceinline__ void st4bf(unsigned char* base, int row, int ld, int col, float a, float b, float c, float d) { uint2 o; o.x = pack2(a, b); o.y = pack2(c, d); *(uint2*)(base + ((size_t)row * ld + col) * 2) = o; }
__device__ __forceinline__ void scan_pos(int b, int d, int s, int& base, int& l, int& len) {
    if (s < LC) { base = RL + b * LC; len = LC; l = d ? (LC - 1 - s) : s; }
    else { base = b * L; len = L; const int i = s - LC; l = d ? (L - 1 - i) : i; }
}
__device__ __forceinline__ int s5_row(int b, int d, int s) {
    if (s < LC) return RL + b * LC + (d ? (LC - 1 - s) : s);
    int i = s - LC; if (d) i = L - 1 - i;
    return b * L + (i & 63) * 64 + (i >> 6);
}

constexpr int SCT = 32;
__device__ __forceinline__ float dpp_sum8(float x) {
    x += __builtin_bit_cast(float, __builtin_amdgcn_update_dpp(0, __builtin_bit_cast(int, x), 0xB1, 0xF, 0xF, true));
    x += __builtin_bit_cast(float, __builtin_amdgcn_update_dpp(0, __builtin_bit_cast(int, x), 0x4E, 0xF, 0xF, true));
    x += __builtin_bit_cast(float, __builtin_amdgcn_update_dpp(0, __builtin_bit_cast(int, x), 0x141, 0xF, 0xF, true));
    return x;
}
__device__ __forceinline__ void dplr_chunk(float (&S)[8], const float* W, const float* KK, const float* BB, const float* KW, const float* VV, const float* RR, float* YO, int vrow, int kg) {
    float4 k0 = *(const float4*)(KK + kg * 8), k1 = *(const float4*)(KK + kg * 8 + 4);
    float4 w0 = *(const float4*)(W + kg * 8), w1 = *(const float4*)(W + kg * 8 + 4), b0 = *(const float4*)(BB + kg * 8), b1 = *(const float4*)(BB + kg * 8 + 4);
    float4 q0 = *(const float4*)(KW + kg * 8), q1 = *(const float4*)(KW + kg * 8 + 4), r0 = *(const float4*)(RR + kg * 8), r1 = *(const float4*)(RR + kg * 8 + 4);
    float v = VV[vrow];
#pragma unroll 2
    for (int t = 0; t < SCT; ++t) {
        const int on = (t + 1 < SCT ? t + 1 : t) * 64 + kg * 8;
        const float4 nk0 = *(const float4*)(KK + on), nk1 = *(const float4*)(KK + on + 4);
        const float4 nw0 = *(const float4*)(W + on), nw1 = *(const float4*)(W + on + 4), nb0 = *(const float4*)(BB + on), nb1 = *(const float4*)(BB + on + 4);
        const float4 nq0 = *(const float4*)(KW + on), nq1 = *(const float4*)(KW + on + 4), nr0 = *(const float4*)(RR + on), nr1 = *(const float4*)(RR + on + 4);
        const float nv = VV[(t + 1 < SCT ? t + 1 : t) * 32 + vrow];
        float d = S[0] * k0.x + S[1] * k0.y; float d2 = S[2] * k0.z + S[3] * k0.w;
        d += S[4] * k1.x + S[5] * k1.y; d2 += S[6] * k1.z + S[7] * k1.w;
        const float skk = -dpp_sum8(d + d2);
        const float c0 = v * q0.x, c1 = v * q0.y, c2 = v * q0.z, c3 = v * q0.w, c4 = v * q1.x, c5 = v * q1.y, c6 = v * q1.z, c7 = v * q1.w;
        S[0] = S[0] * w0.x + (skk * b0.x + c0); S[1] = S[1] * w0.y + (skk * b0.y + c1); S[2] = S[2] * w0.z + (skk * b0.z + c2); S[3] = S[3] * w0.w + (skk * b0.w + c3);
        S[4] = S[4] * w1.x + (skk * b1.x + c4); S[5] = S[5] * w1.y + (skk * b1.y + c5); S[6] = S[6] * w1.z + (skk * b1.z + c6); S[7] = S[7] * w1.w + (skk * b1.w + c7);
        float y = S[0] * r0.x + S[1] * r0.y; float y2 = S[2] * r0.z + S[3] * r0.w;
        y += S[4] * r1.x + S[5] * r1.y; y2 += S[6] * r1.z + S[7] * r1.w;
        y = dpp_sum8(y + y2);
        if (kg == 0) YO[t * 32 + vrow] = y;
        k0 = nk0; k1 = nk1; w0 = nw0; w1 = nw1; b0 = nb0; b1 = nb1; q0 = nq0; q1 = nq1; r0 = nr0; r1 = nr1; v = nv;
    }
}

__device__ __forceinline__ float rw_shift(const P& p, const float* mu, int base, int l, int len, int cidx) {
    const bf16_t* q = p.PM() + (size_t)(base + l) * NP + PC_RW + cidx;
    const bool hm = l > 0, hn = l < len - 1;
    const float p0 = bf2f(q[0]); float pm = bf2f(*(hm ? q - NP : q)), pn = bf2f(*(hn ? q + NP : q));
    if (!hm) pm = 0.f;
    if (!hn) pn = 0.f;
    return p0 + mu[cidx] * (pm - p0) + mu[896 + cidx] * (pn - p0);
}

struct Raw3 { uint2 m, a, n; };
__device__ __forceinline__ Raw3 rw_raw3(const P& p, int base, int l, int len, int cidx) {
    const bf16_t* q = p.PM() + (size_t)(base + l) * NP + PC_RW + cidx; Raw3 r;
    const bool hm = l > 0, hn = l < len - 1;
    r.a = *(const uint2*)q; r.m = *(const uint2*)(hm ? q - NP : q); r.n = *(const uint2*)(hn ? q + NP : q);
    if (!hm) r.m = make_uint2(0u, 0u);
    if (!hn) r.n = make_uint2(0u, 0u);
    return r;
}
__device__ __forceinline__ float4 rw_mix(const Raw3& x, const float4& m0, const float4& m1) {
    float4 r;
    { const float p0 = lo2f(x.a.x); r.x = p0 + m0.x * (lo2f(x.m.x) - p0) + m1.x * (lo2f(x.n.x) - p0); }
    { const float p0 = hi2f(x.a.x); r.y = p0 + m0.y * (hi2f(x.m.x) - p0) + m1.y * (hi2f(x.n.x) - p0); }
    { const float p0 = lo2f(x.a.y); r.z = p0 + m0.z * (lo2f(x.m.y) - p0) + m1.z * (lo2f(x.n.y) - p0); }
    { const float p0 = hi2f(x.a.y); r.w = p0 + m0.w * (hi2f(x.m.y) - p0) + m1.w * (hi2f(x.n.y) - p0); }
    return r;
}
__device__ __forceinline__ float4 rw_shift4(const P& p, const float* mu, int base, int l, int len, int cidx) {
    const bf16_t* q = p.PM() + (size_t)(base + l) * NP + PC_RW + cidx;
    const uint2 a = *(const uint2*)q;
    uint2 m = make_uint2(0u, 0u), n = make_uint2(0u, 0u);
    if (l > 0) m = *(const uint2*)(q - NP);
    if (l < len - 1) n = *(const uint2*)(q + NP);
    const float4 m0 = *(const float4*)(mu + cidx), m1 = *(const float4*)(mu + 896 + cidx);
    float4 r;
    { const float p0 = lo2f(a.x); r.x = p0 + m0.x * (lo2f(m.x) - p0) + m1.x * (lo2f(n.x) - p0); }
    { const float p0 = hi2f(a.x); r.y = p0 + m0.y * (hi2f(m.x) - p0) + m1.y * (hi2f(n.x) - p0); }
    { const float p0 = lo2f(a.y); r.z = p0 + m0.z * (lo2f(m.y) - p0) + m1.z * (lo2f(n.y) - p0); }
    { const float p0 = hi2f(a.y); r.w = p0 + m0.w * (hi2f(m.y) - p0) + m1.w * (hi2f(n.y) - p0); }
    return r;
}

struct RawIn { Raw3 x[4]; uint2 xv[3][5]; float al, be; int base, l; };
template <bool is_dn, bool EDGE = true>
__device__ __forceinline__ RawIn load_raw_chunk(const P& p, int b, int d, int h, int lq, int lt, int ch) {
    RawIn r; int base, l, len; scan_pos(b, d, ch * 32 + lt, base, l, len);
    r.base = base; r.l = l; r.al = 0.f; r.be = 0.f;
    if (!is_dn) { const int c4 = h * 64 + lq * 4;
        if (EDGE) { r.x[0] = rw_raw3(p, base, l, len, 768 + lq * 4); r.x[1] = rw_raw3(p, base, l, len, c4); r.x[2] = rw_raw3(p, base, l, len, 512 + c4); r.x[3] = rw_raw3(p, base, l, len, 256 + c4); }
        else {
            const bf16_t* q = p.PM() + (size_t)(base + l) * NP + PC_RW; const int cs[4] = {768 + lq * 4, c4, 512 + c4, 256 + c4};
#pragma unroll
            for (int i = 0; i < 4; ++i) { r.x[i].a = *(const uint2*)(q + cs[i]); r.x[i].m = *(const uint2*)(q - NP + cs[i]); r.x[i].n = *(const uint2*)(q + NP + cs[i]); } }
    } else {
#pragma unroll
        for (int s3 = 0; s3 < 3; ++s3)
#pragma unroll
            for (int tap = 0; tap < 5; ++tap) {
                if (EDGE) { const int ll = l + tap - 2; const bool ok = ll >= 0 && ll < len; const int lc_ = ok ? ll : l;
                    r.xv[s3][tap] = *(const uint2*)(p.PM() + (size_t)(base + lc_) * NP + PC_DQKV + s3 * 256 + h * 64 + lq * 4);
                    if (!ok) r.xv[s3][tap] = make_uint2(0u, 0u); }
                else r.xv[s3][tap] = *(const uint2*)(p.PM() + (size_t)(base + l + tap - 2) * NP + PC_DQKV + s3 * 256 + h * 64 + lq * 4); }
        r.al = bf2f(p.PM()[(size_t)(base + l) * NP + PC_DAL + d * 4 + h]); r.be = bf2f(p.PM()[(size_t)(base + l) * NP + PC_DBE + d * 4 + h]);
    }
    return r;
}
template <bool is_dn>
__device__ __forceinline__ void scan_rwkv_dn(const P& p, int layer, int chain, int vhalf, unsigned char* smem) {
    const int d = chain & 1, h = (chain >> 1) & 3, b = chain >> 3;
    float* BUF = (float*)smem;
    float* YOB = BUF + 2 * 11264;
    float* TW = YOB + 2 * 1024; float* TA = TW + SCT * 32; float* WU = TA + SCT * 32; float* AU = WU + 32 * 64;
    const float* mu = p.rw_mu() + (size_t)layer * 2 * 896;
    if (!is_dn) {
        for (int i = p.tid(); i < 32 * 64; i += NTHR) { const int i2 = i >> 6, j = i & 63;
            WU[i] = p.rw_w_up()[((size_t)(layer * 2 + d) * 32 + i2) * 256 + h * 64 + j]; AU[i] = p.rw_a_up()[((size_t)(layer * 2 + d) * 32 + i2) * 256 + h * 64 + j]; }
    }
    float S[8];
#pragma unroll
    for (int i = 0; i < 8; ++i) S[i] = 0.f;
    const bool loader = p.wid() >= 4;
    const int tl = p.tid() & 255;
    const int vrow = (p.wid() & 3) * 8 + (p.lane() >> 3), kg = p.lane() & 7;
    bf16_t* yout = p.YS() + (size_t)((is_dn ? 2 : 0) + d) * RT * 256;
    const float dn_A = is_dn ? expf(p.dn_a_log()[(layer * 2 + d) * 4 + h]) : 0.f;
    const float dn_dtb = is_dn ? p.dn_dt_bias()[(layer * 2 + d) * 4 + h] : 0.f;
    const int lq = p.tid() & 15;
    float4 mu_lo[4], mu_hi[4], inv_w0 = make_float4(0.f, 0.f, 0.f, 0.f), inv_a0 = inv_w0, inv_kk = inv_w0, inv_ka = inv_w0; float4 dn_cw[3][5];
#pragma unroll
    for (int i = 0; i < 4; ++i) { mu_lo[i] = inv_w0; mu_hi[i] = inv_w0; }
#pragma unroll
    for (int s3 = 0; s3 < 3; ++s3)
#pragma unroll
        for (int tap = 0; tap < 5; ++tap) dn_cw[s3][tap] = inv_w0;
    if (!is_dn) { const int c4 = h * 64 + lq * 4; const int cols[4] = {768 + lq * 4, c4, 512 + c4, 256 + c4};
#pragma unroll
        for (int i = 0; i < 4; ++i) { mu_lo[i] = *(const float4*)(mu + cols[i]); mu_hi[i] = *(const float4*)(mu + 896 + cols[i]); }
        inv_w0 = *(const float4*)(p.rw_w0() + (layer * 2 + d) * 256 + c4); inv_a0 = *(const float4*)(p.rw_a0() + (layer * 2 + d) * 256 + c4);
        inv_kk = *(const float4*)(p.rw_k_k() + layer * 256 + c4); inv_ka = *(const float4*)(p.rw_k_a() + layer * 256 + c4);
    } else {
#pragma unroll
        for (int s3 = 0; s3 < 3; ++s3)
#pragma unroll
            for (int tap = 0; tap < 5; ++tap) dn_cw[s3][tap] = *(const float4*)(p.dn_conv() + ((size_t)layer * 5 + tap) * 768 + s3 * 256 + h * 64 + lq * 4);
    }
    __syncthreads();
    constexpr int NCH = (L + LC) / SCT;
    for (int it = 0; it <= NCH; ++it) {
        if (loader) {
            if (it >= 2) {
                const int t = tl >> 3, q = tl & 7; const float* YO = YOB + (it & 1) * 1024;
                int base, l, len; scan_pos(b, d, (it - 2) * SCT + t, base, l, len);
                uint2 o; o.x = pack2(YO[t * 32 + q * 4], YO[t * 32 + q * 4 + 1]); o.y = pack2(YO[t * 32 + q * 4 + 2], YO[t * 32 + q * 4 + 3]);
                *(uint2*)(yout + (size_t)(base + l) * 256 + h * 64 + vhalf * 32 + q * 4) = o;
            }
            if (it < NCH) {
                float* W = BUF + (it & 1) * 11264; float* KK = W + 2048; float* BB = KK + 2048; float* KW = BB + 2048; float* RR = KW + 2048; float* VV = RR + 2048;
#pragma unroll 1
                for (int ps = 0; ps < 2; ++ps) {
                    const int t = ps * 16 + (tl >> 4), q = tl & 15;
                    int base, l, len; scan_pos(b, d, it * SCT + t, base, l, len);
                    if (!is_dn) {
                        const int c4 = h * 64 + q * 4;
                        const Raw3 x0 = rw_raw3(p, base, l, len, 768 + q * 4), x1 = rw_raw3(p, base, l, len, c4), x2 = rw_raw3(p, base, l, len, 512 + c4), x3 = rw_raw3(p, base, l, len, 256 + c4);
                        { const float4 sv = rw_mix(x0, mu_lo[0], mu_hi[0]);
                          if (q < 8) { TW[t * 32 + q * 4] = tanhf(sv.x); TW[t * 32 + q * 4 + 1] = tanhf(sv.y); TW[t * 32 + q * 4 + 2] = tanhf(sv.z); TW[t * 32 + q * 4 + 3] = tanhf(sv.w); }
                          else { *(float4*)(TA + t * 32 + (q - 8) * 4) = sv; } }
                        asm volatile("s_waitcnt lgkmcnt(0)" ::: "memory");
                        float4 lwv = inv_w0, apv = inv_a0;
#pragma unroll 2
                        for (int i2 = 0; i2 < 32; ++i2) { const float tw_ = TW[t * 32 + i2], ta_ = TA[t * 32 + i2]; const float4 wu = *(const float4*)(WU + i2 * 64 + q * 4), au = *(const float4*)(AU + i2 * 64 + q * 4);
                            lwv.x += tw_ * wu.x; lwv.y += tw_ * wu.y; lwv.z += tw_ * wu.z; lwv.w += tw_ * wu.w; apv.x += ta_ * au.x; apv.y += ta_ * au.y; apv.z += ta_ * au.z; apv.w += ta_ * au.w; }
                        const float4 av = make_float4(sigm(apv.x), sigm(apv.y), sigm(apv.z), sigm(apv.w));
                        *(float4*)(W + t * 64 + q * 4) = make_float4(__expf(-0.6065306597f * sigm(lwv.x)), __expf(-0.6065306597f * sigm(lwv.y)), __expf(-0.6065306597f * sigm(lwv.z)), __expf(-0.6065306597f * sigm(lwv.w)));
                        *(float4*)(RR + t * 64 + q * 4) = rw_mix(x1, mu_lo[1], mu_hi[1]);
                        { const float4 vs = rw_mix(x2, mu_lo[2], mu_hi[2]); if ((q >> 3) == vhalf) *(float4*)(VV + t * 32 + (q & 7) * 4) = vs; }
                        const float4 ks = rw_mix(x3, mu_lo[3], mu_hi[3]);
                        const float4 kkm = inv_kk, kam = inv_ka;
                        float4 kk = make_float4(ks.x * kkm.x, ks.y * kkm.y, ks.z * kkm.z, ks.w * kkm.w);
                        float ssq = (kk.x * kk.x + kk.y * kk.y) + (kk.z * kk.z + kk.w * kk.w);
                        ssq += __shfl_xor(ssq, 1); ssq += __shfl_xor(ssq, 2); ssq += __shfl_xor(ssq, 4); ssq += __shfl_xor(ssq, 8);
                        const float rn = rsq_fast(ssq + 1e-6f);
                        kk.x *= rn; kk.y *= rn; kk.z *= rn; kk.w *= rn;
                        *(float4*)(KK + t * 64 + q * 4) = kk;
                        *(float4*)(BB + t * 64 + q * 4) = make_float4(kk.x * av.x, kk.y * av.y, kk.z * av.z, kk.w * av.w);
                        *(float4*)(KW + t * 64 + q * 4) = make_float4(ks.x * (1.f + (av.x - 1.f) * kam.x), ks.y * (1.f + (av.y - 1.f) * kam.y), ks.z * (1.f + (av.z - 1.f) * kam.z), ks.w * (1.f + (av.w - 1.f) * kam.w));
                        asm volatile("s_waitcnt lgkmcnt(0)" ::: "memory");
                    } else {
                        float u[3][4]; float sq = 0.f, sk = 0.f;
                        uint2 xv[3][5];
#pragma unroll
                        for (int s3 = 0; s3 < 3; ++s3)
#pragma unroll
                            for (int tap = 0; tap < 5; ++tap) { const int ll = l + tap - 2; xv[s3][tap] = make_uint2(0u, 0u);
                                if (ll >= 0 && ll < len) xv[s3][tap] = *(const uint2*)(p.PM() + (size_t)(base + ll) * NP + PC_DQKV + s3 * 256 + h * 64 + q * 4); }
                        const float al_raw = bf2f(p.PM()[(size_t)(base + l) * NP + PC_DAL + d * 4 + h]), be_raw = bf2f(p.PM()[(size_t)(base + l) * NP + PC_DBE + d * 4 + h]);
#pragma unroll
                        for (int s3 = 0; s3 < 3; ++s3) { float a0 = 0.f, a1 = 0.f, a2 = 0.f, a3 = 0.f;
#pragma unroll
                            for (int tap = 0; tap < 5; ++tap) { const float4 cw = dn_cw[s3][tap]; const uint2 x = xv[s3][tap];
                                a0 += cw.x * lo2f(x.x); a1 += cw.y * hi2f(x.x); a2 += cw.z * lo2f(x.y); a3 += cw.w * hi2f(x.y); }
                            u[s3][0] = silu_(a0); u[s3][1] = silu_(a1); u[s3][2] = silu_(a2); u[s3][3] = silu_(a3); }
#pragma unroll
                        for (int i = 0; i < 4; ++i) { sq += u[0][i] * u[0][i]; sk += u[1][i] * u[1][i]; }
                        sq += __shfl_xor(sq, 1); sq += __shfl_xor(sq, 2); sq += __shfl_xor(sq, 4); sq += __shfl_xor(sq, 8);
                        sk += __shfl_xor(sk, 1); sk += __shfl_xor(sk, 2); sk += __shfl_xor(sk, 4); sk += __shfl_xor(sk, 8);
                        const float qn = rsq_fast(sq + 1e-6f) * 0.125f, kn = rsq_fast(sk + 1e-6f);
                        const float a = __expf(-dn_A * softplus_(al_raw + dn_dtb)), beta = sigm(be_raw);
#pragma unroll
                        for (int i = 0; i < 4; ++i) { const int j = q * 4 + i; const float k = u[1][i] * kn;
                            W[t * 64 + j] = a; KK[t * 64 + j] = k; BB[t * 64 + j] = a * beta * k; KW[t * 64 + j] = beta * k; RR[t * 64 + j] = u[0][i] * qn;
                            if ((q >> 3) == vhalf) VV[t * 32 + (q & 7) * 4 + i] = u[2][i]; }
                    }
                }
            }
        } else if (it >= 1) {
            const float* W = BUF + ((it - 1) & 1) * 11264; const float* KK = W + 2048; const float* BB = KK + 2048; const float* KW = BB + 2048; const float* RR = KW + 2048; const float* VV = RR + 2048;
            dplr_chunk(S, W, KK, BB, KW, VV, RR, YOB + ((it - 1) & 1) * 1024, vrow, kg);
        }
        __syncthreads();
    }
    if (loader) {
        const int t = tl >> 3, q = tl & 7; const float* YO = YOB + ((NCH - 1) & 1) * 1024;
        int base, l, len; scan_pos(b, d, (NCH - 1) * SCT + t, base, l, len);
        uint2 o; o.x = pack2(YO[t * 32 + q * 4], YO[t * 32 + q * 4 + 1]); o.y = pack2(YO[t * 32 + q * 4 + 2], YO[t * 32 + q * 4 + 3]);
        *(uint2*)(yout + (size_t)(base + l) * 256 + h * 64 + vhalf * 32 + q * 4) = o;
    }
}


constexpr int CT = 32;
constexpr int LD64 = 72, LD32 = 40;
constexpr int O_FLW = 0, O_FKK = 8192, O_FB = 16384, O_FKW = 24576, O_FV = 32768, O_FR = 40960;
constexpr int O_AAB = 0;
constexpr int O_AAK = 4608, O_ARB = 7168, O_ARK = 9728, O_TINV = 12288;
constexpr int O_TINVT = 14848;
constexpr int O_M1T = 16128;
constexpr int O_WT = 17408, O_AVT = 22528, O_U0T = 27648;
constexpr int O_REFF = 32768;
constexpr int O_MC = 37376;
constexpr int O_CS = 49152;
constexpr int O_PT = 51200;
constexpr int O_GM = 51456, O_GG = 51584;
constexpr int O_QK = 51712, O_RQ = 56320, O_BH = 60928, O_KH = 65536;
constexpr int O_QKT = 70144, O_BT = 75264, O_KT = 80384, O_VT = 85504;
constexpr int O_RQS = 90624;
constexpr int O_S0 = 98816;
static_assert(O_S0 + 2 * 9216 <= LDS_RING, "chunk scan LDS");


template <bool is_dn>
__device__ __forceinline__ void scan_dplr_mfma(const P& p, int layer, int chain, unsigned char* smem) {
    const int d = chain & 1, h = (chain >> 1) & 3, b = chain >> 3;
    const int tid = p.tid(), lane = tid & 63, wid = tid >> 6, fr = lane & 15, fq = lane >> 4;
    float* FLW = (float*)(smem + O_FLW); float* FKK = (float*)(smem + O_FKK); float* FB = (float*)(smem + O_FB); float* FKW = (float*)(smem + O_FKW); float* FV = (float*)(smem + O_FV); float* FR = (float*)(smem + O_FR);
    float* CS = (float*)(smem + O_CS); float* PT = (float*)(smem + O_PT); float* GM = (float*)(smem + O_GM); float* GG = (float*)(smem + O_GG); float* RQS = (float*)(smem + O_RQS);
    float* AAB = (float*)(smem + O_AAB);
    float* TW = (float*)(smem + O_REFF); float* TA = TW + CT * 32; float* WU = TA + CT * 32;
    (void)TW; (void)TA; (void)WU;
    unsigned char* TWb = smem + O_QK; unsigned char* TAb = smem + O_QK + 2560;
    unsigned char* WUT = smem + 117248; unsigned char* AUT = smem + 117248 + 5120;
    float* LWP = (float*)(smem + O_RQS); float* APP = (float*)(smem + O_QKT);
    const int lq = tid & 15, lt = tid >> 4;
    const float* mu = p.rw_mu() + (size_t)layer * 2 * 896;
    float4 mu_lo[4], mu_hi[4], inv_w0 = make_float4(0.f, 0.f, 0.f, 0.f), inv_a0 = inv_w0, inv_kk = inv_w0, inv_ka = inv_w0;
    float* CWL = (float*)(smem + 117248);
#pragma unroll
    for (int i = 0; i < 4; ++i) { mu_lo[i] = inv_w0; mu_hi[i] = inv_w0; }
    if (!is_dn) { const int c4 = h * 64 + lq * 4; const int cols[4] = {768 + lq * 4, c4, 512 + c4, 256 + c4};
#pragma unroll
        for (int i = 0; i < 4; ++i) { mu_lo[i] = *(const float4*)(mu + cols[i]); mu_hi[i] = *(const float4*)(mu + 896 + cols[i]); }
        inv_w0 = *(const float4*)(p.rw_w0() + (layer * 2 + d) * 256 + c4); inv_a0 = *(const float4*)(p.rw_a0() + (layer * 2 + d) * 256 + c4);
        inv_kk = *(const float4*)(p.rw_k_k() + layer * 256 + c4); inv_ka = *(const float4*)(p.rw_k_a() + layer * 256 + c4);
    } else {
        for (int i = tid; i < 15 * 64; i += NTHR) { const int st = i >> 6, j = i & 63, s3 = st / 5, tap = st % 5; CWL[i] = p.dn_conv()[((size_t)layer * 5 + tap) * 768 + s3 * 256 + h * 64 + j]; }
    }
    const float dn_A = is_dn ? expf(p.dn_a_log()[(layer * 2 + d) * 4 + h]) : 0.f;
    const float dn_dtb = is_dn ? p.dn_dt_bias()[(layer * 2 + d) * 4 + h] : 0.f;
    if (!is_dn) for (int i = tid; i < 32 * 64; i += NTHR) { const int i2 = i >> 6, j = i & 63;
        ((bf16_t*)WUT)[j * LD32 + i2] = f2bf(p.rw_w_up()[((size_t)(layer * 2 + d) * 32 + i2) * 256 + h * 64 + j]); ((bf16_t*)AUT)[j * LD32 + i2] = f2bf(p.rw_a_up()[((size_t)(layer * 2 + d) * 32 + i2) * 256 + h * 64 + j]); }
    bf16_t* yout = p.YS() + (size_t)((is_dn ? 2 : 0) + d) * RT * 256;
    f32x4 Sacc[2]; Sacc[0] = (f32x4){0.f, 0.f, 0.f, 0.f}; Sacc[1] = Sacc[0];
    for (int i = tid; i < 2 * 9216 / 4; i += NTHR) ((unsigned*)(smem + O_S0))[i] = 0u;
    __syncthreads();
    constexpr int NCH = (L + LC) / CT;
    RawIn cur = load_raw_chunk<is_dn>(p, b, d, h, lq, lt, 0);
#pragma unroll 1
    for (int ch = 0; ch < NCH; ++ch) {
        if (!is_dn) {
            const float4 sv0 = rw_mix(cur.x[0], mu_lo[0], mu_hi[0]), rs4 = rw_mix(cur.x[1], mu_lo[1], mu_hi[1]), vs4 = rw_mix(cur.x[2], mu_lo[2], mu_hi[2]), ks4 = rw_mix(cur.x[3], mu_lo[3], mu_hi[3]);
            if (ch + 1 < NCH) cur = load_raw_chunk<is_dn>(p, b, d, h, lq, lt, ch + 1);
            { const float4 sv = sv0;
              if (lq < 8) st4bf(TWb, lt, LD32, lq * 4, fast_tanh(sv.x), fast_tanh(sv.y), fast_tanh(sv.z), fast_tanh(sv.w));
              else st4bf(TAb, lt, LD32, (lq - 8) * 4, sv.x, sv.y, sv.z, sv.w); }
            __syncthreads();
            { const int mt = wid & 1, nt = wid >> 1;
              const bf16x8 aw = lds_frag(TWb, mt * 16 + fr, LD32, fq * 8), aa = lds_frag(TAb, mt * 16 + fr, LD32, fq * 8);
              const bf16x8 bw = lds_frag(WUT, nt * 16 + fr, LD32, fq * 8), ba = lds_frag(AUT, nt * 16 + fr, LD32, fq * 8);
              f32x4 cw = (f32x4){0.f, 0.f, 0.f, 0.f}, ca = cw;
              cw = __builtin_amdgcn_mfma_f32_16x16x32_bf16(bw, aw, cw, 0, 0, 0); ca = __builtin_amdgcn_mfma_f32_16x16x32_bf16(ba, aa, ca, 0, 0, 0);
              *(float4*)(LWP + (mt * 16 + fr) * 64 + nt * 16 + 4 * fq) = make_float4(cw[0], cw[1], cw[2], cw[3]);
              *(float4*)(APP + (mt * 16 + fr) * 64 + nt * 16 + 4 * fq) = make_float4(ca[0], ca[1], ca[2], ca[3]); }
            __syncthreads();
            float4 lwv = *(const float4*)(LWP + lt * 64 + lq * 4), apv = *(const float4*)(APP + lt * 64 + lq * 4);
            lwv.x += inv_w0.x; lwv.y += inv_w0.y; lwv.z += inv_w0.z; lwv.w += inv_w0.w; apv.x += inv_a0.x; apv.y += inv_a0.y; apv.z += inv_a0.z; apv.w += inv_a0.w;
            const float4 av = make_float4(sigm(apv.x), sigm(apv.y), sigm(apv.z), sigm(apv.w));
            *(float4*)(FLW + lt * 64 + lq * 4) = make_float4(-0.6065306597f * sigm(lwv.x), -0.6065306597f * sigm(lwv.y), -0.6065306597f * sigm(lwv.z), -0.6065306597f * sigm(lwv.w));
            *(float4*)(FR + lt * 64 + lq * 4) = rs4;
            *(float4*)(FV + lt * 64 + lq * 4) = vs4;
            const float4 ks = ks4;
            float4 kk = make_float4(ks.x * inv_kk.x, ks.y * inv_kk.y, ks.z * inv_kk.z, ks.w * inv_kk.w);
            float ssq = (kk.x * kk.x + kk.y * kk.y) + (kk.z * kk.z + kk.w * kk.w);
            ssq += __shfl_xor(ssq, 1); ssq += __shfl_xor(ssq, 2); ssq += __shfl_xor(ssq, 4); ssq += __shfl_xor(ssq, 8);
            const float rn = rsq_fast(ssq + 1e-6f);
            kk.x *= rn; kk.y *= rn; kk.z *= rn; kk.w *= rn;
            *(float4*)(FKK + lt * 64 + lq * 4) = kk;
            *(float4*)(FB + lt * 64 + lq * 4) = make_float4(kk.x * av.x, kk.y * av.y, kk.z * av.z, kk.w * av.w);
            *(float4*)(FKW + lt * 64 + lq * 4) = make_float4(ks.x * (1.f + (av.x - 1.f) * inv_ka.x), ks.y * (1.f + (av.y - 1.f) * inv_ka.y), ks.z * (1.f + (av.z - 1.f) * inv_ka.z), ks.w * (1.f + (av.w - 1.f) * inv_ka.w));
        } else {
            float u[3][4]; float sq = 0.f, sk = 0.f;
            const float al_raw = cur.al, be_raw = cur.be;
#pragma unroll
            for (int s3 = 0; s3 < 3; ++s3) { float a0 = 0.f, a1 = 0.f, a2 = 0.f, a3 = 0.f;
#pragma unroll
                for (int tap = 0; tap < 5; ++tap) { const float4 cw = *(const float4*)(CWL + (s3 * 5 + tap) * 64 + lq * 4); const uint2 x = cur.xv[s3][tap];
                    a0 += cw.x * lo2f(x.x); a1 += cw.y * hi2f(x.x); a2 += cw.z * lo2f(x.y); a3 += cw.w * hi2f(x.y); }
                u[s3][0] = a0; u[s3][1] = a1; u[s3][2] = a2; u[s3][3] = a3; }
            asm volatile("" : "+v"(u[0][0]), "+v"(u[0][1]), "+v"(u[0][2]), "+v"(u[0][3]), "+v"(u[1][0]), "+v"(u[1][1]), "+v"(u[1][2]), "+v"(u[1][3]), "+v"(u[2][0]), "+v"(u[2][1]), "+v"(u[2][2]), "+v"(u[2][3]));
            if (ch + 1 < NCH) cur = load_raw_chunk<is_dn>(p, b, d, h, lq, lt, ch + 1);
#pragma unroll
            for (int s3 = 0; s3 < 3; ++s3)
#pragma unroll
                for (int i = 0; i < 4; ++i) u[s3][i] = silu_(u[s3][i]);
#pragma unroll
            for (int i = 0; i < 4; ++i) { sq += u[0][i] * u[0][i]; sk += u[1][i] * u[1][i]; }
            sq += __shfl_xor(sq, 1); sq += __shfl_xor(sq, 2); sq += __shfl_xor(sq, 4); sq += __shfl_xor(sq, 8);
            sk += __shfl_xor(sk, 1); sk += __shfl_xor(sk, 2); sk += __shfl_xor(sk, 4); sk += __shfl_xor(sk, 8);
            const float qn = rsq_fast(sq + 1e-6f) * 0.125f, kn = rsq_fast(sk + 1e-6f);
            const float la = -dn_A * softplus_(al_raw + dn_dtb), a = __expf(la), beta = sigm(be_raw);
#pragma unroll
            for (int i = 0; i < 4; ++i) { const int j = lq * 4 + i; const float k = u[1][i] * kn;
                FLW[lt * 64 + j] = la; FKK[lt * 64 + j] = k; FB[lt * 64 + j] = a * beta * k; FKW[lt * 64 + j] = beta * k; FV[lt * 64 + j] = u[2][i]; FR[lt * 64 + j] = u[0][i] * qn; }
        }
        __syncthreads();
        const int k = tid & 63, tg = tid >> 6, t0 = tg * 4;
        float c0 = FLW[(t0 + 0) * 64 + k], c1 = c0 + FLW[(t0 + 1) * 64 + k], c2 = c1 + FLW[(t0 + 2) * 64 + k], c3 = c2 + FLW[(t0 + 3) * 64 + k];
        CS[tg * 64 + k] = c3;
        __syncthreads();
        {
            float off = 0.f, tot = 0.f;
#pragma unroll
            for (int g2 = 0; g2 < 8; ++g2) { const float s = CS[g2 * 64 + k]; tot += s; if (g2 < tg) off += s; }
            const float cum[4] = {off + c0, off + c1, off + c2, off + c3}; const float cumm[4] = {off, off + c0, off + c1, off + c2};
            float qk[4], bt[4], kt[4], vv[4];
#pragma unroll
            for (int j = 0; j < 4; ++j) { const int t = t0 + j; const float kkv = FKK[t * 64 + k], bv = FB[t * 64 + k], kwv = FKW[t * 64 + k], rv = FR[t * 64 + k];
                const float em = __expf(cumm[j]), ec = __expf(cum[j]), ee = __expf(tot - cum[j]);
                vv[j] = FV[t * 64 + k]; qk[j] = kkv * em; bt[j] = bv * ee; kt[j] = kwv * ee;
                RQS[t * 64 + k] = rv * ec;
                if (!is_dn) { const float ei = __expf(-cum[j]);
                    ((bf16_t*)(smem + O_QK))[t * LD64 + k] = f2bf(kkv * em); ((bf16_t*)(smem + O_RQ))[t * LD64 + k] = f2bf(rv * ec);
                    ((bf16_t*)(smem + O_BH))[t * LD64 + k] = f2bf(bv * ei); ((bf16_t*)(smem + O_KH))[t * LD64 + k] = f2bf(kwv * ei);
                } else {
                    ((bf16_t*)(smem + O_QK))[t * LD64 + k] = f2bf(kkv); ((bf16_t*)(smem + O_RQ))[t * LD64 + k] = f2bf(rv);
                    ((bf16_t*)(smem + O_BH))[t * LD64 + k] = f2bf(bv); ((bf16_t*)(smem + O_KH))[t * LD64 + k] = f2bf(kwv);
                    if (k == 0) { GM[t] = cumm[j]; GG[t] = cum[j]; }
                } }
            st4bf(smem + O_QKT, k, LD32, t0, qk[0], qk[1], qk[2], qk[3]); st4bf(smem + O_BT, k, LD32, t0, bt[0], bt[1], bt[2], bt[3]);
            st4bf(smem + O_KT, k, LD32, t0, kt[0], kt[1], kt[2], kt[3]); st4bf(smem + O_VT, k, LD32, t0, vv[0], vv[1], vv[2], vv[3]);
            if (tg == 0) PT[k] = __expf(tot);
        }
        __syncthreads();
        {
            const int mi = wid >> 1, hf = wid & 1;
            const unsigned char* Ab = smem + (mi < 2 ? O_QK : O_RQ); const unsigned char* Bb = smem + ((mi & 1) ? O_KH : O_BH);
            f32x4 acc[2]; acc[0] = (f32x4){0.f, 0.f, 0.f, 0.f}; acc[1] = acc[0];
#pragma unroll
            for (int ks = 0; ks < 2; ++ks) { const bf16x8 af = lds_frag(Ab, hf * 16 + fr, LD64, ks * 32 + fq * 8);
#pragma unroll
                for (int nt = 0; nt < 2; ++nt) { const bf16x8 bfv = lds_frag(Bb, nt * 16 + fr, LD64, ks * 32 + fq * 8); acc[nt] = __builtin_amdgcn_mfma_f32_16x16x32_bf16(bfv, af, acc[nt], 0, 0, 0); } }
            const int t = hf * 16 + fr; const float gt = is_dn ? (mi < 2 ? GM[t] : GG[t]) : 0.f;
#pragma unroll
            for (int nt = 0; nt < 2; ++nt) { float o[4];
#pragma unroll
                for (int j = 0; j < 4; ++j) { const int i = nt * 16 + 4 * fq + j; const bool keep = mi < 2 ? (i < t) : (i <= t); float val = keep ? acc[nt][j] : 0.f;
                    if (is_dn && keep) val *= __expf(gt - GG[i]); o[j] = val; }
                const int i0 = nt * 16 + 4 * fq;
                if (mi == 0) *(float4*)(AAB + t * 36 + i0) = make_float4(o[0], o[1], o[2], o[3]);
                else st4bf(smem + (mi == 1 ? O_AAK : (mi == 2 ? O_ARB : O_ARK)), t, LD32, i0, o[0], o[1], o[2], o[3]); }
        }
        __syncthreads();
        if (wid == 0) {
            bf16_t* TINV = (bf16_t*)(smem + O_TINV); bf16_t* TINVT = (bf16_t*)(smem + O_TINVT); bf16_t* M1T = (bf16_t*)(smem + O_M1T);
            if (lane < 32) { const int blk = lane >> 4, j = lane & 15; float x[16];
#pragma unroll
                for (int t = 0; t < 16; ++t) { float s = (t == j) ? 1.f : 0.f, s2 = 0.f; const float* rowp = AAB + (blk * 16 + t) * 36 + blk * 16;
                    float rv[16];
#pragma unroll
                    for (int i4 = 0; i4 < 16; i4 += 4) if (i4 < t) { const float4 q4 = *(const float4*)(rowp + i4); rv[i4] = q4.x; rv[i4 + 1] = q4.y; rv[i4 + 2] = q4.z; rv[i4 + 3] = q4.w; }
#pragma unroll
                    for (int i = 0; i < t; ++i) { if (i & 1) s2 -= rv[i] * x[i]; else s -= rv[i] * x[i]; }
                    x[t] = s + s2; }
#pragma unroll
                for (int t = 0; t < 16; ++t) TINV[(blk * 16 + t) * LD32 + blk * 16 + j] = f2bf(x[t]);
                if (blk == 0) {
#pragma unroll
                    for (int t = 0; t < 16; t += 4) st4bf(smem + O_TINVT, j, LD32, t, x[t], x[t + 1], x[t + 2], x[t + 3]); }
            } else { const int r = lane - 32;
#pragma unroll
                for (int t = 0; t < 16; t += 4) if (r < 16) st4bf(smem + O_TINV, r, LD32, 16 + t, 0.f, 0.f, 0.f, 0.f); }
            asm volatile("s_waitcnt lgkmcnt(0)" ::: "memory");
            bf16x8 af, bfv; const bf16x8 zf = {0, 0, 0, 0, 0, 0, 0, 0};
            if (fq < 2) { const float* lp = AAB + (16 + fr) * 36 + fq * 8; uint4 w; w.x = pack2(lp[0], lp[1]); w.y = pack2(lp[2], lp[3]); w.z = pack2(lp[4], lp[5]); w.w = pack2(lp[6], lp[7]); af = __builtin_bit_cast(bf16x8, w);
                bfv = lds_frag(smem + O_TINVT, fr, LD32, fq * 8); } else { af = zf; bfv = zf; }
            f32x4 m1 = (f32x4){0.f, 0.f, 0.f, 0.f};
            m1 = __builtin_amdgcn_mfma_f32_16x16x32_bf16(bfv, af, m1, 0, 0, 0);
#pragma unroll
            for (int j = 0; j < 4; ++j) M1T[(4 * fq + j) * LD32 + fr] = f2bf(m1[j]);
            asm volatile("s_waitcnt lgkmcnt(0)" ::: "memory");
            if (fq < 2) { af = lds_frag(smem + O_TINV, 16 + fr, LD32, 16 + fq * 8); bfv = lds_frag(smem + O_M1T, fr, LD32, fq * 8); } else { af = zf; bfv = zf; }
            f32x4 x21 = (f32x4){0.f, 0.f, 0.f, 0.f};
            x21 = __builtin_amdgcn_mfma_f32_16x16x32_bf16(bfv, af, x21, 0, 0, 0);
            st4bf(smem + O_TINV, 16 + fr, LD32, 4 * fq, -x21[0], -x21[1], -x21[2], -x21[3]);
        }
        __syncthreads();
        {
            const int mt = wid & 3, nt = wid >> 2;
            { const bf16x8 af = lds_frag(smem + O_QKT, mt * 16 + fr, LD32, fq * 8), bfv = lds_frag(smem + O_TINV, nt * 16 + fr, LD32, fq * 8);
              f32x4 acc = (f32x4){0.f, 0.f, 0.f, 0.f}; acc = __builtin_amdgcn_mfma_f32_16x16x32_bf16(bfv, af, acc, 0, 0, 0);
              st4bf(smem + O_WT, mt * 16 + fr, LD32, nt * 16 + 4 * fq, acc[0], acc[1], acc[2], acc[3]); }
            { const bf16x8 af = lds_frag(smem + O_VT, mt * 16 + fr, LD32, fq * 8), bfv = lds_frag(smem + O_AAK, nt * 16 + fr, LD32, fq * 8);
              f32x4 acc = (f32x4){0.f, 0.f, 0.f, 0.f}; acc = __builtin_amdgcn_mfma_f32_16x16x32_bf16(bfv, af, acc, 0, 0, 0);
              st4bf(smem + O_AVT, mt * 16 + fr, LD32, nt * 16 + 4 * fq, acc[0], acc[1], acc[2], acc[3]); }
        }
        __syncthreads();
        {
            { const int mt = wid & 3, nt = wid >> 2;
              const bf16x8 af = lds_frag(smem + O_AVT, mt * 16 + fr, LD32, fq * 8), bfv = lds_frag(smem + O_TINV, nt * 16 + fr, LD32, fq * 8);
              f32x4 acc = (f32x4){0.f, 0.f, 0.f, 0.f}; acc = __builtin_amdgcn_mfma_f32_16x16x32_bf16(bfv, af, acc, 0, 0, 0);
              st4bf(smem + O_U0T, mt * 16 + fr, LD32, nt * 16 + 4 * fq, -acc[0], -acc[1], -acc[2], -acc[3]); }
            { const int mt = wid & 1, nt = wid >> 1;
              const bf16x8 af = lds_frag(smem + O_ARB, mt * 16 + fr, LD32, fq * 8), bfv = lds_frag(smem + O_WT, nt * 16 + fr, LD32, fq * 8);
              f32x4 acc = (f32x4){0.f, 0.f, 0.f, 0.f}; acc = __builtin_amdgcn_mfma_f32_16x16x32_bf16(bfv, af, acc, 0, 0, 0);
              const int t = mt * 16 + fr, k0 = nt * 16 + 4 * fq; const float4 rq = *(const float4*)(RQS + t * 64 + k0);
              st4bf(smem + O_REFF, t, LD64, k0, rq.x - acc[0], rq.y - acc[1], rq.z - acc[2], rq.w - acc[3]); }
#pragma unroll
            for (int j2 = 0; j2 < 2; ++j2) { const int mt = wid & 3, nt = (wid >> 2) * 2 + j2;
              const bf16x8 af = lds_frag(smem + O_BT, mt * 16 + fr, LD32, fq * 8), bfv = lds_frag(smem + O_WT, nt * 16 + fr, LD32, fq * 8);
              f32x4 acc = (f32x4){0.f, 0.f, 0.f, 0.f}; acc = __builtin_amdgcn_mfma_f32_16x16x32_bf16(bfv, af, acc, 0, 0, 0);
              st4bf(smem + O_MC, mt * 16 + fr, LD64, nt * 16 + 4 * fq, -acc[0], -acc[1], -acc[2], -acc[3]); }
        }
        __syncthreads();
        {
            const unsigned char* S0c = smem + O_S0 + (ch & 1) * 9216; unsigned char* S0n = smem + O_S0 + ((ch + 1) & 1) * 9216;
            { const int mt = wid & 1, nt = wid >> 1;
              f32x4 acc = (f32x4){0.f, 0.f, 0.f, 0.f};
#pragma unroll
              for (int ks = 0; ks < 2; ++ks) acc = __builtin_amdgcn_mfma_f32_16x16x32_bf16(lds_frag(S0c, nt * 16 + fr, LD64, ks * 32 + fq * 8), lds_frag(smem + O_REFF, mt * 16 + fr, LD64, ks * 32 + fq * 8), acc, 0, 0, 0);
              acc = __builtin_amdgcn_mfma_f32_16x16x32_bf16(lds_frag(smem + O_U0T, nt * 16 + fr, LD32, fq * 8), lds_frag(smem + O_ARB, mt * 16 + fr, LD32, fq * 8), acc, 0, 0, 0);
              acc = __builtin_amdgcn_mfma_f32_16x16x32_bf16(lds_frag(smem + O_VT, nt * 16 + fr, LD32, fq * 8), lds_frag(smem + O_ARK, mt * 16 + fr, LD32, fq * 8), acc, 0, 0, 0);
              int yb, yl, ylen; scan_pos(b, d, ch * CT + mt * 16 + fr, yb, yl, ylen);
              uint2 o; o.x = pack2(acc[0], acc[1]); o.y = pack2(acc[2], acc[3]);
              *(uint2*)(yout + (size_t)(yb + yl) * 256 + h * 64 + nt * 16 + 4 * fq) = o; }
#pragma unroll
            for (int j2 = 0; j2 < 2; ++j2) { const int mt = wid & 3, nt = (wid >> 2) * 2 + j2;
              const float4 pt = *(const float4*)(PT + nt * 16 + 4 * fq);
              f32x4 acc = Sacc[j2]; acc[0] *= pt.x; acc[1] *= pt.y; acc[2] *= pt.z; acc[3] *= pt.w;
#pragma unroll
              for (int ks = 0; ks < 2; ++ks) acc = __builtin_amdgcn_mfma_f32_16x16x32_bf16(lds_frag(smem + O_MC, nt * 16 + fr, LD64, ks * 32 + fq * 8), lds_frag(S0c, mt * 16 + fr, LD64, ks * 32 + fq * 8), acc, 0, 0, 0);
              acc = __builtin_amdgcn_mfma_f32_16x16x32_bf16(lds_frag(smem + O_BT, nt * 16 + fr, LD32, fq * 8), lds_frag(smem + O_U0T, mt * 16 + fr, LD32, fq * 8), acc, 0, 0, 0);
              acc = __builtin_amdgcn_mfma_f32_16x16x32_bf16(lds_frag(smem + O_KT, nt * 16 + fr, LD32, fq * 8), lds_frag(smem + O_VT, mt * 16 + fr, LD32, fq * 8), acc, 0, 0, 0);
              Sacc[j2] = acc;
              st4bf(S0n, mt * 16 + fr, LD64, nt * 16 + 4 * fq, acc[0], acc[1], acc[2], acc[3]); }
        }
        __syncthreads();
    }
}

constexpr int K_QK = 0, K_RQ = 4608, K_BH = 9216, K_KH = 13824;
constexpr int K_V = 18432;
constexpr int K_PT = 22528, K_GM = 22784, K_GG = 22912;
constexpr int PKG_BYTES = 24576;
constexpr int T_QKT = 0, T_BT = 5120, T_KT = 10240, T_VT = 15360, T_BYTES = 20480;
constexpr int RING_R = 8;
constexpr int P_PK = 51712;
constexpr int P_TW = 98304, P_TA = 100864, P_LWP = 103424, P_APP = 111616, P_WUT = 119808, P_AUT = 124928, P_CWL = 119808;
constexpr int C_PKG = 46592, C_T = C_PKG + 2 * PKG_BYTES, C_S0 = C_T + T_BYTES;
static_assert(P_PK + PKG_BYTES <= P_TW && P_AUT + 5120 <= LDS_BYTES - 16, "producer LDS");
static_assert(C_S0 + 2 * 9216 <= LDS_BYTES - 16, "consumer LDS");
static_assert((size_t)128 * RING_R * PKG_BYTES <= (size_t)RL * D * 2, "ring stays below the context rows of Y");
static_assert(PKG_BYTES == 3 * 8192, "copy-out rounds");
constexpr int CW_RING = 8192;
static_assert((CW_RING + 2 * 128 * 32) * 4 <= (int)CTL_BYTES, "ring flags");
__device__ __forceinline__ void ring_wait(unsigned* flag, unsigned need, unsigned& seen, unsigned* bar) {
    if (seen >= need) return;
    unsigned sp = 0u;
    for (;;) {
        seen = __builtin_amdgcn_readfirstlane(xb_ld(flag));
        if (seen >= need) break;
        __builtin_amdgcn_s_sleep(1);
        if ((++sp & 255u) == 0u) { if (xb_ld(&bar[XB_TMO])) break; if (sp > XB_SPIN_CAP) { atomicAdd(&bar[XB_TMO], 1u); break; } }
    }
}
template <bool is_dn>
__device__ __forceinline__ void scan_producer(const P& p, int layer, int chain, unsigned char* smem) {
    const int d = chain & 1, h = (chain >> 1) & 3, b = chain >> 3;
    const int tid = p.tid(), lane = tid & 63, wid = tid >> 6, fr = lane & 15, fq = lane >> 4;
    float* FLW = (float*)(smem + O_FLW); float* FKK = (float*)(smem + O_FKK); float* FB = (float*)(smem + O_FB); float* FKW = (float*)(smem + O_FKW); float* FV = (float*)(smem + O_FV); float* FR = (float*)(smem + O_FR);
    float* CS = (float*)(smem + O_CS); unsigned char* pk = smem + P_PK; float* PT = (float*)(pk + K_PT); float* GM = (float*)(pk + K_GM); float* GG = (float*)(pk + K_GG);
    unsigned char* TWb = smem + P_TW; unsigned char* TAb = smem + P_TA;
    unsigned char* WUT = smem + P_WUT; unsigned char* AUT = smem + P_AUT;
    float* LWP = (float*)(smem + P_LWP); float* APP = (float*)(smem + P_APP);
    const int lq = tid & 15, lt = tid >> 4;
    const float* mu = p.rw_mu() + (size_t)layer * 2 * 896;
    float4 mu_lo[4], mu_hi[4], inv_w0 = make_float4(0.f, 0.f, 0.f, 0.f), inv_a0 = inv_w0, inv_kk = inv_w0, inv_ka = inv_w0;
    float* CWL = (float*)(smem + P_CWL);
#pragma unroll
    for (int i = 0; i < 4; ++i) { mu_lo[i] = inv_w0; mu_hi[i] = inv_w0; }
    if (!is_dn) { const int c4 = h * 64 + lq * 4; const int cols[4] = {768 + lq * 4, c4, 512 + c4, 256 + c4};
#pragma unroll
        for (int i = 0; i < 4; ++i) { mu_lo[i] = *(const float4*)(mu + cols[i]); mu_hi[i] = *(const float4*)(mu + 896 + cols[i]); }
        inv_w0 = *(const float4*)(p.rw_w0() + (layer * 2 + d) * 256 + c4); inv_a0 = *(const float4*)(p.rw_a0() + (layer * 2 + d) * 256 + c4);
        inv_kk = *(const float4*)(p.rw_k_k() + layer * 256 + c4); inv_ka = *(const float4*)(p.rw_k_a() + layer * 256 + c4);
    } else {
        for (int i = tid; i < 15 * 64; i += NTHR) { const int st = i >> 6, j = i & 63, s3 = st / 5, tap = st % 5; CWL[i] = p.dn_conv()[((size_t)layer * 5 + tap) * 768 + s3 * 256 + h * 64 + j]; }
    }
    const float dn_A = is_dn ? expf(p.dn_a_log()[(layer * 2 + d) * 4 + h]) : 0.f;
    const float dn_dtb = is_dn ? p.dn_dt_bias()[(layer * 2 + d) * 4 + h] : 0.f;
    if (!is_dn) for (int i = tid; i < 32 * 64; i += NTHR) { const int i2 = i >> 6, j = i & 63;
        ((bf16_t*)WUT)[j * LD32 + i2] = f2bf(p.rw_w_up()[((size_t)(layer * 2 + d) * 32 + i2) * 256 + h * 64 + j]); ((bf16_t*)AUT)[j * LD32 + i2] = f2bf(p.rw_a_up()[((size_t)(layer * 2 + d) * 32 + i2) * 256 + h * 64 + j]); }
    const int cg = (is_dn ? 64 : 0) + chain;
    unsigned* fl = p.ctl() + CW_RING + (layer * 128 + cg) * 32;
    unsigned char* ring = (unsigned char*)p.Y() + (size_t)cg * RING_R * PKG_BYTES;
    const __amdgpu_buffer_rsrc_t ring_rs = __builtin_amdgcn_make_buffer_rsrc((void*)ring, 0, RING_R * PKG_BYTES, 0x00020000);
    unsigned cons_seen = 0u;
    __syncthreads();
    constexpr int NCH = (L + LC) / CT;
    RawIn cur = load_raw_chunk<is_dn>(p, b, d, h, lq, lt, 0);
#pragma unroll 1
    for (int ch = 0; ch < NCH; ++ch) {
        if (!is_dn) {
            const float4 sv0 = rw_mix(cur.x[0], mu_lo[0], mu_hi[0]), rs4 = rw_mix(cur.x[1], mu_lo[1], mu_hi[1]), vs4 = rw_mix(cur.x[2], mu_lo[2], mu_hi[2]), ks4 = rw_mix(cur.x[3], mu_lo[3], mu_hi[3]);
            if (ch + 1 < NCH) { const int cn = ch + 1; if (cn == 7 || cn == 8 || cn == NCH - 1) cur = load_raw_chunk<is_dn, true>(p, b, d, h, lq, lt, cn); else cur = load_raw_chunk<is_dn, false>(p, b, d, h, lq, lt, cn); }
            { const float4 sv = sv0;
              if (lq < 8) st4bf(TWb, lt, LD32, lq * 4, fast_tanh(sv.x), fast_tanh(sv.y), fast_tanh(sv.z), fast_tanh(sv.w));
              else st4bf(TAb, lt, LD32, (lq - 8) * 4, sv.x, sv.y, sv.z, sv.w); }
            __syncthreads();
            { const int mt = wid & 1, nt = wid >> 1;
              const bf16x8 aw = lds_frag(TWb, mt * 16 + fr, LD32, fq * 8), aa = lds_frag(TAb, mt * 16 + fr, LD32, fq * 8);
              const bf16x8 bw = lds_frag(WUT, nt * 16 + fr, LD32, fq * 8), ba = lds_frag(AUT, nt * 16 + fr, LD32, fq * 8);
              f32x4 cw = (f32x4){0.f, 0.f, 0.f, 0.f}, ca = cw;
              cw = __builtin_amdgcn_mfma_f32_16x16x32_bf16(bw, aw, cw, 0, 0, 0); ca = __builtin_amdgcn_mfma_f32_16x16x32_bf16(ba, aa, ca, 0, 0, 0);
              *(float4*)(LWP + (mt * 16 + fr) * 64 + nt * 16 + 4 * fq) = make_float4(cw[0], cw[1], cw[2], cw[3]);
              *(float4*)(APP + (mt * 16 + fr) * 64 + nt * 16 + 4 * fq) = make_float4(ca[0], ca[1], ca[2], ca[3]); }
            __syncthreads();
            float4 lwv = *(const float4*)(LWP + lt * 64 + lq * 4), apv = *(const float4*)(APP + lt * 64 + lq * 4);
            lwv.x += inv_w0.x; lwv.y += inv_w0.y; lwv.z += inv_w0.z; lwv.w += inv_w0.w; apv.x += inv_a0.x; apv.y += inv_a0.y; apv.z += inv_a0.z; apv.w += inv_a0.w;
            const float4 av = make_float4(sigm(apv.x), sigm(apv.y), sigm(apv.z), sigm(apv.w));
            *(float4*)(FLW + lt * 64 + lq * 4) = make_float4(-0.6065306597f * sigm(lwv.x), -0.6065306597f * sigm(lwv.y), -0.6065306597f * sigm(lwv.z), -0.6065306597f * sigm(lwv.w));
            *(float4*)(FR + lt * 64 + lq * 4) = rs4;
            *(float4*)(FV + lt * 64 + lq * 4) = vs4;
            const float4 ks = ks4;
            float4 kk = make_float4(ks.x * inv_kk.x, ks.y * inv_kk.y, ks.z * inv_kk.z, ks.w * inv_kk.w);
            float ssq = (kk.x * kk.x + kk.y * kk.y) + (kk.z * kk.z + kk.w * kk.w);
            ssq += __shfl_xor(ssq, 1); ssq += __shfl_xor(ssq, 2); ssq += __shfl_xor(ssq, 4); ssq += __shfl_xor(ssq, 8);
            const float rn = rsq_fast(ssq + 1e-6f);
            kk.x *= rn; kk.y *= rn; kk.z *= rn; kk.w *= rn;
            *(float4*)(FKK + lt * 64 + lq * 4) = kk;
            *(float4*)(FB + lt * 64 + lq * 4) = make_float4(kk.x * av.x, kk.y * av.y, kk.z * av.z, kk.w * av.w);
            *(float4*)(FKW + lt * 64 + lq * 4) = make_float4(ks.x * (1.f + (av.x - 1.f) * inv_ka.x), ks.y * (1.f + (av.y - 1.f) * inv_ka.y), ks.z * (1.f + (av.z - 1.f) * inv_ka.z), ks.w * (1.f + (av.w - 1.f) * inv_ka.w));
        } else {
            float u[3][4]; float sq = 0.f, sk = 0.f;
            const float al_raw = cur.al, be_raw = cur.be;
#pragma unroll
            for (int s3 = 0; s3 < 3; ++s3) { float a0 = 0.f, a1 = 0.f, a2 = 0.f, a3 = 0.f;
#pragma unroll
                for (int tap = 0; tap < 5; ++tap) { const float4 cw = *(const float4*)(CWL + (s3 * 5 + tap) * 64 + lq * 4); const uint2 x = cur.xv[s3][tap];
                    a0 += cw.x * lo2f(x.x); a1 += cw.y * hi2f(x.x); a2 += cw.z * lo2f(x.y); a3 += cw.w * hi2f(x.y); }
                u[s3][0] = a0; u[s3][1] = a1; u[s3][2] = a2; u[s3][3] = a3; }
            asm volatile("" : "+v"(u[0][0]), "+v"(u[0][1]), "+v"(u[0][2]), "+v"(u[0][3]), "+v"(u[1][0]), "+v"(u[1][1]), "+v"(u[1][2]), "+v"(u[1][3]), "+v"(u[2][0]), "+v"(u[2][1]), "+v"(u[2][2]), "+v"(u[2][3]));
            if (ch + 1 < NCH) { const int cn = ch + 1; if (cn == 7 || cn == 8 || cn == NCH - 1) cur = load_raw_chunk<is_dn, true>(p, b, d, h, lq, lt, cn); else cur = load_raw_chunk<is_dn, false>(p, b, d, h, lq, lt, cn); }
#pragma unroll
            for (int s3 = 0; s3 < 3; ++s3)
#pragma unroll
                for (int i = 0; i < 4; ++i) u[s3][i] = silu_(u[s3][i]);
#pragma unroll
            for (int i = 0; i < 4; ++i) { sq += u[0][i] * u[0][i]; sk += u[1][i] * u[1][i]; }
            sq += __shfl_xor(sq, 1); sq += __shfl_xor(sq, 2); sq += __shfl_xor(sq, 4); sq += __shfl_xor(sq, 8);
            sk += __shfl_xor(sk, 1); sk += __shfl_xor(sk, 2); sk += __shfl_xor(sk, 4); sk += __shfl_xor(sk, 8);
            const float qn = rsq_fast(sq + 1e-6f) * 0.125f, kn = rsq_fast(sk + 1e-6f);
            const float la = -dn_A * softplus_(al_raw + dn_dtb), a = __expf(la), beta = sigm(be_raw);
#pragma unroll
            for (int i = 0; i < 4; ++i) u[1][i] *= kn;
            {
                unsigned char* pkd = smem + P_PK + (ch & 1) * PKG_BYTES; const float ab = a * beta;
                st4bf(pkd + K_QK, lt, LD64, lq * 4, u[1][0], u[1][1], u[1][2], u[1][3]);
                st4bf(pkd + K_RQ, lt, LD64, lq * 4, u[0][0] * qn, u[0][1] * qn, u[0][2] * qn, u[0][3] * qn);
                st4bf(pkd + K_BH, lt, LD64, lq * 4, ab * u[1][0], ab * u[1][1], ab * u[1][2], ab * u[1][3]);
                st4bf(pkd + K_KH, lt, LD64, lq * 4, beta * u[1][0], beta * u[1][1], beta * u[1][2], beta * u[1][3]);
                st4bf(pkd + K_V, lt, 64, lq * 4, u[2][0], u[2][1], u[2][2], u[2][3]);
                if (lq == 0) CS[lt] = la; }
        }
        asm volatile("s_waitcnt vmcnt(0)" ::: "memory");
        __syncthreads();
        if (tid == 0 && ch > 0) __hip_atomic_store(fl, (unsigned)ch, __ATOMIC_RELAXED, __HIP_MEMORY_SCOPE_AGENT);
        unsigned char* pkc = is_dn ? smem + P_PK + (ch & 1) * PKG_BYTES : smem + P_PK;
        if (is_dn) {
            if (wid == 0) { const float lav = CS[lane & 31]; float x = lane < 32 ? lav : 0.f;
#pragma unroll
                for (int o = 1; o < 32; o <<= 1) { const float y = __shfl_up(x, o); if (lane >= o) x += y; }
                const float tot = __shfl(x, 31);
                if (lane < 32) { ((float*)(pkc + K_GM))[lane] = x - lav; ((float*)(pkc + K_GG))[lane] = x; }
                ((float*)(pkc + K_PT))[lane] = __expf(tot); }
            __syncthreads();
        } else {
        const int k = tid & 63, tg = tid >> 6, t0 = tg * 4;
        float c0 = FLW[(t0 + 0) * 64 + k], c1 = c0 + FLW[(t0 + 1) * 64 + k], c2 = c1 + FLW[(t0 + 2) * 64 + k], c3 = c2 + FLW[(t0 + 3) * 64 + k];
        CS[tg * 64 + k] = c3;
        __syncthreads();
        {
            float off = 0.f, tot = 0.f;
#pragma unroll
            for (int g2 = 0; g2 < 8; ++g2) { const float s = CS[g2 * 64 + k]; tot += s; if (g2 < tg) off += s; }
            const float cum[4] = {off + c0, off + c1, off + c2, off + c3}; const float cumm[4] = {off, off + c0, off + c1, off + c2};
            float qk[4], bt[4], kt[4], vv[4]; float ecp = 0.f;
#pragma unroll
            for (int j = 0; j < 4; ++j) { const int t = t0 + j; const float kkv = FKK[t * 64 + k], bv = FB[t * 64 + k], kwv = FKW[t * 64 + k], rv = FR[t * 64 + k];
                const float em = j == 0 ? __expf(cumm[0]) : ecp, ec = __expf(cum[j]), ee = __expf(tot - cum[j]); ecp = ec;
                vv[j] = FV[t * 64 + k]; qk[j] = kkv * em; bt[j] = bv * ee; kt[j] = kwv * ee;
                if (!is_dn) { const float ei = __expf(-cum[j]);
                    ((bf16_t*)(pk + K_QK))[t * LD64 + k] = f2bf(kkv * em); ((bf16_t*)(pk + K_RQ))[t * LD64 + k] = f2bf(rv * ec);
                    ((bf16_t*)(pk + K_BH))[t * LD64 + k] = f2bf(bv * ei); ((bf16_t*)(pk + K_KH))[t * LD64 + k] = f2bf(kwv * ei);
                } else {
                    ((bf16_t*)(pk + K_QK))[t * LD64 + k] = f2bf(kkv); ((bf16_t*)(pk + K_RQ))[t * LD64 + k] = f2bf(rv);
                    ((bf16_t*)(pk + K_BH))[t * LD64 + k] = f2bf(bv); ((bf16_t*)(pk + K_KH))[t * LD64 + k] = f2bf(kwv);
                    if (k == 0) { GM[t] = cumm[j]; GG[t] = cum[j]; }
                } }
#pragma unroll
            for (int j = 0; j < 4; ++j) ((bf16_t*)(pk + K_V))[(t0 + j) * 64 + k] = f2bf(vv[j]);
            (void)qk; (void)bt; (void)kt;
            if (tg == 0) PT[k] = __expf(tot);
        }
        __syncthreads();
        }
        if (ch >= RING_R) ring_wait(fl + 16, (unsigned)(ch - RING_R + 1), cons_seen, p.ctl() + CW_BAR);
        { const unsigned so = (unsigned)(ch & (RING_R - 1)) * (unsigned)PKG_BYTES;
#pragma unroll
          for (int r = 0; r < 3; ++r) { const int o = (r * NTHR + tid) * 16;
              { const pg8::u32x4 v = *(const pg8::u32x4*)(pkc + o); __builtin_amdgcn_raw_buffer_store_b128(v, ring_rs, so + (unsigned)o, 0, 16); } } }
    }
    asm volatile("s_waitcnt vmcnt(0)" ::: "memory");
    __syncthreads();
    if (tid == 0) __hip_atomic_store(fl, (unsigned)NCH, __ATOMIC_RELAXED, __HIP_MEMORY_SCOPE_AGENT);
}

template <bool is_dn>
__device__ __forceinline__ void scan_consumer(const P& p, int layer, int chain, unsigned char* smem) {
    const int d = chain & 1, h = (chain >> 1) & 3, b = chain >> 3;
    const int tid = p.tid(), lane = tid & 63, wid = tid >> 6, fr = lane & 15, fq = lane >> 4;
    float* AAB = (float*)(smem + O_AAB);
    const int cg = (is_dn ? 64 : 0) + chain;
    unsigned* fl = p.ctl() + CW_RING + (layer * 128 + cg) * 32;
    const unsigned char* ring = (const unsigned char*)p.Y() + (size_t)cg * RING_R * PKG_BYTES;
    PG8_LAS unsigned char* sl = (PG8_LAS unsigned char*)smem;
    bf16_t* yout = p.YS() + (size_t)((is_dn ? 2 : 0) + d) * RT * 256;
    f32x4 Sacc[2]; Sacc[0] = (f32x4){0.f, 0.f, 0.f, 0.f}; Sacc[1] = Sacc[0];
    for (int i = tid; i < 2 * 9216 / 4; i += NTHR) ((unsigned*)(smem + C_S0))[i] = 0u;
    constexpr int NCH = (L + LC) / CT;
    unsigned prod_seen = 0u;
#define RING_DMA1(gptr, ldsaddr) do { unsigned m0s_; asm volatile("s_mov_b32 %0, m0\n\ts_mov_b32 m0, %2\n\ts_nop 0\n\tglobal_load_lds_dwordx4 %1, off sc1\n\ts_mov_b32 m0, %0" : "=&s"(m0s_) : "v"(gptr), "s"(ldsaddr) : "memory"); } while (0)
#define RING_DMA(c) do { ring_wait(fl, (unsigned)((c) + 1), prod_seen, p.ctl() + CW_BAR); \
        const unsigned char* src_ = ring + (size_t)((c) & (RING_R - 1)) * PKG_BYTES + wid * 1024 + lane * 16; \
        const unsigned dst_ = __builtin_amdgcn_readfirstlane((unsigned)(size_t)(sl + C_PKG + ((c) & 1) * PKG_BYTES + wid * 1024)); \
        _Pragma("unroll") for (int r_ = 0; r_ < 3; ++r_) RING_DMA1(src_ + r_ * 8192, dst_ + (unsigned)(r_ * 8192)); } while (0)
    RING_DMA(0);
    unsigned early_flag = 0u;
    asm volatile("s_waitcnt vmcnt(0)" ::: "memory");
    __syncthreads();
    if (tid == 0) __hip_atomic_store(fl + 16, 1u, __ATOMIC_RELAXED, __HIP_MEMORY_SCOPE_AGENT);
#pragma unroll 1
    for (int ch = 0; ch < NCH; ++ch) {
        const unsigned char* pk = smem + C_PKG + (ch & 1) * PKG_BYTES;
        { const unsigned ef = __builtin_amdgcn_readfirstlane(early_flag); prod_seen = ef > prod_seen ? ef : prod_seen; }
        if (ch + 1 < NCH) RING_DMA(ch + 1);
#define GRAM_TILE(MI, HF, NT) do { const int mi_ = (MI), hf_ = (HF), nt_ = (NT); \
            const unsigned char* Ab_ = pk + (mi_ < 2 ? K_QK : K_RQ); const unsigned char* Bb_ = pk + ((mi_ & 1) ? K_KH : K_BH); \
            f32x4 ga_ = (f32x4){0.f, 0.f, 0.f, 0.f}; \
            _Pragma("unroll") for (int ks = 0; ks < 2; ++ks) ga_ = __builtin_amdgcn_mfma_f32_16x16x32_bf16(lds_frag(Bb_, nt_ * 16 + fr, LD64, ks * 32 + fq * 8), lds_frag(Ab_, hf_ * 16 + fr, LD64, ks * 32 + fq * 8), ga_, 0, 0, 0); \
            const int t_ = hf_ * 16 + fr; const float* GM_ = (const float*)(pk + K_GM); const float* GG_ = (const float*)(pk + K_GG); const float gt_ = is_dn ? (mi_ < 2 ? GM_[t_] : GG_[t_]) : 0.f; \
            float o_[4]; \
            _Pragma("unroll") for (int j = 0; j < 4; ++j) { const int i_ = nt_ * 16 + 4 * fq + j; const bool keep_ = mi_ < 2 ? (i_ < t_) : (i_ <= t_); float val_ = keep_ ? ga_[j] : 0.f; \
                if (is_dn && keep_) val_ *= __expf(gt_ - GG_[i_]); o_[j] = val_; } \
            const int i0_ = nt_ * 16 + 4 * fq; \
            if (mi_ == 0) *(float4*)(AAB + t_ * 36 + i0_) = make_float4(o_[0], o_[1], o_[2], o_[3]); \
            else st4bf(smem + (mi_ == 1 ? O_AAK : (mi_ == 2 ? O_ARB : O_ARK)), t_, LD32, i0_, o_[0], o_[1], o_[2], o_[3]); } while (0)
        if (wid < 4) GRAM_TILE(0, wid & 1, wid >> 1);
        __syncthreads();
        if (wid == 0) {
            bf16_t* TINV = (bf16_t*)(smem + O_TINV); bf16_t* TINVT = (bf16_t*)(smem + O_TINVT); bf16_t* M1T = (bf16_t*)(smem + O_M1T);
            if (lane < 32) { const int blk = lane >> 4, j = lane & 15; float x[16];
#pragma unroll
                for (int t = 0; t < 16; ++t) { float s = (t == j) ? 1.f : 0.f, s2 = 0.f; const float* rowp = AAB + (blk * 16 + t) * 36 + blk * 16;
                    float rv[16];
#pragma unroll
                    for (int i4 = 0; i4 < 16; i4 += 4) if (i4 < t) { const float4 q4 = *(const float4*)(rowp + i4); rv[i4] = q4.x; rv[i4 + 1] = q4.y; rv[i4 + 2] = q4.z; rv[i4 + 3] = q4.w; }
#pragma unroll
                    for (int i = 0; i < t; ++i) { if (i & 1) s2 -= rv[i] * x[i]; else s -= rv[i] * x[i]; }
                    x[t] = s + s2; }
#pragma unroll
                for (int t = 0; t < 16; ++t) TINV[(blk * 16 + t) * LD32 + blk * 16 + j] = f2bf(x[t]);
                if (blk == 0) {
#pragma unroll
                    for (int t = 0; t < 16; t += 4) st4bf(smem + O_TINVT, j, LD32, t, x[t], x[t + 1], x[t + 2], x[t + 3]); }
            } else { const int r = lane - 32;
#pragma unroll
                for (int t = 0; t < 16; t += 4) if (r < 16) st4bf(smem + O_TINV, r, LD32, 16 + t, 0.f, 0.f, 0.f, 0.f); }
            asm volatile("s_waitcnt lgkmcnt(0)" ::: "memory");
            bf16x8 af, bfv; const bf16x8 zf = {0, 0, 0, 0, 0, 0, 0, 0};
            if (fq < 2) { const float* lp = AAB + (16 + fr) * 36 + fq * 8; uint4 w; w.x = pack2(lp[0], lp[1]); w.y = pack2(lp[2], lp[3]); w.z = pack2(lp[4], lp[5]); w.w = pack2(lp[6], lp[7]); af = __builtin_bit_cast(bf16x8, w);
                bfv = lds_frag(smem + O_TINVT, fr, LD32, fq * 8); } else { af = zf; bfv = zf; }
            f32x4 m1 = (f32x4){0.f, 0.f, 0.f, 0.f};
            m1 = __builtin_amdgcn_mfma_f32_16x16x32_bf16(bfv, af, m1, 0, 0, 0);
#pragma unroll
            for (int j = 0; j < 4; ++j) M1T[(4 * fq + j) * LD32 + fr] = f2bf(m1[j]);
            asm volatile("s_waitcnt lgkmcnt(0)" ::: "memory");
            if (fq < 2) { af = lds_frag(smem + O_TINV, 16 + fr, LD32, 16 + fq * 8); bfv = lds_frag(smem + O_M1T, fr, LD32, fq * 8); } else { af = zf; bfv = zf; }
            f32x4 x21 = (f32x4){0.f, 0.f, 0.f, 0.f};
            x21 = __builtin_amdgcn_mfma_f32_16x16x32_bf16(bfv, af, x21, 0, 0, 0);
            st4bf(smem + O_TINV, 16 + fr, LD32, 4 * fq, -x21[0], -x21[1], -x21[2], -x21[3]);
        } else {
#define T_STAGE_BODY
            for (int rep_ = 0; rep_ < (wid == 1 ? 2 : 1); ++rep_) { const int TG_ = rep_ == 0 ? wid : 0;
        {
            const int k = tid & 63, t0 = TG_ * 4;
            const bf16_t* QKr = (const bf16_t*)(pk + K_QK); const bf16_t* BHr = (const bf16_t*)(pk + K_BH); const bf16_t* KHr = (const bf16_t*)(pk + K_KH); const bf16_t* Vr = (const bf16_t*)(pk + K_V);
            float q4[4], b4[4], k4[4], v4[4];
            if (!is_dn) { const float pt = ((const float*)(pk + K_PT))[k];
#pragma unroll
                for (int j = 0; j < 4; ++j) { const int t = t0 + j; q4[j] = bf2f(QKr[t * LD64 + k]); b4[j] = bf2f(BHr[t * LD64 + k]) * pt; k4[j] = bf2f(KHr[t * LD64 + k]) * pt; v4[j] = bf2f(Vr[t * 64 + k]); }
            } else { const float* GMr = (const float*)(pk + K_GM); const float* GGr = (const float*)(pk + K_GG); const float tot = GGr[31];
#pragma unroll
                for (int j = 0; j < 4; ++j) { const int t = t0 + j; const float em = __expf(GMr[t]), ee = __expf(tot - GGr[t]);
                    q4[j] = bf2f(QKr[t * LD64 + k]) * em; b4[j] = bf2f(BHr[t * LD64 + k]) * ee; k4[j] = bf2f(KHr[t * LD64 + k]) * ee; v4[j] = bf2f(Vr[t * 64 + k]); }
            }
            st4bf(smem + C_T + T_QKT, k, LD32, t0, q4[0], q4[1], q4[2], q4[3]); st4bf(smem + C_T + T_BT, k, LD32, t0, b4[0], b4[1], b4[2], b4[3]);
            st4bf(smem + C_T + T_KT, k, LD32, t0, k4[0], k4[1], k4[2], k4[3]); st4bf(smem + C_T + T_VT, k, LD32, t0, v4[0], v4[1], v4[2], v4[3]);
        }
            }
#undef T_STAGE_BODY
            if (wid >= 2) {
#pragma unroll 1
                for (int q_ = 0; q_ < 2; ++q_) { const int tl_ = (wid - 2) * 2 + q_; GRAM_TILE(1 + (tl_ >> 2), (tl_ >> 1) & 1, tl_ & 1); } }
        }
        __syncthreads();
        {
            const int mt = wid & 3, nt = wid >> 2;
            { const bf16x8 af = lds_frag(smem + C_T + T_QKT, mt * 16 + fr, LD32, fq * 8), bfv = lds_frag(smem + O_TINV, nt * 16 + fr, LD32, fq * 8);
              f32x4 acc = (f32x4){0.f, 0.f, 0.f, 0.f}; acc = __builtin_amdgcn_mfma_f32_16x16x32_bf16(bfv, af, acc, 0, 0, 0);
              st4bf(smem + O_WT, mt * 16 + fr, LD32, nt * 16 + 4 * fq, acc[0], acc[1], acc[2], acc[3]); }
            { const bf16x8 af = lds_frag(smem + C_T + T_VT, mt * 16 + fr, LD32, fq * 8), bfv = lds_frag(smem + O_AAK, nt * 16 + fr, LD32, fq * 8);
              f32x4 acc = (f32x4){0.f, 0.f, 0.f, 0.f}; acc = __builtin_amdgcn_mfma_f32_16x16x32_bf16(bfv, af, acc, 0, 0, 0);
              st4bf(smem + O_AVT, mt * 16 + fr, LD32, nt * 16 + 4 * fq, acc[0], acc[1], acc[2], acc[3]); }
        }
        __syncthreads();
        {
            { const int mt = wid & 3, nt = wid >> 2;
              const bf16x8 af = lds_frag(smem + O_AVT, mt * 16 + fr, LD32, fq * 8), bfv = lds_frag(smem + O_TINV, nt * 16 + fr, LD32, fq * 8);
              f32x4 acc = (f32x4){0.f, 0.f, 0.f, 0.f}; acc = __builtin_amdgcn_mfma_f32_16x16x32_bf16(bfv, af, acc, 0, 0, 0);
              st4bf(smem + O_U0T, mt * 16 + fr, LD32, nt * 16 + 4 * fq, -acc[0], -acc[1], -acc[2], -acc[3]); }
            { const int mt = wid & 1, nt = wid >> 1;
              const bf16x8 af = lds_frag(smem + O_ARB, mt * 16 + fr, LD32, fq * 8), bfv = lds_frag(smem + O_WT, nt * 16 + fr, LD32, fq * 8);
              f32x4 acc = (f32x4){0.f, 0.f, 0.f, 0.f}; acc = __builtin_amdgcn_mfma_f32_16x16x32_bf16(bfv, af, acc, 0, 0, 0);
              const int t = mt * 16 + fr, k0 = nt * 16 + 4 * fq; const uint2 rq2 = *(const uint2*)(pk + K_RQ + (t * LD64 + k0) * 2); const float rsc = is_dn ? __expf(((const float*)(pk + K_GG))[t]) : 1.f;
              const float4 rq = make_float4(lo2f(rq2.x) * rsc, hi2f(rq2.x) * rsc, lo2f(rq2.y) * rsc, hi2f(rq2.y) * rsc);
              st4bf(smem + O_REFF, t, LD64, k0, rq.x - acc[0], rq.y - acc[1], rq.z - acc[2], rq.w - acc[3]); }
#pragma unroll
            for (int j2 = 0; j2 < 2; ++j2) { const int mt = wid & 3, nt = (wid >> 2) * 2 + j2;
              const bf16x8 af = lds_frag(smem + C_T + T_BT, mt * 16 + fr, LD32, fq * 8), bfv = lds_frag(smem + O_WT, nt * 16 + fr, LD32, fq * 8);
              f32x4 acc = (f32x4){0.f, 0.f, 0.f, 0.f}; acc = __builtin_amdgcn_mfma_f32_16x16x32_bf16(bfv, af, acc, 0, 0, 0);
              st4bf(smem + O_MC, mt * 16 + fr, LD64, nt * 16 + 4 * fq, -acc[0], -acc[1], -acc[2], -acc[3]); }
        }
        asm volatile("s_waitcnt vmcnt(0)" ::: "memory");
        __syncthreads();
        if (tid == 0 && ch + 1 < NCH) __hip_atomic_store(fl + 16, (unsigned)(ch + 2), __ATOMIC_RELAXED, __HIP_MEMORY_SCOPE_AGENT);
        early_flag = xb_ld(fl);
        {
            const unsigned char* S0c = smem + C_S0 + (ch & 1) * 9216; unsigned char* S0n = smem + C_S0 + ((ch + 1) & 1) * 9216;
            { const int mt = wid & 1, nt = wid >> 1;
              f32x4 acc = (f32x4){0.f, 0.f, 0.f, 0.f};
#pragma unroll
              for (int ks = 0; ks < 2; ++ks) acc = __builtin_amdgcn_mfma_f32_16x16x32_bf16(lds_frag(S0c, nt * 16 + fr, LD64, ks * 32 + fq * 8), lds_frag(smem + O_REFF, mt * 16 + fr, LD64, ks * 32 + fq * 8), acc, 0, 0, 0);
              acc = __builtin_amdgcn_mfma_f32_16x16x32_bf16(lds_frag(smem + O_U0T, nt * 16 + fr, LD32, fq * 8), lds_frag(smem + O_ARB, mt * 16 + fr, LD32, fq * 8), acc, 0, 0, 0);
              acc = __builtin_amdgcn_mfma_f32_16x16x32_bf16(lds_frag(smem + C_T + T_VT, nt * 16 + fr, LD32, fq * 8), lds_frag(smem + O_ARK, mt * 16 + fr, LD32, fq * 8), acc, 0, 0, 0);
              int yb, yl, ylen; scan_pos(b, d, ch * CT + mt * 16 + fr, yb, yl, ylen);
              uint2 o; o.x = pack2(acc[0], acc[1]); o.y = pack2(acc[2], acc[3]);
              *(uint2*)(yout + (size_t)(yb + yl) * 256 + h * 64 + nt * 16 + 4 * fq) = o; }
#pragma unroll
            for (int j2 = 0; j2 < 2; ++j2) { const int mt = wid & 3, nt = (wid >> 2) * 2 + j2;
              const float4 pt = *(const float4*)(pk + K_PT + (nt * 16 + 4 * fq) * 4);
              f32x4 acc = Sacc[j2]; acc[0] *= pt.x; acc[1] *= pt.y; acc[2] *= pt.z; acc[3] *= pt.w;
#pragma unroll
              for (int ks = 0; ks < 2; ++ks) acc = __builtin_amdgcn_mfma_f32_16x16x32_bf16(lds_frag(smem + O_MC, nt * 16 + fr, LD64, ks * 32 + fq * 8), lds_frag(S0c, mt * 16 + fr, LD64, ks * 32 + fq * 8), acc, 0, 0, 0);
              acc = __builtin_amdgcn_mfma_f32_16x16x32_bf16(lds_frag(smem + C_T + T_BT, nt * 16 + fr, LD32, fq * 8), lds_frag(smem + O_U0T, mt * 16 + fr, LD32, fq * 8), acc, 0, 0, 0);
              acc = __builtin_amdgcn_mfma_f32_16x16x32_bf16(lds_frag(smem + C_T + T_KT, nt * 16 + fr, LD32, fq * 8), lds_frag(smem + C_T + T_VT, mt * 16 + fr, LD32, fq * 8), acc, 0, 0, 0);
              Sacc[j2] = acc;
              st4bf(S0n, mt * 16 + fr, LD64, nt * 16 + 4 * fq, acc[0], acc[1], acc[2], acc[3]); }
        }
        __syncthreads();
    }
}
#undef RING_DMA
#undef GRAM_TILE
#undef RING_DMA1

__device__ __forceinline__ void s5_state_scan(const P& p, int layer) {
    if (p.bid() >= 32) return;
    const int pr = p.bid() * 4 + (p.wid() >> 1), b = pr >> 4, g = pr & 15, d = p.wid() & 1, pp = p.lane();
    float2 lam = p.LAMB()[((size_t)(layer * 2 + d) * 16 + g) * 64 + pp];
#pragma unroll
    for (int k = 0; k < 4; ++k) lam = make_float2(lam.x * lam.x - lam.y * lam.y, 2.f * lam.x * lam.y);
    float sr = 0.f, si = 0.f;
    const size_t rb = (size_t)g * S5ROWS + (size_t)b * 272;
    bf16_t* ac = p.AC() + 256 + 2 * (d * 64 + pp); const bf16_t* vv = p.V() + 2 * (d * 64 + pp);
#pragma unroll 1
    for (int bt = 0; bt < 4; ++bt) {
        unsigned vreg[68];
#pragma unroll
        for (int i = 0; i < 68; ++i) { const int st = bt * 68 + i; const int cf = d == 0 ? st : (st < 16 ? 15 - st : 287 - st);
            vreg[i] = *(const unsigned*)(vv + (rb + cf) * 256); }
        asm volatile("" ::: "memory");
#pragma unroll
        for (int i = 0; i < 68; ++i) { const int st = bt * 68 + i; const int cf = d == 0 ? st : (st < 16 ? 15 - st : 287 - st);
            __hip_atomic_store((unsigned*)(ac + (rb + cf) * 512), pack2(sr, si), __ATOMIC_RELAXED, __HIP_MEMORY_SCOPE_AGENT);
            const unsigned v = vreg[i];
            const float nr = lam.x * sr - lam.y * si + lo2f(v), ni = lam.x * si + lam.y * sr + hi2f(v);
            sr = nr; si = ni; }
    }
}

__device__ __forceinline__ void fourier_a_init(const P& p, unsigned char* smem) {
    bf16_t* DA = (bf16_t*)smem;
    for (int i = p.tid(); i < 64 * 64; i += NTHR) { const int q2 = i >> 6, pp = i & 63; float s, c; sincospif(2.f * (float)((q2 * pp) & 63) / 64.f, &s, &c);
        *(unsigned*)(DA + q2 * 136 + 2 * pp) = pack2(c, -s); *(unsigned*)(DA + (64 + q2) * 136 + 2 * pp) = pack2(-s, -c); }
    __syncthreads();
}
__device__ __forceinline__ void fourier_a(const P& p, int item, unsigned char* smem) {
    unsigned char* DAb = smem; unsigned char* DTb = smem + 34816; bf16_t* DT = (bf16_t*)DTb;
    const int chb = item & 3, q = (item >> 2) & 63, b = item >> 8;
    const int lane = p.lane(), wid = p.wid(), fr = lane & 15, fq = lane >> 4;
    { const int pp = p.tid() >> 3, c8 = (p.tid() & 7) * 8; const size_t row = (size_t)b * L + 64 * pp + q;
      const uint4 a = *(const uint4*)(p.PM() + row * NP + PC_FC + chb * 64 + c8), s = *(const uint4*)(p.PM() + row * NP + PC_FS + chb * 64 + c8);
      const unsigned av[4] = {a.x, a.y, a.z, a.w}, sv[4] = {s.x, s.y, s.z, s.w};
#pragma unroll
      for (int j = 0; j < 4; ++j) {
          *(unsigned*)(DT + (c8 + 2 * j) * 136 + 2 * pp) = (av[j] & 0xFFFFu) | (sv[j] << 16);
          *(unsigned*)(DT + (c8 + 2 * j + 1) * 136 + 2 * pp) = (av[j] >> 16) | (sv[j] & 0xFFFF0000u); } }
    __syncthreads();
    const int mt = wid & 3, q2 = mt * 16 + fr;
    float sn, cs; sincospif(2.f * (float)(q * q2) / 4096.f, &sn, &cs);
#pragma unroll
    for (int j2 = 0; j2 < 2; ++j2) { const int nt = (wid >> 2) * 2 + j2;
        f32x4 ar = (f32x4){0.f, 0.f, 0.f, 0.f}, ai = ar;
#pragma unroll
        for (int ks = 0; ks < 4; ++ks) { const bf16x8 bfv = lds_frag(DTb, nt * 16 + fr, 136, ks * 32 + fq * 8);
            ar = __builtin_amdgcn_mfma_f32_16x16x32_bf16(bfv, lds_frag(DAb, mt * 16 + fr, 136, ks * 32 + fq * 8), ar, 0, 0, 0);
            ai = __builtin_amdgcn_mfma_f32_16x16x32_bf16(bfv, lds_frag(DAb, 64 + mt * 16 + fr, 136, ks * 32 + fq * 8), ai, 0, 0, 0); }
        const size_t row = (size_t)b * L + 64 * q2 + q; const int c0 = chb * 64 + nt * 16 + 4 * fq;
        uint2 o; o.x = pack2(ar[0] * cs + ai[0] * sn, ar[1] * cs + ai[1] * sn); o.y = pack2(ar[2] * cs + ai[2] * sn, ar[3] * cs + ai[3] * sn);
        *(uint2*)(p.PM() + row * NP + PC_FC + c0) = o;
        o.x = pack2(ai[0] * cs - ar[0] * sn, ai[1] * cs - ar[1] * sn); o.y = pack2(ai[2] * cs - ar[2] * sn, ai[3] * cs - ar[3] * sn);
        *(uint2*)(p.PM() + row * NP + PC_FS + c0) = o; }
    __syncthreads();
}
__device__ __forceinline__ void fourier_b_init(const P& p, unsigned char* smem) {
    bf16_t* DM = (bf16_t*)smem;
    for (int i = p.tid(); i < 64 * 64; i += NTHR) { const int p2 = i >> 6, q = i & 63; float s, c; sincospif(2.f * (float)((p2 * q) & 63) / 64.f, &s, &c);
        *(unsigned*)(DM + p2 * 136 + 2 * q) = pack2(c, s); }
    __syncthreads();
}
__device__ __forceinline__ void fourier_b(const P& p, int item, unsigned char* smem) {
    unsigned char* DMb = smem; unsigned char* DTb = smem + 17408; bf16_t* DT = (bf16_t*)DTb;
    const int chb = item & 3, q2 = (item >> 2) & 63, b = item >> 8;
    const int lane = p.lane(), wid = p.wid(), fr = lane & 15, fq = lane >> 4;
    { const int q = p.tid() >> 3, c8 = (p.tid() & 7) * 8; const size_t row = (size_t)b * L + 64 * q2 + q;
      const uint4 a = *(const uint4*)(p.PM() + row * NP + PC_FC + chb * 64 + c8), s = *(const uint4*)(p.PM() + row * NP + PC_FS + chb * 64 + c8);
      const unsigned av[4] = {a.x, a.y, a.z, a.w}, sv[4] = {s.x, s.y, s.z, s.w};
#pragma unroll
      for (int j = 0; j < 4; ++j) {
          *(unsigned*)(DT + (c8 + 2 * j) * 136 + 2 * q) = (av[j] & 0xFFFFu) | (sv[j] << 16);
          *(unsigned*)(DT + (c8 + 2 * j + 1) * 136 + 2 * q) = (av[j] >> 16) | (sv[j] & 0xFFFF0000u); } }
    __syncthreads();
#pragma unroll
    for (int j2 = 0; j2 < 2; ++j2) { const int mt = wid & 3, nt = (wid >> 2) * 2 + j2;
        f32x4 acc = (f32x4){0.f, 0.f, 0.f, 0.f};
#pragma unroll
        for (int ks = 0; ks < 4; ++ks) acc = __builtin_amdgcn_mfma_f32_16x16x32_bf16(lds_frag(DTb, nt * 16 + fr, 136, ks * 32 + fq * 8), lds_frag(DMb, mt * 16 + fr, 136, ks * 32 + fq * 8), acc, 0, 0, 0);
        const size_t row = (size_t)b * L + 64 * (mt * 16 + fr) + q2; const float sc = 1.f / 512.f;
        uint2 o; o.x = pack2(acc[0] * sc, acc[1] * sc); o.y = pack2(acc[2] * sc, acc[3] * sc);
        *(uint2*)(p.Y() + row * D + chb * 64 + nt * 16 + 4 * fq) = o; }
    __syncthreads();
}
__device__ __forceinline__ void fourier_ctx(const P& p, int item, unsigned char* smem) {
    unsigned* twb = (unsigned*)smem;
    unsigned char* ZTb = smem + 1024; bf16_t* ZT = (bf16_t*)ZTb;
    constexpr int LDZ = 520;
    const int chb = item & 7, b = item >> 3;
    const int lane = p.lane(), wid = p.wid(), fr = lane & 15, fq = lane >> 4;
    if (p.tid() < 256) { float s, c; sincospif(2.f * p.tid() / 256.f, &s, &c); twb[p.tid()] = pack2(c, s); }
    for (int i = p.tid(); i < 256 * 4; i += NTHR) { const int l = i >> 2, c8 = (i & 3) * 8; const size_t row = (size_t)RL + b * LC + l;
        const uint4 a = *(const uint4*)(p.PM() + row * NP + PC_FC + chb * 32 + c8), s = *(const uint4*)(p.PM() + row * NP + PC_FS + chb * 32 + c8);
        const unsigned av[4] = {a.x, a.y, a.z, a.w}, sv[4] = {s.x ^ 0x80008000u, s.y ^ 0x80008000u, s.z ^ 0x80008000u, s.w ^ 0x80008000u};
#pragma unroll
        for (int j = 0; j < 4; ++j) { ZT[(c8 + 2 * j) * LDZ + l] = (bf16_t)(av[j] & 0xFFFFu); ZT[(c8 + 2 * j + 1) * LDZ + l] = (bf16_t)(av[j] >> 16);
            ZT[(c8 + 2 * j) * LDZ + 256 + l] = (bf16_t)(sv[j] & 0xFFFFu); ZT[(c8 + 2 * j + 1) * LDZ + 256 + l] = (bf16_t)(sv[j] >> 16); } }
    __syncthreads();
    f32x4 acc[2][2];
#pragma unroll
    for (int mi = 0; mi < 2; ++mi)
#pragma unroll
        for (int nt = 0; nt < 2; ++nt) acc[mi][nt] = (f32x4){0.f, 0.f, 0.f, 0.f};
#pragma unroll 2
    for (int ks = 0; ks < 16; ++ks) {
        const bf16x8 b0 = lds_frag(ZTb, fr, LDZ, ks * 32 + fq * 8), b1 = lds_frag(ZTb, 16 + fr, LDZ, ks * 32 + fq * 8);
        const int kb = (ks & 7) * 32 + fq * 8; const bool sn = ks >= 8;
#pragma unroll
        for (int mi = 0; mi < 2; ++mi) { const int l2 = (wid * 2 + mi) * 16 + fr;
            unsigned w[4];
#pragma unroll
            for (int j2 = 0; j2 < 4; ++j2) { const unsigned t0 = twb[((kb + 2 * j2) * l2) & 255], t1 = twb[((kb + 2 * j2 + 1) * l2) & 255];
                w[j2] = sn ? ((t0 >> 16) | (t1 & 0xFFFF0000u)) : ((t0 & 0xFFFFu) | (t1 << 16)); }
            uint4 wv; wv.x = w[0]; wv.y = w[1]; wv.z = w[2]; wv.w = w[3];
            const bf16x8 af = __builtin_bit_cast(bf16x8, wv);
            acc[mi][0] = __builtin_amdgcn_mfma_f32_16x16x32_bf16(b0, af, acc[mi][0], 0, 0, 0);
            acc[mi][1] = __builtin_amdgcn_mfma_f32_16x16x32_bf16(b1, af, acc[mi][1], 0, 0, 0); }
    }
#pragma unroll
    for (int mi = 0; mi < 2; ++mi)
#pragma unroll
        for (int nt = 0; nt < 2; ++nt) { const size_t row = (size_t)RL + b * LC + (wid * 2 + mi) * 16 + fr; const float sc = 1.f / 128.f;
            uint2 o; o.x = pack2(acc[mi][nt][0] * sc, acc[mi][nt][1] * sc); o.y = pack2(acc[mi][nt][2] * sc, acc[mi][nt][3] * sc);
            *(uint2*)(p.Y() + row * D + chb * 32 + nt * 16 + 4 * fq) = o; }
    __syncthreads();
}

__device__ __forceinline__ void phase_mixA(const P& p, int layer, unsigned char* smem) {
    if (p.bid() < 64) scan_consumer<false>(p, layer, p.bid(), smem);
    else if (p.bid() < 128) scan_consumer<true>(p, layer, p.bid() - 64, smem);
    else if (p.bid() < 192) scan_producer<false>(p, layer, p.bid() - 128, smem);
    else scan_producer<true>(p, layer, p.bid() - 192, smem);
    __syncthreads();
    {
        const int hb = (p.bid() + 128) & 255, nh = p.nblk();
        { pg8::Gemm g{p.AC(), p.S5GG() + (size_t)layer * 16 * 256 * 256, 512, 256, 256}; pg8::S5Order S; S.init(nh, hb, (size_t)256 * 256 * 2);
          EpiStoreBf16 E{p.V(), 256, 0, (size_t)S5ROWS * 256, nullptr};
          pg8::gemm_phase<EpiStoreBf16, pg8::S5Order>((PG8_LAS unsigned char*)smem, g, S, E); }
        __syncthreads();
        fourier_a_init(p, smem);
        if (hb < 128) { for (int it = hb * 10; it < hb * 10 + 10; ++it) fourier_a(p, it, smem); }
        else { for (int it = 1280 + (hb - 128) * 6; it < 1280 + (hb - 128) * 6 + 6; ++it) fourier_a(p, it, smem); }
        if (layer == 0) for (int it = hb; it < 64; it += nh) fourier_ctx(p, it, smem);
    }
}

__device__ __forceinline__ void phase_mixB(const P& p, int layer, unsigned char* smem) {
    const int nrows = layer == 0 ? RT : RL;
    unsigned* s5f = p.ctl() + CW_S5F + layer * 64;
    if (p.bid() < 32) {
        s5_state_scan(p, layer);
        asm volatile("s_waitcnt vmcnt(0)" ::: "memory");
        __syncthreads();
        if (p.tid() == 0) (void)xb_add(s5f, 1u);
    }
    __syncthreads();
    fourier_b_init(p, smem);
    for (int it = p.bid(); it < 2048; it += p.nblk()) fourier_b(p, it, smem);
    { pg8::Gemm g{p.AC(), p.S5TT() + (size_t)layer * 16 * 256 * 512, 512, 512, 512}; pg8::S5FlowOrder S; S.init(p.nblk(), p.bid(), (size_t)256 * 512 * 2); S.flag = s5f; S.bar = p.ctl() + CW_BAR;
      EpiS5Y E{p.PM(), p.s5_d() + layer * 256, layer == 0 ? 1 : 0};
      pg8::gemm_phase<EpiS5Y, pg8::S5FlowOrder>((PG8_LAS unsigned char*)smem, g, S, E); }
    __syncthreads();
    float* GU = (float*)smem;
    float* SG = GU + 64 * 256;
    for (int i = p.tid(); i < 64 * 256; i += NTHR) GU[i] = p.rw_g_up()[(size_t)layer * 64 * 256 + i];
    __syncthreads();
    int r_lo, r_hi;
    {
      const int N1 = 32, NA = 144, D1 = 22, EX = 83, c = p.bid(), G = p.nblk(); const int a = (nrows + N1 * D1 - (G - NA) * EX) / G, rem = nrows - (G * a - N1 * D1 + (G - NA) * EX);
      r_lo = c * a + (c < rem ? c : rem) - D1 * (c < N1 ? c : N1) + EX * (c > NA ? c - NA : 0);
      const int c1 = c + 1;
      r_hi = c1 * a + (c1 < rem ? c1 : rem) - D1 * (c1 < N1 ? c1 : N1) + EX * (c1 > NA ? c1 - NA : 0); }
    const float* mu = p.rw_mu() + (size_t)layer * 2 * 896;
    const bf16_t* Y0 = p.YS(); const bf16_t* Y1 = p.YS() + (size_t)RT * 256;
    const bf16_t* D0 = p.YS() + (size_t)2 * RT * 256; const bf16_t* D1 = p.YS() + (size_t)3 * RT * 256;
#pragma unroll 2
    for (int r = r_lo + p.wid(); r < r_hi; r += 8) {
        int base, l, len;
        if (r < RL) { base = (r >> 12) << 12; l = r & 4095; len = L; } else { const int rr = r - RL; base = RL + ((rr >> 8) << 8); l = rr & 255; len = LC; }
        const int c0 = p.lane() * 4, hh = p.lane() >> 4;
        { SG[p.wid() * 64 + p.lane()] = sigm(rw_shift(p, mu, base, l, len, 832 + p.lane()));
          const uint2 a = *(const uint2*)(Y0 + (size_t)r * 256 + c0), bq = *(const uint2*)(Y1 + (size_t)r * 256 + c0);
          float y[4] = {lo2f(a.x) + lo2f(bq.x), hi2f(a.x) + hi2f(bq.x), lo2f(a.y) + lo2f(bq.y), hi2f(a.y) + hi2f(bq.y)};
          float sm = (y[0] + y[1]) + (y[2] + y[3]);
          sm += __shfl_xor(sm, 1); sm += __shfl_xor(sm, 2); sm += __shfl_xor(sm, 4); sm += __shfl_xor(sm, 8);
          const float mean = sm * (1.f / 64.f);
          float vq = 0.f;
#pragma unroll
          for (int i = 0; i < 4; ++i) { const float dd = y[i] - mean; vq += dd * dd; }
          vq += __shfl_xor(vq, 1); vq += __shfl_xor(vq, 2); vq += __shfl_xor(vq, 4); vq += __shfl_xor(vq, 8);
          const float rstd = rsq_fast(vq * (1.f / 64.f) + 64e-5f);
          float rs[4], ks[4], vs[4], bsum = 0.f;
          { const Raw3 xr_ = rw_raw3(p, base, l, len, c0); const float4 r4 = rw_mix(xr_, *(const float4*)(mu + c0), *(const float4*)(mu + 896 + c0));
            asm volatile("" ::: "memory");
            const Raw3 xk_ = rw_raw3(p, base, l, len, 256 + c0); const float4 k4 = rw_mix(xk_, *(const float4*)(mu + 256 + c0), *(const float4*)(mu + 896 + 256 + c0));
            asm volatile("" ::: "memory");
            const Raw3 xv_ = rw_raw3(p, base, l, len, 512 + c0); const float4 v4 = rw_mix(xv_, *(const float4*)(mu + 512 + c0), *(const float4*)(mu + 896 + 512 + c0));
            const float4 rk4 = *(const float4*)(p.rw_r_k() + layer * 256 + c0);
            rs[0] = r4.x; rs[1] = r4.y; rs[2] = r4.z; rs[3] = r4.w; ks[0] = k4.x; ks[1] = k4.y; ks[2] = k4.z; ks[3] = k4.w; vs[0] = v4.x; vs[1] = v4.y; vs[2] = v4.z; vs[3] = v4.w;
            bsum = (rs[0] * ks[0] * rk4.x + rs[1] * ks[1] * rk4.y) + (rs[2] * ks[2] * rk4.z + rs[3] * ks[3] * rk4.w); }
          bsum += __shfl_xor(bsum, 1); bsum += __shfl_xor(bsum, 2); bsum += __shfl_xor(bsum, 4); bsum += __shfl_xor(bsum, 8);
          float g[4] = {0.f, 0.f, 0.f, 0.f};
          for (int i2 = 0; i2 < 64; ++i2) { const float sg = SG[p.wid() * 64 + i2]; const float4 gu = *(const float4*)(GU + i2 * 256 + c0);
              g[0] += sg * gu.x; g[1] += sg * gu.y; g[2] += sg * gu.z; g[3] += sg * gu.w; }
          float o[4];
#pragma unroll
          for (int i = 0; i < 4; ++i) { const int c = c0 + i; const float yn = (y[i] - mean) * rstd * p.rw_ln_g()[layer * 256 + c] + p.rw_ln_b()[layer * 256 + c];
              o[i] = (yn + bsum * vs[i]) * g[i]; }
          uint2 w; w.x = pack2(o[0], o[1]); w.y = pack2(o[2], o[3]);
          *(uint2*)(p.Y() + (size_t)r * D + 256 + c0) = w; }
        { const uint2 a = *(const uint2*)(D0 + (size_t)r * 256 + c0), bq = *(const uint2*)(D1 + (size_t)r * 256 + c0);
          float y[4] = {lo2f(a.x) + lo2f(bq.x), hi2f(a.x) + hi2f(bq.x), lo2f(a.y) + lo2f(bq.y), hi2f(a.y) + hi2f(bq.y)};
          float sq = (y[0] * y[0] + y[1] * y[1]) + (y[2] * y[2] + y[3] * y[3]);
          sq += __shfl_xor(sq, 1); sq += __shfl_xor(sq, 2); sq += __shfl_xor(sq, 4); sq += __shfl_xor(sq, 8);
          const float rstd = rsq_fast(sq * (1.f / 64.f) + 1e-6f);
          const uint2 gt = *(const uint2*)(p.PM() + (size_t)r * NP + PC_DG + c0);
          const float gv[4] = {lo2f(gt.x), hi2f(gt.x), lo2f(gt.y), hi2f(gt.y)};
          float o[4];
#pragma unroll
          for (int i = 0; i < 4; ++i) o[i] = y[i] * rstd * p.dn_norm_g()[layer * 64 + ((c0 + i) & 63)] * silu_(gv[i]);
          uint2 w; w.x = pack2(o[0], o[1]); w.y = pack2(o[2], o[3]);
          *(uint2*)(p.Y() + (size_t)r * D + 512 + c0) = w; }
        (void)hh;
    }
}

__device__ __forceinline__ void phase_mixB1(const P& p, int layer, unsigned char* smem) {
    { pg8::Gemm g{p.AC(), p.S5TT() + (size_t)layer * 16 * 256 * 512, 512, 512, 512}; pg8::S5Order S; S.init(p.nblk(), p.bid(), (size_t)256 * 512 * 2);
      EpiS5Y E{p.PM(), p.s5_d() + layer * 256, layer == 0 ? 1 : 0};
      pg8::gemm_phase<EpiS5Y, pg8::S5Order>((PG8_LAS unsigned char*)smem, g, S, E); }
}

__device__ __forceinline__ void phase_glu(const P& p, int layer, unsigned char* smem) {
    const int rows = layer == 0 ? RT : RL;
    pg8::Gemm g{p.PM() + PC_S5, p.WGLUT(), NP, 256, 256}; pg8::GridOrder S; S.init(rows, 256, p.nblk(), p.bid(), NP, 256);
    EpiGlu E{p.PM(), p.Y(), p.s5_b_glu() + layer * 256};
    pg8::gemm_phase<EpiGlu, pg8::GridOrder>((PG8_LAS unsigned char*)smem, g, S, E);
}
__device__ __forceinline__ void phase_gates(const P& p, int layer, unsigned char* smem) {
    const int rows = layer == 0 ? RT : RL;
    pg8::Gemm g{p.H(), p.WGT(), 1024, 1024, 1024}; pg8::GridOrder S; S.init(rows, 4096, p.nblk(), p.bid(), 1024, 1024);
    EpiStoreBf16 E{p.GB(), 4096, 1, 0, nullptr};
    pg8::gemm_phase<EpiStoreBf16, pg8::GridOrder>((PG8_LAS unsigned char*)smem, g, S, E);
}
constexpr size_t GM_SCRP = 0, GM_SCRS = (size_t)32 << 20, GM_TL = (size_t)64 << 20, GM_MM = (size_t)96 << 20;
static_assert(GM_MM + (size_t)RT * 1024 * 2 <= (size_t)RT * NP * 2, "gate/merge scratch fits in PM");
static_assert(GM_TL + (size_t)32 * 4 * 65536 * 2 <= GM_MM && (size_t)256 * 131072 <= GM_SCRS, "gate/merge scratch layout");
__device__ __forceinline__ bf16_t* gm_mm(const P& p) { return (bf16_t*)((unsigned char*)p.PM() + GM_MM); }
__device__ __forceinline__ void phase_gatemerge(const P& p, int layer, unsigned char* smem) {
    const int rows = layer == 0 ? RT : RL;
    pg8::Gemm g{p.H(), p.WGT(), 1024, 1024, 1024};
    pg8::GateMergeOrder S; S.init(rows, 1024, p.nblk(), p.bid(), 1024, 1024);
    S.dA = (size_t)((const char*)p.Y() - (const char*)p.H()); S.dB = (size_t)((const char*)p.WBT() - (const char*)p.WGT());
    unsigned char* pm = (unsigned char*)p.PM();
    EpiGateMerge E{pm + GM_SCRP, pm + GM_SCRS, (bf16_t*)(pm + GM_TL), gm_mm(p)};
    pg8::gemm_phase_gm<EpiGateMerge, pg8::GateMergeOrder>((PG8_LAS unsigned char*)smem, g, S, E);
}
__device__ __forceinline__ void phase_gm_tail(const P& p, int layer) {
    const int rows = layer == 0 ? RT : RL;
    pg8::GateMergeOrder S; S.init(rows, 1024, p.nblk(), p.bid(), 1024, 1024);
    const int ft = S.full_tiles(), nt = S.nwg - ft;
    const bf16_t* TL = (const bf16_t*)((unsigned char*)p.PM() + GM_TL); bf16_t* M = gm_mm(p);
    for (int i = p.bid() * NTHR + p.tid(); i < nt * 8192; i += p.nblk() * NTHR) {
        const int lt = i >> 13, lr = (i >> 5) & 255, lc = (i & 31) * 8;
        int pm, pn; S.tile((long)ft + lt, pm, pn);
        const bf16_t* tp = TL + ((size_t)lt * 4 * 65536 + lr * 256 + lc);
        const uint4 a = *(const uint4*)tp, b = *(const uint4*)(tp + 65536), cc = *(const uint4*)(tp + 2 * 65536), d = *(const uint4*)(tp + 3 * 65536);
        uint4 o;
        o.x = pack2((lo2f(a.x) + lo2f(b.x)) + (lo2f(cc.x) + lo2f(d.x)), (hi2f(a.x) + hi2f(b.x)) + (hi2f(cc.x) + hi2f(d.x)));
        o.y = pack2((lo2f(a.y) + lo2f(b.y)) + (lo2f(cc.y) + lo2f(d.y)), (hi2f(a.y) + hi2f(b.y)) + (hi2f(cc.y) + hi2f(d.y)));
        o.z = pack2((lo2f(a.z) + lo2f(b.z)) + (lo2f(cc.z) + lo2f(d.z)), (hi2f(a.z) + hi2f(b.z)) + (hi2f(cc.z) + hi2f(d.z)));
        o.w = pack2((lo2f(a.w) + lo2f(b.w)) + (lo2f(cc.w) + lo2f(d.w)), (hi2f(a.w) + hi2f(b.w)) + (hi2f(cc.w) + hi2f(d.w)));
        *(uint4*)(M + ((size_t)pm * 256 + lr) * 1024 + pn * 256 + lc) = o;
    }
}
__device__ __forceinline__ void phase_merge(const P& p, int layer, unsigned char* smem) {
    const int rows = layer == 0 ? RT : RL;
    pg8::Gemm g{p.Y(), p.WBT(), 1024, 256, 256}; pg8::MergeOrder S; S.init(rows, 1024, p.nblk(), p.bid(), 1024, 256);
    EpiMergeY E{p.GB(), p.MM()};
    pg8::gemm_phase<EpiMergeY, pg8::MergeOrder>((PG8_LAS unsigned char*)smem, g, S, E);
}
__device__ __forceinline__ void phase_msum(const P& p, int layer) {
    const int rows = layer == 0 ? RT : RL;
    const size_t n8 = (size_t)rows * 128;
    for (size_t i = (size_t)p.bid() * NTHR + p.tid(); i < n8; i += (size_t)p.nblk() * NTHR) {
        const size_t r = i >> 7; const int c = (int)(i & 127) * 8;
        const bf16_t* tp = p.GB() + r * 4096 + c;
        const uint4 a = *(const uint4*)tp, b = *(const uint4*)(tp + 1024), cc = *(const uint4*)(tp + 2048), d = *(const uint4*)(tp + 3072);
        uint4 o;
        o.x = pack2((lo2f(a.x) + lo2f(b.x)) + (lo2f(cc.x) + lo2f(d.x)), (hi2f(a.x) + hi2f(b.x)) + (hi2f(cc.x) + hi2f(d.x)));
        o.y = pack2((lo2f(a.y) + lo2f(b.y)) + (lo2f(cc.y) + lo2f(d.y)), (hi2f(a.y) + hi2f(b.y)) + (hi2f(cc.y) + hi2f(d.y)));
        o.z = pack2((lo2f(a.z) + lo2f(b.z)) + (lo2f(cc.z) + lo2f(d.z)), (hi2f(a.z) + hi2f(b.z)) + (hi2f(cc.z) + hi2f(d.z)));
        o.w = pack2((lo2f(a.w) + lo2f(b.w)) + (lo2f(cc.w) + lo2f(d.w)), (hi2f(a.w) + hi2f(b.w)) + (hi2f(cc.w) + hi2f(d.w)));
        *(uint4*)(p.MM() + r * 1024 + c) = o;
    }
}
__device__ __forceinline__ void phase_msum_tail(const P& p, int layer) {
    const int rows = layer == 0 ? RT : RL;
    pg8::MergeOrder S; S.init(rows, 1024, p.nblk(), p.bid(), 1024, 256);
    const int ft = S.full_tiles(), nt = S.nwg - ft;
    for (int i = p.bid() * NTHR + p.tid(); i < nt * 8192; i += p.nblk() * NTHR) {
        int pm, pn; S.tile((long)ft + (i >> 13), pm, pn);
        const size_t r = (size_t)pm * 256 + ((i >> 5) & 255); const int c = pn * 256 + (i & 31) * 8;
        const bf16_t* tp = p.GB() + r * 4096 + c;
        const uint4 a = *(const uint4*)tp, b = *(const uint4*)(tp + 1024), cc = *(const uint4*)(tp + 2048), d = *(const uint4*)(tp + 3072);
        uint4 o;
        o.x = pack2((lo2f(a.x) + lo2f(b.x)) + (lo2f(cc.x) + lo2f(d.x)), (hi2f(a.x) + hi2f(b.x)) + (hi2f(cc.x) + hi2f(d.x)));
        o.y = pack2((lo2f(a.y) + lo2f(b.y)) + (lo2f(cc.y) + lo2f(d.y)), (hi2f(a.y) + hi2f(b.y)) + (hi2f(cc.y) + hi2f(d.y)));
        o.z = pack2((lo2f(a.z) + lo2f(b.z)) + (lo2f(cc.z) + lo2f(d.z)), (hi2f(a.z) + hi2f(b.z)) + (hi2f(cc.z) + hi2f(d.z)));
        o.w = pack2((lo2f(a.w) + lo2f(b.w)) + (lo2f(cc.w) + lo2f(d.w)), (hi2f(a.w) + hi2f(b.w)) + (hi2f(cc.w) + hi2f(d.w)));
        *(uint4*)(p.MM() + r * 1024 + c) = o;
    }
}
__device__ __forceinline__ void phase_outproj(const P& p, int layer, unsigned char* smem) {
    const int rows = layer == 0 ? RT : RL;
    pg8::Gemm g{gm_mm(p), p.WOT(), 1024, 1024, 1024}; pg8::GridOrder S; S.init(rows, 1024, p.nblk(), p.bid(), 1024, 1024);
    EpiOut E{p.out(), p.XC(), p.MOD() + (size_t)layer * 9 * 6144 + 2 * 1024};
    pg8::gemm_phase<EpiOut, pg8::GridOrder>((PG8_LAS unsigned char*)smem, g, S, E);
    if (layer == 0 && p.bid() >= 32) wprep_items(p, 1, p.bid() - 32, p.nblk() - 32, smem, 1);
}

__device__ __forceinline__ void phase_norm2_router(const P& p, int layer, unsigned char* smem) {
    float* RW = (float*)smem;
    unsigned* lcnt = (unsigned*)(RW + 1024 * 20);
    int t_ = (int)threadIdx.x; asm volatile("" : "+v"(t_));
    for (int i = t_; i < 1024 * 16; i += NTHR) { const int k = i >> 4, e = i & 15; RW[(((k >> 8) * 4 + (k & 3)) * 64 + ((k >> 2) & 63)) * 20 + e] = p.router_w()[i]; }
    if (t_ < 16) lcnt[t_] = 0u;
    __syncthreads();
    const int nrows = layer == 0 ? RT : RL;
    const int gw = p.bid() * 8 + p.wid(), nw = p.nblk() * 8;
    float rb[16];
#pragma unroll
    for (int e = 0; e < 16; ++e) rb[e] = p.router_b()[e];
    const int ln4 = p.lane() * 4, last = nrows - 1;
    float4 xn[4];
#pragma unroll
    for (int j = 0; j < 4; ++j) xn[j] = *(const float4*)(xrow(p, gw) + j * 256 + ln4);
#pragma unroll 1
    for (int r = gw; r < nrows; r += nw) {
        const float* md = p.MOD() + (size_t)(layer * 9 + modrow(r)) * 6144;
        float v[16]; float ss = 0.f;
#pragma unroll
        for (int j = 0; j < 4; ++j) { v[j * 4] = xn[j].x; v[j * 4 + 1] = xn[j].y; v[j * 4 + 2] = xn[j].z; v[j * 4 + 3] = xn[j].w; }
        { const float* xq = xrow(p, min(r + nw, last));
#pragma unroll
          for (int j = 0; j < 4; ++j) xn[j] = *(const float4*)(xq + j * 256 + ln4); }
#pragma unroll
        for (int j = 0; j < 16; ++j) ss += v[j] * v[j];
#pragma unroll
        for (int o = 32; o >= 1; o >>= 1) ss += __shfl_xor(ss, o);
        const float rstd = rsq_fast(ss * (1.f / 1024.f) + 1e-6f);
        float lg[16];
#pragma unroll
        for (int e = 0; e < 16; ++e) lg[e] = 0.f;
#pragma unroll
        for (int j = 0; j < 4; ++j) { const int k = j * 256 + ln4;
            const float4 g = *(const float4*)(p.norm2_g() + layer * 1024 + k), sc = *(const float4*)(md + 4 * 1024 + k), sh = *(const float4*)(md + 3 * 1024 + k);
            float h2[4];
            h2[0] = v[j * 4] * rstd * g.x * (1.f + sc.x) + sh.x; h2[1] = v[j * 4 + 1] * rstd * g.y * (1.f + sc.y) + sh.y;
            h2[2] = v[j * 4 + 2] * rstd * g.z * (1.f + sc.z) + sh.z; h2[3] = v[j * 4 + 3] * rstd * g.w * (1.f + sc.w) + sh.w;
            uint2 o; o.x = pack2(h2[0], h2[1]); o.y = pack2(h2[2], h2[3]);
            *(uint2*)(p.H() + (size_t)r * D + k) = o;
#pragma unroll
            for (int q = 0; q < 4; ++q) { const float4* rw4 = (const float4*)(RW + ((j * 4 + q) * 64 + p.lane()) * 20);
#pragma unroll
                for (int e4 = 0; e4 < 4; ++e4) { const float4 w = rw4[e4]; lg[e4 * 4] += h2[q] * w.x; lg[e4 * 4 + 1] += h2[q] * w.y; lg[e4 * 4 + 2] += h2[q] * w.z; lg[e4 * 4 + 3] += h2[q] * w.w; } }
            asm volatile("" ::: "memory"); }
        const int ln = p.lane();
#pragma unroll
        for (int i = 0; i < 8; ++i) { const bool up = (ln & 32) != 0; const float send = up ? lg[i] : lg[i + 8], keep = up ? lg[i + 8] : lg[i]; lg[i] = keep + __shfl_xor(send, 32); }
#pragma unroll
        for (int i = 0; i < 4; ++i) { const bool up = (ln & 16) != 0; const float send = up ? lg[i] : lg[i + 4], keep = up ? lg[i + 4] : lg[i]; lg[i] = keep + __shfl_xor(send, 16); }
#pragma unroll
        for (int i = 0; i < 2; ++i) { const bool up = (ln & 8) != 0; const float send = up ? lg[i] : lg[i + 2], keep = up ? lg[i + 2] : lg[i]; lg[i] = keep + __shfl_xor(send, 8); }
        { const bool up = (ln & 4) != 0; const float send = up ? lg[0] : lg[1], keep = up ? lg[1] : lg[0]; lg[0] = keep + __shfl_xor(send, 4); }
        lg[0] += __shfl_xor(lg[0], 2); lg[0] += __shfl_xor(lg[0], 1);
        float sc[16], sel[16];
#pragma unroll
        for (int e = 0; e < 16; ++e) { sc[e] = sigm(__shfl(lg[0], 4 * e)); sel[e] = sc[e] + rb[e]; }
        int best = 0; float bestv = -1e30f;
#pragma unroll
        for (int g = 0; g < 4; ++g) { float m1 = -1e30f, m2 = -1e30f;
#pragma unroll
            for (int i = 0; i < 4; ++i) { const float s = sel[g * 4 + i]; if (s > m1) { m2 = m1; m1 = s; } else if (s > m2) m2 = s; }
            const float gs = m1 + m2; if (gs > bestv) { bestv = gs; best = g; } }
        int i1 = 0, i2 = 0; float s1 = -1e30f, s2 = -1e30f;
#pragma unroll
        for (int g = 0; g < 4; ++g)
#pragma unroll
            for (int i = 0; i < 4; ++i) if (g == best) { const float s = sel[g * 4 + i]; const int e = g * 4 + i;
                if (s > s1) { s2 = s1; i2 = i1; s1 = s; i1 = e; } else if (s > s2) { s2 = s; i2 = e; } }
        float w1 = 0.f, w2 = 0.f;
#pragma unroll
        for (int e = 0; e < 16; ++e) { if (e == i1) w1 = sc[e]; if (e == i2) w2 = sc[e]; }
        const float inv = 1.f / (w1 + w2);
        if (p.lane() == 0) { p.TOK()[r] = make_int4(i1, i2, __float_as_int(w1 * inv), __float_as_int(w2 * inv)); atomicAdd(&lcnt[i1], 1u); atomicAdd(&lcnt[i2], 1u); }
    }
    __syncthreads();
    if (p.tid() < 16 && lcnt[p.tid()]) atomicAdd(p.ctl() + CW_CNT + layer * 64 + p.tid(), lcnt[p.tid()]);
}

__device__ __forceinline__ void load_segments(const P& p, int layer, int* seg  , int* cnt  ) {
    if (p.tid() == 0) { int s = 0; for (int e = 0; e < 16; ++e) { const int c = (int)__hip_atomic_load(p.ctl() + CW_CNT + layer * 64 + e, __ATOMIC_RELAXED, __HIP_MEMORY_SCOPE_AGENT); cnt[e] = c; seg[e] = s; s += (c + 255) & ~255; } seg[16] = s; }
    __syncthreads();
}

__device__ __forceinline__ void phase_scatter(const P& p, int layer, unsigned char* smem) {
    int* seg = (int*)(smem + LDS_RING); int* cnt = seg + 32;
    load_segments(p, layer, seg, cnt);
    int* lc = (int*)smem; int* lbase = lc + 16; int* rowpos = lc + 64;
    const int nrows = layer == 0 ? RT : RL;
    const int rpw = nrows / p.nblk(), r0 = p.bid() * rpw;
    if (p.tid() < 16) lc[p.tid()] = 0;
    __syncthreads();
    for (int i = p.wid(); i < rpw; i += 8) {
        if (p.lane() == 0) { const int4 tk = p.TOK()[r0 + i]; rowpos[i * 2] = atomicAdd(&lc[tk.x], 1); rowpos[i * 2 + 1] = atomicAdd(&lc[tk.y], 1); }
    }
    __syncthreads();
    if (p.tid() < 16) lbase[p.tid()] = lc[p.tid()] ? (int)atomicAdd(p.ctl() + CW_CNT + layer * 64 + 32 + p.tid(), (unsigned)lc[p.tid()]) : 0;
    __syncthreads();
    for (int i = p.wid(); i < rpw; i += 8) {
        const int r = r0 + i; const int4 tk = p.TOK()[r];
        const int s0 = seg[tk.x] + lbase[tk.x] + rowpos[i * 2], s1 = seg[tk.y] + lbase[tk.y] + rowpos[i * 2 + 1];
        if (p.lane() == 0) p.SLOT()[r] = make_int2(s0, s1);
        const uint4* src = (const uint4*)(p.H() + (size_t)r * D);
        const uint4 a = src[p.lane()], b2 = src[64 + p.lane()];
        uint4* d0 = (uint4*)(p.XS() + (size_t)s0 * D); uint4* d1 = (uint4*)(p.XS() + (size_t)s1 * D);
        d0[p.lane()] = a; d0[64 + p.lane()] = b2; d1[p.lane()] = a; d1[64 + p.lane()] = b2;
    }
}

__device__ __forceinline__ void phase_moe1(const P& p, int layer, unsigned char* smem) {
    int* seg = (int*)(smem + LDS_RING); int* cnt = seg + 32;
    load_segments(p, layer, seg, cnt);
    pg8::Gemm g{p.XS(), p.W13T(), 1024, 1024, 1024}; pg8::Moe1Order S; S.init(seg, 2, 512, p.nblk(), p.bid(), 1024, 1024); S.flags = p.ctl() + CW_MOEF + layer * 512;
    EpiMoe1 E{p.ACT()};
    pg8::gemm_phase<EpiMoe1, pg8::Moe1Order>((PG8_LAS unsigned char*)smem, g, S, E);
}
__device__ __forceinline__ void phase_moe2(const P& p, int layer, unsigned char* smem) {
    int* seg = (int*)(smem + LDS_RING); int* cnt = seg + 32;
    load_segments(p, layer, seg, cnt);
    pg8::Gemm g{p.ACT(), p.W2T(), 256, 256, 256}; pg8::Moe2Order S; S.init(seg, 4, 1024, p.nblk(), p.bid(), 256, 256); S.flags = p.ctl() + CW_MOEF + layer * 512; S.bar = p.ctl() + CW_BAR;
    { const int u1 = (seg[16] >> 8) * 2 - 2 * p.nblk(); S.r1 = u1 < 0 ? 0 : (u1 > p.nblk() ? p.nblk() : u1); }
    EpiStoreBf16 E{p.YE(), 1024, 0, 0, nullptr};
    pg8::gemm_phase<EpiStoreBf16, pg8::Moe2Order>((PG8_LAS unsigned char*)smem, g, S, E);
}

constexpr int NPH_LAYER = 13;
constexpr int NPHASE = 1 + 2 * NPH_LAYER + 1;

__global__ void __launch_bounds__(NTHR, 2) fwd(Args a) {
    extern __shared__ __attribute__((aligned(16))) unsigned char smem[];
    P p(a);

    volatile LAS unsigned* xbw = (volatile LAS unsigned*)(smem + LDS_BYTES - 16);
    const bool multi = (a.ph_hi - a.ph_lo) > 1;
    XcdBarrier bar; bar.bar = p.ctl() + CW_BAR; bar.x = 0; bar.st = xbw;
    if (multi) {
        if (threadIdx.x == 0) { xbw[0] = 0u; xbw[1] = 0u; xbw[2] = 0u; xbw[3] = 0u; }
        __syncthreads();
        bar = xcd_barrier_post(p.ctl() + CW_BAR, xbw);
    }
#define IN(k) (a.ph_lo <= (k) && (k) < a.ph_hi)
#define SEAM(k) do { if (IN((k) + 1)) xcd_barrier(bar); } while (0)

    if (IN(0)) { phase_prologue(p, smem); SEAM(0); }
    {
        if (IN(1)) { phase_wprep(p, 0, smem); phase_norm1(p, 0); SEAM(1); }
        if (IN(2)) { phase_gemm1(p, smem); SEAM(2); }
        if (IN(3)) { phase_mixA(p, 0, smem); SEAM(3); }
        if (IN(4)) { phase_mixB(p, 0, smem); SEAM(4); }
        if (IN(5)) { if (!MK_SINGLE) SEAM(5); }
        if (IN(6)) { phase_glu(p, 0, smem); SEAM(6); }
        if (IN(7)) { phase_gatemerge(p, 0, smem); SEAM(7); }
        if (IN(8)) { phase_gm_tail(p, 0); SEAM(8); }
        if (IN(9)) { phase_outproj(p, 0, smem); SEAM(9); }
        if (IN(10)) { phase_norm2_router(p, 0, smem); SEAM(10); }
        if (IN(11)) { phase_scatter(p, 0, smem); SEAM(11); }
        if (IN(12)) { phase_moe1(p, 0, smem); if (!MK_SINGLE) SEAM(12); }
        if (IN(13)) { phase_moe2(p, 0, smem); SEAM(13); }
    }
    {
        if (IN(14)) { phase_wprep(p, 1, smem); phase_norm1(p, 1); SEAM(14); }
        if (IN(15)) { phase_gemm1(p, smem); SEAM(15); }
        if (IN(16)) { phase_mixA(p, 1, smem); SEAM(16); }
        if (IN(17)) { phase_mixB(p, 1, smem); SEAM(17); }
        if (IN(18)) { if (!MK_SINGLE) SEAM(18); }
        if (IN(19)) { phase_glu(p, 1, smem); SEAM(19); }
        if (IN(20)) { phase_gatemerge(p, 1, smem); SEAM(20); }
        if (IN(21)) { if (!MK_SINGLE) SEAM(21); }
        if (IN(22)) { phase_outproj(p, 1, smem); SEAM(22); }
        if (IN(23)) { phase_norm2_router(p, 1, smem); SEAM(23); }
        if (IN(24)) { phase_scatter(p, 1, smem); SEAM(24); }
        if (IN(25)) { phase_moe1(p, 1, smem); if (!MK_SINGLE) SEAM(25); }
        if (IN(26)) { phase_moe2(p, 1, smem); SEAM(26); }
    }
    if (IN(NPHASE - 1)) { phase_norm1(p, 2); }
#undef IN
#undef SEAM
}

}

extern "C" void kernel_launch(void* const* d_in, const int* in_sizes, int n_in, void* d_out, int out_size, void* d_ws, size_t ws_size, hipStream_t stream) {
    static int ready = 0;
    if (ready == 0) {
        if (n_in != 42 || out_size != RL * D || ws_size < WS_END) { fprintf(stderr, "kernel_launch: unexpected shapes n_in=%d out=%d ws=%zu need=%zu\n", n_in, out_size, ws_size, (size_t)WS_END); ready = -1; return; }
        if (hipFuncSetAttribute((const void*)fwd, hipFuncAttributeMaxDynamicSharedMemorySize, LDS_BYTES) != hipSuccess) { fprintf(stderr, "kernel_launch: hipFuncSetAttribute failed\n"); ready = -1; return; }
        int per_cu = 0; (void)hipOccupancyMaxActiveBlocksPerMultiprocessor(&per_cu, (const void*)fwd, NTHR, LDS_BYTES); (void)hipGetLastError();
        if (per_cu < 1) fprintf(stderr, "kernel_launch: occupancy query says %d blocks/CU\n", per_cu);
        ready = 1;
    }
    if (ready < 0) return;
    (void)in_sizes;
    (void)hipMemsetAsync((char*)d_ws + WS_CTL, 0, CTL_BYTES, stream);
    Args a{};
    for (int i = 0; i < 42; ++i) a.in[i] = (const float*)d_in[i];
    a.out = (float*)d_out; a.ws = (unsigned char*)d_ws;
    const int grid = 256;
#if MK_SINGLE
    a.ph_lo = 0; a.ph_hi = NPHASE;
    hipLaunchKernelGGL(fwd, dim3(grid), dim3(NTHR), LDS_BYTES, stream, a);
#else
    for (int ph = 0; ph < NPHASE; ++ph) { a.ph_lo = ph; a.ph_hi = ph + 1; hipLaunchKernelGGL(fwd, dim3(grid), dim3(NTHR), LDS_BYTES, stream, a); }
#endif
}
```
